# Optimizing an MI355X kernel written in HIP

```python
import jax, jax.numpy as jnp
from jax import lax
import numpy as np

D_MODEL = 2048
BATCH = 16
SEQ = 256
DEPTH = 2
DEC_BATCH = 2
DEC_SEQ = 4096
PAST_LEN = 512

GRID_W = 64
HEAD_DIM = 128
H_GQA = 8
KV_GQA = 2
H_NAT = 8
H_WIN = 8
KV_WIN = 2
BRANCH_W = 1024
N_BRANCH = 3
D_FF = 5632
Q_BLOCK = 128
WIN_RADIUS = 128
NAT_ROWS = 8
NAT_COLS = 16
ROPE_THETA = 10000.0
EPS = 1e-6
NEG_INF = -1e30
SCALE = HEAD_DIM ** -0.5
IN_SIZES = (H_GQA * HEAD_DIM, KV_GQA * HEAD_DIM, KV_GQA * HEAD_DIM,
            H_NAT * HEAD_DIM, H_NAT * HEAD_DIM, H_NAT * HEAD_DIM,
            H_WIN * HEAD_DIM, KV_WIN * HEAD_DIM, KV_WIN * HEAD_DIM,
            N_BRANCH * D_MODEL)
D_IN = sum(IN_SIZES)

kernel_name = "hybrid_diffusion_prefix_trunk_step"


def rmsnorm(x, g):
    xf = x.astype(jnp.float32)
    y = xf * lax.rsqrt(jnp.mean(xf * xf, axis=-1, keepdims=True) + EPS)
    return (y * g.astype(jnp.float32)).astype(x.dtype)


def modulation(cond, w_mod, b_mod):
    m = (jax.nn.silu(cond) @ w_mod + b_mod)[..., None, :]
    return jnp.split(m, 9, axis=-1)


def adaln(x, g, shift, scale):
    return rmsnorm(x, g) * (1 + scale) + shift


def swiglu(h, w_gu, w_down):
    a, b = jnp.split(h @ w_gu, 2, axis=-1)
    return (jax.nn.silu(a) * b) @ w_down


def project_in(h, w_in):
    z = h @ w_in
    idx = [int(i) for i in np.cumsum(IN_SIZES)[:-1]]
    parts = jnp.split(z, idx, axis=-1)
    B, T = h.shape[:2]
    heads = [p.reshape(B, T, -1, HEAD_DIM) for p in parts[:9]]
    return heads, parts[9]


def rope_2d(x):
    N, hd = x.shape[1], x.shape[-1]
    half = hd // 2
    nf = half // 2
    t = jnp.arange(N)
    row = (t // GRID_W).astype(jnp.float32)
    col = (t % GRID_W).astype(jnp.float32)
    inv = 1.0 / (ROPE_THETA ** (jnp.arange(nf, dtype=jnp.float32) / nf))

    def rot(seg, pos):
        ang = pos[:, None] * inv[None, :]
        cos = jnp.cos(ang)[None, :, None, :]
        sin = jnp.sin(ang)[None, :, None, :]
        s1, s2 = seg[..., :nf], seg[..., nf:]
        return jnp.concatenate([s1 * cos - s2 * sin, s2 * cos + s1 * sin], axis=-1)

    xf = x.astype(jnp.float32)
    return jnp.concatenate([rot(xf[..., :half], row), rot(xf[..., half:], col)], axis=-1).astype(x.dtype)


def joint_softmax(parts, sink=None):
    s = [p.astype(jnp.float32) for p in parts]
    if sink is not None:
        s.append(jnp.broadcast_to(sink.astype(jnp.float32), s[0].shape[:-1] + (1,)))
    p = jax.nn.softmax(jnp.concatenate(s, axis=-1), axis=-1)
    out, start = [], 0
    for q in parts:
        n = q.shape[-1]
        out.append(p[..., start:start + n])
        start += n
    return out


def dense_attn(q, k, v, sink=None):
    B, T, Hq, hd = q.shape
    Hkv = k.shape[2]
    G = Hq // Hkv
    qb = q.reshape(B, T // Q_BLOCK, Q_BLOCK, Hkv, G, hd).transpose(1, 0, 2, 3, 4, 5)

    def block(qblk):
        s = jnp.einsum('bqkgd,bskd->bkgqs', qblk, k).astype(jnp.float32) * SCALE
        (p,) = joint_softmax([s], sink)
        return jnp.einsum('bkgqs,bskd->bqkgd', p.astype(v.dtype), v)

    o = lax.map(block, qb)
    return o.transpose(1, 0, 2, 3, 4, 5).reshape(B, T, Hq * hd)


def window_attn(q, k, v, kc, vc, sink):
    B, N, Hq, hd = q.shape
    Hkv = k.shape[2]
    G = Hq // Hkv
    nb = N // Q_BLOCK

    def band(x):
        xp = jnp.pad(x, ((0, 0), (Q_BLOCK, Q_BLOCK), (0, 0), (0, 0))).reshape(B, nb + 2, Q_BLOCK, Hkv, hd)
        return jnp.concatenate([xp[:, :-2], xp[:, 1:-1], xp[:, 2:]], axis=2)

    kb, vb = band(k), band(v)
    qb = q.reshape(B, nb, Q_BLOCK, Hkv, G, hd)
    blk = jnp.arange(nb)[:, None] * Q_BLOCK
    qpos = blk + jnp.arange(Q_BLOCK)[None, :]
    kpos = blk - Q_BLOCK + jnp.arange(3 * Q_BLOCK)[None, :]
    mask = ((jnp.abs(kpos[:, None, :] - qpos[:, :, None]) <= WIN_RADIUS)
            & ((kpos >= 0) & (kpos < N))[:, None, :])
    s_loc = jnp.einsum('bnqkgd,bnskd->bnkgqs', qb, kb).astype(jnp.float32) * SCALE
    s_loc = jnp.where(mask[None, :, None, None], s_loc, NEG_INF)
    s_ctx = jnp.einsum('bnqkgd,bskd->bnkgqs', qb, kc).astype(jnp.float32) * SCALE
    p_ctx, p_loc = joint_softmax([s_ctx, s_loc], sink)
    o = (jnp.einsum('bnkgqs,bskd->bnqkgd', p_ctx.astype(vc.dtype), vc)
         + jnp.einsum('bnkgqs,bnskd->bnqkgd', p_loc.astype(vb.dtype), vb))
    return o.reshape(B, N, Hq * hd)


def nat_attn(q, k, v, kc, vc, rpb):
    B, N, H, hd = q.shape
    rows = N // GRID_W
    wr = min(NAT_ROWS, rows)
    wc = NAT_COLS
    r = jnp.arange(rows)
    rs = jnp.clip(r - wr // 2, 0, rows - wr)
    row_idx = rs[:, None] + jnp.arange(wr)[None, :]
    c = jnp.arange(GRID_W)
    cs = jnp.clip(c - wc // 2, 0, GRID_W - wc)
    col_ok = (c[None, :] >= cs[:, None]) & (c[None, :] < cs[:, None] + wc)
    dr = row_idx - r[:, None] + NAT_ROWS - 1
    dc = jnp.clip(c[None, :] - c[:, None] + wc - 1, 0, 2 * wc - 2)
    bias = rpb[:, dr[:, :, None, None], dc[None, None, :, :]]
    bias = bias.astype(jnp.float32).transpose(1, 0, 3, 2, 4).reshape(rows, H, GRID_W, wr * GRID_W)
    ok = jnp.broadcast_to(col_ok[:, None, :], (GRID_W, wr, GRID_W)).reshape(GRID_W, wr * GRID_W)
    bias = jnp.where(ok[None, None], bias, NEG_INF)
    kg = k.reshape(B, rows, GRID_W, H, hd)[:, row_idx].reshape(B, rows, wr * GRID_W, H, hd)
    vg = v.reshape(B, rows, GRID_W, H, hd)[:, row_idx].reshape(B, rows, wr * GRID_W, H, hd)
    qg = q.reshape(B, rows, GRID_W, H, hd)
    s_loc = jnp.einsum('brqhd,brkhd->brhqk', qg, kg).astype(jnp.float32) * SCALE + bias[None]
    s_ctx = jnp.einsum('brqhd,bshd->brhqs', qg, kc).astype(jnp.float32) * SCALE
    p_ctx, p_loc = joint_softmax([s_ctx, s_loc])
    o = (jnp.einsum('brhqs,bshd->brqhd', p_ctx.astype(vc.dtype), vc)
         + jnp.einsum('brhqk,brkhd->brqhd', p_loc.astype(vg.dtype), vg))
    return o.reshape(B, N, H * hd)


def merge(gates, outs, w_branch, w_o):
    gs = jnp.split(gates, N_BRANCH, axis=-1)
    m = sum(jax.nn.sigmoid(g) * (o @ w_branch[i]) for i, (g, o) in enumerate(zip(gs, outs)))
    return m @ w_o


def mixer_context(h, w_in, g_q, g_k, sink, w_branch, w_o):
    (qa, ka, va, qb, kb, vb, qc, kc, vc), gates = project_in(h, w_in)
    qa = rmsnorm(qa, g_q)
    ka = rmsnorm(ka, g_k)
    sink_r = sink.reshape(KV_WIN, H_WIN // KV_WIN, 1, 1)
    oa = dense_attn(qa, ka, va)
    ob = dense_attn(qb, kb, vb)
    oc = dense_attn(qc, kc, vc, sink_r)
    return merge(gates, (oa, ob, oc), w_branch, w_o), (ka, va, kb, vb, kc, vc)


def mixer_latent(h, ctx, w_in, g_q, g_k, rpb, sink, w_branch, w_o):
    ka_c, va_c, kb_c, vb_c, kc_c, vc_c = ctx
    (qa, ka, va, qb, kb, vb, qc, kc, vc), gates = project_in(h, w_in)
    qa = rope_2d(rmsnorm(qa, g_q))
    ka = rope_2d(rmsnorm(ka, g_k))
    sink_r = sink.reshape(KV_WIN, H_WIN // KV_WIN, 1, 1)
    oa = dense_attn(qa, jnp.concatenate([ka_c.astype(ka.dtype), ka], axis=1),
                    jnp.concatenate([va_c.astype(va.dtype), va], axis=1))
    ob = nat_attn(qb, kb, vb, kb_c, vb_c, rpb)
    oc = window_attn(rope_2d(qc), rope_2d(kc), vc, kc_c, vc_c, sink_r)
    return merge(gates, (oa, ob, oc), w_branch, w_o), None


def trunk_layer(x, mods, g_norm, w1_gu, w1_down, w2_gu, w2_down, mix):
    sh1, sc1, gt1, sh2, sc2, gt2, sh3, sc3, gt3 = mods
    x = x + 0.5 * gt1 * swiglu(adaln(x, g_norm[0], sh1, sc1), w1_gu, w1_down)
    m, aux = mix(adaln(x, g_norm[1], sh2, sc2))
    x = x + gt2 * m
    x = x + 0.5 * gt3 * swiglu(adaln(x, g_norm[2], sh3, sc3), w2_gu, w2_down)
    return x, aux


def setup_inputs(seed: int = 0) -> dict:
    key = jax.random.key(seed)
    ks = jax.random.split(key, 32)
    f32 = jnp.float32

    def nrm(k, shape, s):
        return jax.random.normal(k, shape, f32) * s

    hd = HEAD_DIM
    return {
        'x_prompt': nrm(ks[0], (BATCH, SEQ, D_MODEL), 1.0),
        'x_sample': nrm(ks[1], (DEC_BATCH, DEC_SEQ, D_MODEL), 1.0),
        'cache_k_gqa': nrm(ks[2], (DEC_BATCH, DEPTH, PAST_LEN, KV_GQA, hd), 1.0),
        'cache_v_gqa': nrm(ks[3], (DEC_BATCH, DEPTH, PAST_LEN, KV_GQA, hd), 1.0),
        'cache_k_nat': nrm(ks[4], (DEC_BATCH, DEPTH, PAST_LEN, H_NAT, hd), 1.0),
        'cache_v_nat': nrm(ks[5], (DEC_BATCH, DEPTH, PAST_LEN, H_NAT, hd), 1.0),
        'cache_k_win': nrm(ks[6], (DEC_BATCH, DEPTH, PAST_LEN, KV_WIN, hd), 1.0),
        'cache_v_win': nrm(ks[7], (DEC_BATCH, DEPTH, PAST_LEN, KV_WIN, hd), 1.0),
        'c': nrm(ks[8], (DEC_BATCH, D_MODEL), 1.0),
        'c_ctx': nrm(ks[9], (D_MODEL,), 1.0),
        'w_mod': nrm(ks[10], (DEPTH, D_MODEL, 9 * D_MODEL), 0.5 * D_MODEL ** -0.5),
        'b_mod': nrm(ks[11], (DEPTH, 9 * D_MODEL), 0.02),
        'g_norm': 1.0 + nrm(ks[12], (DEPTH, 3, D_MODEL), 0.02),
        'w_ffn1_gu': nrm(ks[13], (DEPTH, D_MODEL, 2 * D_FF), D_MODEL ** -0.5),
        'w_ffn1_down': nrm(ks[14], (DEPTH, D_FF, D_MODEL), D_FF ** -0.5),
        'w_in': nrm(ks[15], (DEPTH, D_MODEL, D_IN), D_MODEL ** -0.5),
        'g_q': 1.0 + nrm(ks[16], (DEPTH, hd), 0.02),
        'g_k': 1.0 + nrm(ks[17], (DEPTH, hd), 0.02),
        'rpb': nrm(ks[18], (DEPTH, H_NAT, 2 * NAT_ROWS - 1, 2 * NAT_COLS - 1), 0.1),
        'sink': nrm(ks[19], (DEPTH, H_WIN), 0.5),
        'w_branch': nrm(ks[20], (DEPTH, N_BRANCH, BRANCH_W, D_MODEL), BRANCH_W ** -0.5),
        'w_o': nrm(ks[21], (DEPTH, D_MODEL, D_MODEL), D_MODEL ** -0.5),
        'w_ffn2_gu': nrm(ks[22], (DEPTH, D_MODEL, 2 * D_FF), D_MODEL ** -0.5),
        'w_ffn2_down': nrm(ks[23], (DEPTH, D_FF, D_MODEL), D_FF ** -0.5),
        'g_final': 1.0 + nrm(ks[24], (D_MODEL,), 0.02),
    }


def reference(x_prompt, x_sample, cache_k_gqa, cache_v_gqa, cache_k_nat, cache_v_nat, cache_k_win, cache_v_win,
              c, c_ctx, w_mod, b_mod, g_norm, w_ffn1_gu, w_ffn1_down, w_in, g_q, g_k, rpb, sink,
              w_branch, w_o, w_ffn2_gu, w_ffn2_down, g_final):
    y_p = x_prompt
    y_s = x_sample
    new = [[] for _ in range(6)]
    for l in range(DEPTH):
        mods_ctx = modulation(c_ctx, w_mod[l], b_mod[l])
        y_p, ctx_kv = trunk_layer(
            y_p, mods_ctx, g_norm[l], w_ffn1_gu[l], w_ffn1_down[l], w_ffn2_gu[l], w_ffn2_down[l],
            lambda h: mixer_context(h, w_in[l], g_q[l], g_k[l], sink[l], w_branch[l], w_o[l]))
        for i in range(6):
            new[i].append(ctx_kv[i])
        mods_lat = modulation(c, w_mod[l], b_mod[l])
        cache_l = (cache_k_gqa[:, l], cache_v_gqa[:, l], cache_k_nat[:, l], cache_v_nat[:, l],
                   cache_k_win[:, l], cache_v_win[:, l])
        y_s, _ = trunk_layer(
            y_s, mods_lat, g_norm[l], w_ffn1_gu[l], w_ffn1_down[l], w_ffn2_gu[l], w_ffn2_down[l],
            lambda h: mixer_latent(h, cache_l, w_in[l], g_q[l], g_k[l], rpb[l], sink[l], w_branch[l], w_o[l]))
    y_prompt = rmsnorm(y_p, g_final)
    y_sample = rmsnorm(y_s, g_final)
    new_k_gqa = jnp.stack(new[0], axis=1)
    new_v_gqa = jnp.stack(new[1], axis=1)
    new_k_nat = jnp.stack(new[2], axis=1)
    new_v_nat = jnp.stack(new[3], axis=1)
    new_k_win = jnp.stack(new[4], axis=1)
    new_v_win = jnp.stack(new[5], axis=1)
    return (y_prompt, y_sample, new_k_gqa, new_v_gqa, new_k_nat, new_v_nat, new_k_win, new_v_win)
```

```cpp
#include <hip/hip_runtime.h>
#include <cstdio>
#include <cstdint>
namespace pg8 {
#define PG8_LAS __attribute__((address_space(3)))
typedef unsigned short bf16_t;
typedef short bf16x8 __attribute__((ext_vector_type(8)));
typedef float f32x4 __attribute__((ext_vector_type(4)));
typedef unsigned u32x4 __attribute__((ext_vector_type(4)));
constexpr int BM = 256, BK = 64, HALF = 128, HTB = HALF * BK * 2  , STAGE_BYTES = 8 * HTB, NXCD = 8, WGM = 8;

__host__ __device__ __forceinline__ int lds_byte(int r, int c) { const int st = (r >> 4) * 2 + (c >> 5), rr = r & 15, cc = c & 31, ob = rr * 64 + cc * 2; return st * 1024 + (ob ^ (((ob >> 9) & 1) << 5)); }
__host__ __device__ __forceinline__ void stage_rc(int b, int& R, int& C) { const int st = b / 1024, sb = b % 1024, swz = sb ^ (((sb >> 9) & 1) << 5); R = (st >> 1) * 16 + swz / 64; C = (st & 1) * 32 + (swz % 64) / 2; }
__host__ __device__ __forceinline__ int perm32(int rho) { const int n = rho >> 4, i = rho & 15; return 8 * (i >> 2) + 4 * n + (i & 3); }

struct Unit { int pm, pn; };
struct Gemm { const bf16_t* A; const bf16_t* Bt; int M, N, K; };

struct StaticOrder {
    int nM, nN, nwg, G, c;
    __host__ __device__ void init(int M, int N, int G_, int c_) { nM = M / BM; nN = N / BM; nwg = nM * nN; G = G_; c = c_; }
    __host__ __device__ bool next(int i, Unit& u) const {
        const long L = (long)i * G + c; if (L >= nwg) return false;
        int wgid = (int)L; { const int q = nwg / NXCD, r = nwg % NXCD, xcd = wgid % NXCD, off = wgid / NXCD; wgid = (xcd < r ? xcd * (q + 1) : r * (q + 1) + (xcd - r) * q) + off; }
        const int nig = WGM * nN, gid = wgid / nig, fm = gid * WGM, gsz = (nM - fm) < WGM ? (nM - fm) : WGM;
        u.pm = fm + ((wgid % nig) % gsz); u.pn = (wgid % nig) / gsz; return true;
    }
    __device__ __forceinline__ void a_ready(const Unit&) const {}
    __device__ __forceinline__ void done(const Unit&) const {}
};

__device__ __forceinline__ unsigned cvt_pk_bf16(float lo, float hi) { unsigned r; asm volatile("v_cvt_pk_bf16_f32 %0, %1, %2" : "=v"(r) : "v"(lo), "v"(hi)); return r; }
typedef float f32x2 __attribute__((ext_vector_type(2)));
__device__ __forceinline__ f32x2 gelu_pk(f32x2 v) {
    const f32x2 av = __builtin_elementwise_abs(v), d = av * 0.2316418882f + 1.0f;
    f32x2 t; t.x = __builtin_amdgcn_rcpf(d.x); t.y = __builtin_amdgcn_rcpf(d.y);
    f32x2 q = t * 0.5307027145f + (-0.7265760135f); q = q * t + 0.7107068705f; q = q * t + (-0.142248368f); q = q * t + 0.127414796f; q = q * t;
    const f32x2 s = (v * v) * (-0.72134752044f);
    f32x2 e; e.x = __builtin_amdgcn_exp2f(s.x); e.y = __builtin_amdgcn_exp2f(s.y);
    const f32x2 m = v * (q * e), r = v - m;
    f32x2 o; o.x = v.x < 0.f ? m.x : r.x; o.y = v.y < 0.f ? m.y : r.y; return o;
}

template <int ACT  > struct EpiBf16 {
    static constexpr bool PERM = true, AFTER_DRAIN = false; static_assert(ACT == 0 || ACT == 1, "EpiBf16: ACT is 0 (none) or 1 (gelu_pk)");
    bf16_t* O; int ldc; const float* bias; int split_cols; size_t split_stride; float scale0;
    __device__ __forceinline__ void operator()(const f32x4 (&acc)[2][2][4][2], const Unit& u, int wr, int wc, int fr, int fq) const {
        const int row0 = u.pm * BM + wr * 64 + fr; int colt = u.pn * BM; bf16_t* base = O;
        float sc = 1.f; if (split_cols) { const int t = colt / split_cols; base += (size_t)t * split_stride; colt -= t * split_cols; if (t == 0) sc = scale0; }
        const int col0 = colt + wc * 32 + 8 * fq, bcol0 = u.pn * BM + wc * 32 + 8 * fq;
        f32x4 bv[2][2];
#pragma unroll
        for (int bj = 0; bj < 2; ++bj)
#pragma unroll
            for (int n = 0; n < 2; ++n) bv[bj][n] = bias ? *(const f32x4*)(bias + bcol0 + bj * HALF + 4 * n) : (f32x4){0.f, 0.f, 0.f, 0.f};
#pragma unroll
        for (int ai = 0; ai < 2; ++ai)
#pragma unroll
            for (int m = 0; m < 4; ++m) { bf16_t* rowp = base + (size_t)(row0 + ai * HALF + m * 16) * ldc + col0;
#pragma unroll
                for (int bj = 0; bj < 2; ++bj) { f32x4 v0 = acc[ai][bj][m][0] + bv[bj][0], v1 = acc[ai][bj][m][1] + bv[bj][1];
                    if (ACT == 1) { f32x2 a = gelu_pk((f32x2){v0[0], v0[1]}), b = gelu_pk((f32x2){v0[2], v0[3]}), c = gelu_pk((f32x2){v1[0], v1[1]}), d = gelu_pk((f32x2){v1[2], v1[3]});
                        v0 = (f32x4){a.x, a.y, b.x, b.y}; v1 = (f32x4){c.x, c.y, d.x, d.y}; }
                    v0 = v0 * sc; v1 = v1 * sc; u32x4 w; w.x = cvt_pk_bf16(v0[0], v0[1]); w.y = cvt_pk_bf16(v0[2], v0[3]); w.z = cvt_pk_bf16(v1[0], v1[1]); w.w = cvt_pk_bf16(v1[2], v1[3]);
                    *(u32x4*)(rowp + bj * HALF) = w; } }
    }
};

template <class Epi, class Sched, bool ALIGN_EPI = false, bool SP2 = false>
__device__ __forceinline__ void gemm_phase(PG8_LAS unsigned char* lds, const Gemm g, const Sched& S, const Epi& E) {
    int tid_l = threadIdx.x; asm volatile("" : "+v"(tid_l));
    const int tid = tid_l, wid = __builtin_amdgcn_readfirstlane(tid >> 6), lane = tid & 63, wr = wid >> 2, wc = wid & 3, fr = lane & 15, fq = lane >> 4;
    const int K = g.K, nt = K / BK;
    unsigned voffA[2], voffB[2];
#pragma unroll
    for (int i = 0; i < 2; ++i) { int R, C; stage_rc(tid * 16 + i * 8192, R, C); const int Rb = Epi::PERM ? ((R & ~31) + perm32(R & 31)) : R;
        voffA[i] = (unsigned)(R * K + C) * 2u; voffB[i] = (unsigned)(Rb * K + C) * 2u; }
    const size_t kstep = (size_t)(BK * 2);
    const size_t hstep = (size_t)HALF * K * 2;
    const size_t tstep = 2 * hstep;
    const unsigned ldsw = (unsigned)wid * 1024u;
    const int aoff = lds_byte(wr * 64 + fr, fq * 8), boff = lds_byte(wc * 32 + fr, fq * 8);
#define PG8_SA(b, h) (((b) * 2 + (h)) * HTB)
#define PG8_SB(b, h) ((4 + (b) * 2 + (h)) * HTB)
#define PG8_STAGE(bufoff, gbase, voff) do { _Pragma("unroll") for (int _i = 0; _i < 2; ++_i) \
        __builtin_amdgcn_global_load_lds((const unsigned*)((const char*)(gbase) + (voff)[_i]), (PG8_LAS unsigned*)(lds + (bufoff) + ldsw + _i * 8192), 16, 0, 0); } while (0)
#define PG8_LDA(dst, b, h) do { _Pragma("unroll") for (int m = 0; m < 4; ++m) _Pragma("unroll") for (int k = 0; k < 2; ++k) dst[m][k] = *(const PG8_LAS bf16x8*)(lds + PG8_SA(b, h) + aoff + m * 2048 + k * 1024); } while (0)
#define PG8_LDB(dst, b, h) do { _Pragma("unroll") for (int n = 0; n < 2; ++n) _Pragma("unroll") for (int k = 0; k < 2; ++k) dst[n][k] = *(const PG8_LAS bf16x8*)(lds + PG8_SB(b, h) + boff + n * 2048 + k * 1024); } while (0)
#define PG8_MMA(ai, bj, At, Bt) do { __builtin_amdgcn_s_setprio(1); _Pragma("unroll") for (int m = 0; m < 4; ++m) _Pragma("unroll") for (int n = 0; n < 2; ++n) _Pragma("unroll") for (int k = 0; k < 2; ++k) \
        acc[ai][bj][m][n] = __builtin_amdgcn_mfma_f32_16x16x32_bf16(Bt[n][k], At[m][k], acc[ai][bj][m][n], 0, 0, 0); __builtin_amdgcn_s_setprio(0); } while (0)
#define PG8_WAIT_V(n) asm volatile("s_waitcnt vmcnt(" #n ")" ::: "memory")
#define PG8_WAIT_L(n) asm volatile("s_waitcnt lgkmcnt(" #n ")" ::: "memory")
#define PG8_BAR __builtin_amdgcn_s_barrier()
#define PG8_SCHED __builtin_amdgcn_sched_barrier(0)
    Unit cur, nxt; int ui = 0;
    if (!S.next(0, cur)) return;
    f32x4 acc[2][2][4][2];
#pragma unroll
    for (int a = 0; a < 2; ++a)
#pragma unroll
        for (int b = 0; b < 2; ++b)
#pragma unroll
            for (int m = 0; m < 4; ++m)
#pragma unroll
                for (int n = 0; n < 2; ++n) acc[a][b][m][n] = (f32x4){0.f, 0.f, 0.f, 0.f};
    bf16x8 At[4][2], B0[2][2], B1[2][2];
    const char* cA = (const char*)g.A + (size_t)cur.pm * tstep; const char* cB = (const char*)g.Bt + (size_t)cur.pn * tstep;
    S.a_ready(cur);
    if constexpr (SP2) {
        PG8_STAGE(PG8_SB(0, 0), cB, voffB); PG8_STAGE(PG8_SB(0, 1), cB + hstep, voffB); PG8_STAGE(PG8_SA(0, 0), cA, voffA); PG8_STAGE(PG8_SA(0, 1), cA + hstep, voffA);
        if (wr == 1) PG8_BAR;
        PG8_WAIT_V(2); PG8_BAR;
        PG8_STAGE(PG8_SB(1, 0), cB + kstep, voffB); PG8_STAGE(PG8_SA(1, 0), cA + kstep, voffA); PG8_STAGE(PG8_SB(1, 1), cB + hstep + kstep, voffB);
        PG8_WAIT_V(6); PG8_BAR;
    } else {
        PG8_STAGE(PG8_SB(0, 0), cB, voffB); PG8_STAGE(PG8_SA(0, 0), cA, voffA); PG8_STAGE(PG8_SB(0, 1), cB + hstep, voffB); PG8_STAGE(PG8_SA(0, 1), cA + hstep, voffA);
        if (wr == 1) PG8_BAR;
        PG8_WAIT_V(4); PG8_BAR;
        PG8_STAGE(PG8_SB(1, 0), cB + kstep, voffB); PG8_STAGE(PG8_SA(1, 0), cA + kstep, voffA); PG8_STAGE(PG8_SB(1, 1), cB + hstep + kstep, voffB);
        PG8_WAIT_V(6); PG8_BAR;
    }
    for (;;) {
        const bool has_next = S.next(ui + 1, nxt);
        const char* nA = has_next ? (const char*)g.A + (size_t)nxt.pm * tstep : cA; const char* nB = has_next ? (const char*)g.Bt + (size_t)nxt.pn * tstep : cB;
        for (int t = 0; t < nt; t += 2) {
            const bool last = (t == nt - 2);
            const char* a1 = cA + (size_t)(t + 1) * kstep;
            const char* a2 = last ? nA : cA + (size_t)(t + 2) * kstep; const char* b2 = last ? nB : cB + (size_t)(t + 2) * kstep;
            const char* a3 = a2 + kstep; const char* b3 = b2 + kstep;
            if (last && has_next) S.a_ready(nxt);
            if constexpr (SP2) {
            PG8_LDB(B0, 0, 0); PG8_LDB(B1, 0, 1); PG8_SCHED; PG8_LDA(At, 0, 0); PG8_STAGE(PG8_SA(1, 1), a1 + hstep, voffA);
            PG8_WAIT_V(8); PG8_WAIT_L(0); PG8_BAR; PG8_MMA(0, 0, At, B0); PG8_MMA(0, 1, At, B1); PG8_BAR; PG8_SCHED;
            PG8_LDA(At, 0, 1); PG8_STAGE(PG8_SB(0, 0), b2, voffB); PG8_STAGE(PG8_SB(0, 1), b2 + hstep, voffB); PG8_STAGE(PG8_SA(0, 0), a2, voffA);
            PG8_WAIT_V(8); PG8_WAIT_L(0); PG8_BAR; PG8_MMA(1, 0, At, B0); PG8_MMA(1, 1, At, B1); PG8_BAR; PG8_SCHED;
            PG8_LDB(B0, 1, 0); PG8_LDB(B1, 1, 1); PG8_SCHED; PG8_LDA(At, 1, 0); PG8_STAGE(PG8_SA(0, 1), a2 + hstep, voffA);
            PG8_WAIT_V(8); PG8_WAIT_L(0); PG8_BAR; PG8_MMA(0, 0, At, B0); PG8_MMA(0, 1, At, B1); PG8_BAR; PG8_SCHED;
            PG8_LDA(At, 1, 1); PG8_STAGE(PG8_SB(1, 0), b3, voffB); PG8_STAGE(PG8_SB(1, 1), b3 + hstep, voffB); PG8_STAGE(PG8_SA(1, 0), a3, voffA);
            PG8_WAIT_V(8); PG8_WAIT_L(0); PG8_BAR; PG8_MMA(1, 0, At, B0); PG8_MMA(1, 1, At, B1); PG8_BAR; PG8_SCHED;
            } else {
            PG8_LDB(B0, 0, 0); PG8_SCHED; PG8_LDA(At, 0, 0); PG8_STAGE(PG8_SA(1, 1), a1 + hstep, voffA);
            PG8_WAIT_L(8); PG8_BAR; PG8_WAIT_L(0); PG8_MMA(0, 0, At, B0); PG8_BAR; PG8_SCHED;
            PG8_LDB(B1, 0, 1); PG8_STAGE(PG8_SB(0, 0), b2, voffB);
            PG8_BAR; PG8_WAIT_L(0); PG8_MMA(0, 1, At, B1); PG8_BAR;
            PG8_LDA(At, 0, 1); PG8_STAGE(PG8_SA(0, 0), a2, voffA);
            PG8_BAR; PG8_WAIT_L(0); PG8_MMA(1, 0, At, B0); PG8_BAR; PG8_SCHED;
            PG8_STAGE(PG8_SB(0, 1), b2 + hstep, voffB);
            PG8_WAIT_V(6); PG8_BAR; PG8_MMA(1, 1, At, B1); PG8_BAR;
            PG8_LDB(B0, 1, 0); PG8_SCHED; PG8_LDA(At, 1, 0); PG8_STAGE(PG8_SA(0, 1), a2 + hstep, voffA);
            PG8_WAIT_L(8); PG8_BAR; PG8_WAIT_L(0); PG8_MMA(0, 0, At, B0); PG8_BAR; PG8_SCHED;
            PG8_LDB(B1, 1, 1); PG8_STAGE(PG8_SB(1, 0), b3, voffB);
            PG8_BAR; PG8_WAIT_L(0); PG8_MMA(0, 1, At, B1); PG8_BAR;
            PG8_LDA(At, 1, 1); PG8_STAGE(PG8_SA(1, 0), a3, voffA);
            PG8_BAR; PG8_WAIT_L(0); PG8_MMA(1, 0, At, B0); PG8_BAR; PG8_SCHED;
            PG8_STAGE(PG8_SB(1, 1), b3 + hstep, voffB);
            PG8_WAIT_V(6); PG8_BAR; PG8_MMA(1, 1, At, B1); PG8_BAR;
            }
        }
        if constexpr (ALIGN_EPI) { if (wr == 0) PG8_BAR; }
        if constexpr (!Epi::AFTER_DRAIN) { E(acc, cur, wr, wc, fr, fq); S.done(cur); }
        if (!has_next) break;
#pragma unroll
        for (int a = 0; a < 2; ++a)
#pragma unroll
            for (int b = 0; b < 2; ++b)
#pragma unroll
                for (int m = 0; m < 4; ++m)
#pragma unroll
                    for (int n = 0; n < 2; ++n) acc[a][b][m][n] = (f32x4){0.f, 0.f, 0.f, 0.f};
        cur = nxt; cA = nA; cB = nB; ++ui;
        if constexpr (ALIGN_EPI) { if (wr == 1) PG8_BAR; }
    }
    PG8_WAIT_V(0);
    if constexpr (!ALIGN_EPI) { if (wr == 0) PG8_BAR; }
    PG8_BAR;
    if constexpr (Epi::AFTER_DRAIN) { E.fused(acc, cur, wr, wc, fr, fq, lds, wid, lane); S.done(cur); }
#undef PG8_SA
#undef PG8_SB
#undef PG8_STAGE
#undef PG8_LDA
#undef PG8_LDB
#undef PG8_MMA
#undef PG8_WAIT_V
#undef PG8_WAIT_L
#undef PG8_BAR
#undef PG8_SCHED
}
}
#define GAS __attribute__((address_space(1)))
#define LAS __attribute__((address_space(3)))
typedef unsigned short bf16;
typedef unsigned v4u __attribute__((ext_vector_type(4)));
typedef float f32x4 __attribute__((ext_vector_type(4)));
typedef short bf16x8 __attribute__((ext_vector_type(8)));
typedef GAS unsigned gu32;
typedef GAS unsigned long long gu64;
#define RLX_AGENT __ATOMIC_RELAXED, __HIP_MEMORY_SCOPE_AGENT
#define LDS_WAIT() asm volatile("s_waitcnt lgkmcnt(0)" ::: "memory")
#define VM_WAIT() asm volatile("s_waitcnt vmcnt(0)" ::: "memory")
__device__ __forceinline__ unsigned long long rt() { return __builtin_amdgcn_s_memrealtime(); }
__device__ __forceinline__ unsigned f2bf(float f) { unsigned u = __builtin_bit_cast(unsigned, f); return (u + 0x7fffu + ((u >> 16) & 1u)) >> 16; }
__device__ __forceinline__ unsigned pk2(float lo, float hi) { return f2bf(lo) | (f2bf(hi) << 16); }

#define XB_TMO      128
#define XB_XCNT(j)  (256  + 64 * (j))
#define XB_XSUB(j)  (1280 + 64 * (j))
#define XB_XGEN(j)  (2304 + 64 * (j))
#define XB_TOP      3328
#define XB_TOPGEN   3392
#define XCD_BAR_WORDS 3456
#define XB_SPIN_CAP (1u << 18)

__device__ __forceinline__ unsigned xb_ld(unsigned* p)              { return __hip_atomic_load(p, __ATOMIC_RELAXED, __HIP_MEMORY_SCOPE_AGENT); }
__device__ __forceinline__ unsigned xb_add(unsigned* p, unsigned v) { return __hip_atomic_fetch_add(p, v, __ATOMIC_RELAXED, __HIP_MEMORY_SCOPE_AGENT); }
__device__ __forceinline__ unsigned xb_xcc_id() { return (unsigned)__builtin_amdgcn_s_getreg((3 << 11) | 20) & 0xFu; }
#define XB_SPIN(cond, bar) do { unsigned _sp = 0; while (cond) { __builtin_amdgcn_s_sleep(1); \
    if ((++_sp & 255u) == 0u) { if (xb_ld(&(bar)[XB_TMO])) break; if (_sp > XB_SPIN_CAP) { atomicAdd(&(bar)[XB_TMO], 1u); break; } } } } while (0)

struct XcdBarrier {
    unsigned* bar; unsigned x;
    volatile LAS unsigned* st;
};

__device__ __forceinline__ XcdBarrier xcd_barrier_post(unsigned* bar, volatile LAS unsigned* st) {
    XcdBarrier b; b.bar = bar; b.x = xb_xcc_id(); b.st = st;
    if (threadIdx.x == 0) (void)xb_add(&bar[XB_XCNT(b.x)], 1u);
    return b;
}
__device__ __forceinline__ void xcd_barrier_complete(unsigned* bar, unsigned x, unsigned& nloc, unsigned& nx) {
    const unsigned G = gridDim.x * gridDim.y * gridDim.z;
    unsigned sum, cnt, mine, sp = 0u;
    for (;;) {
        sum = 0u; cnt = 0u; mine = 0u;
#pragma unroll
        for (unsigned j = 0; j < 16; ++j) { const unsigned c = xb_ld(&bar[XB_XCNT(j)]); sum += c; cnt += (c > 0u) ? 1u : 0u; mine = (j == x) ? c : mine; }
        if (sum == G) break;
        __builtin_amdgcn_s_sleep(1);
        if ((++sp & 255u) == 0u) { if (xb_ld(&bar[XB_TMO])) break; if (sp > XB_SPIN_CAP) { atomicAdd(&bar[XB_TMO], 1u); break; } }
    }
    nloc = mine > 0u ? mine : 1u; nx = cnt > 0u ? cnt : 1u;
}

__device__ __forceinline__ void xcd_barrier(const XcdBarrier& b) {
    asm volatile("s_waitcnt vmcnt(0)" ::: "memory");
    __syncthreads();
    if (threadIdx.x == 0) {
        unsigned* bar = b.bar;
        __builtin_amdgcn_s_waitcnt(0);
        unsigned nloc = b.st[0], nx = b.st[1];
        if (nloc == 0u) { xcd_barrier_complete(bar, b.x, nloc, nx); b.st[0] = nloc; b.st[1] = nx; }
        const unsigned old = xb_add(&bar[XB_XSUB(b.x)], 1u);
        const unsigned gen = old / nloc;
        if (old + 1u == (gen + 1u) * nloc) {
            __builtin_amdgcn_fence(__ATOMIC_RELEASE, "agent");
            asm volatile("s_waitcnt vmcnt(0)" ::: "memory");
            const unsigned og = xb_add(&bar[XB_TOP], 1u);
            const unsigned tg = og / nx;
            if (og + 1u == (tg + 1u) * nx) xb_add(&bar[XB_TOPGEN], 1u);
            else XB_SPIN(xb_ld(&bar[XB_TOPGEN]) == tg, bar);
            __builtin_amdgcn_fence(__ATOMIC_ACQUIRE, "agent");
            xb_add(&bar[XB_XGEN(b.x)], 1u);
            asm volatile("s_waitcnt vmcnt(0)" ::: "memory");
        } else {
            XB_SPIN(xb_ld(&bar[XB_XGEN(b.x)]) == gen, bar);
            __builtin_amdgcn_fence(__ATOMIC_ACQUIRE, "agent");
            asm volatile("s_waitcnt vmcnt(0)" ::: "memory");
        }
    }
    __syncthreads();
}
constexpr int DM = 2048, R_CTX = 4096, R_LAT = 8192, RT = 12288, FF = 5632, NGU = 11264, DIN = 12288, HD = 128;
constexpr int NWAVES = 8, NTHR = 512;
constexpr float EPS_N = 1e-6f, SM_SCALE = 0.08838834764831845f;
constexpr size_t MiB = 1u << 20;
constexpr size_t WS_CTL = 0, CTL_ZERO_BYTES = 1 * MiB;
constexpr size_t WS_MODS = 1 * MiB;
constexpr size_t WS_ROPE = 2 * MiB;
constexpr size_t WS_CACHE = 4 * MiB;
constexpr size_t WS_W = 16 * MiB, W_LAYER = 200 * MiB;
constexpr size_t W_GU1 = 0, W_D1 = 44 * MiB, W_IN = 66 * MiB, W_B = 114 * MiB, W_O = 126 * MiB, W_GU2 = 134 * MiB, W_D2 = 178 * MiB;
constexpr size_t WS_H = 416 * MiB;
constexpr size_t WS_ACT = 464 * MiB;
constexpr size_t WS_Z = 596 * MiB;
constexpr size_t WS_QKVG = 884 * MiB;
constexpr size_t WS_END = 1172 * MiB;
constexpr int CW_BAR = 4096;
constexpr int EXCH_OFF = 131072, LDSCTL_OFF = 139264, MISC_OFF = LDSCTL_OFF + 320, LDS_BYTES = 147456;
constexpr size_t OUT_YP = 0, OUT_YS = 8388608, OUT_KGQA = 25165824, OUT_VGQA = 27262976, OUT_KNAT = 29360128, OUT_VNAT = 37748736, OUT_KWIN = 46137344, OUT_VWIN = 48234496, OUT_TOTAL = 50331648;

struct Args { const float* in[25]; float* out; unsigned char* ws; };

struct Frame {
    LAS unsigned char* lds;
    int tid, lane, wave, G;
    const float* in[25];
    float* out; unsigned char* ws;
};

__device__ __forceinline__ float wave_sum(float v) {
#pragma unroll
    for (int o = 1; o < 64; o <<= 1) v += __shfl_xor(v, o);
    return v;
}
__device__ __forceinline__ float bf2f(unsigned b) { return __uint_as_float(b << 16); }
__device__ __forceinline__ float bflo(unsigned w) { return __uint_as_float(w << 16); }
__device__ __forceinline__ float bfhi(unsigned w) { return __uint_as_float(w & 0xffff0000u); }
__device__ __forceinline__ float sigm(float x) { return 1.f / (1.f + __expf(-x)); }

__device__ __forceinline__ void transpose_item(const float* W, int K, int N, bf16* WT, LAS float* scr, int k0, int n0, int lane) {
#pragma unroll 4
    for (int i = 0; i < 16; ++i) {
        const int k = 4 * i + (lane >> 4), n4 = lane & 15;
        const f32x4 v = *(const GAS f32x4*)(W + (size_t)(k0 + k) * N + n0 + 4 * n4);
        LAS float* s = scr + k * 65 + 4 * n4; s[0] = v.x; s[1] = v.y; s[2] = v.z; s[3] = v.w;
    }
    LDS_WAIT(); asm volatile("" ::: "memory");
    const int c = lane & 7;
#pragma unroll
    for (int j = 0; j < 8; ++j) {
        const int n = 8 * j + (lane >> 3); const LAS float* s = scr + (8 * c) * 65 + n;
        v4u o; o.x = pk2(s[0], s[65]); o.y = pk2(s[130], s[195]); o.z = pk2(s[260], s[325]); o.w = pk2(s[390], s[455]);
        *(GAS v4u*)(WT + (size_t)(n0 + n) * K + k0 + 8 * c) = o;
    }
    LDS_WAIT(); asm volatile("" ::: "memory");
}
__device__ __forceinline__ void transpose_matrix(Frame& F, const float* W, int K, int N, bf16* WT) {
    LAS float* scr = (LAS float*)(F.lds + F.wave * 16640);
    const int gw = blockIdx.x * NWAVES + F.wave, NGW = F.G * NWAVES, nb = N / 64, items = (K / 64) * nb;
    for (int it = gw; it < items; it += NGW) transpose_item(W, K, N, WT, scr, 64 * (it / nb), 64 * (it % nb), F.lane);
}
__device__ __forceinline__ void cvt_array(Frame& F, const float* src, bf16* dst, int n8) {
    for (int i = blockIdx.x * NTHR + F.tid; i < n8; i += F.G * NTHR) {
        const f32x4 a = *(const GAS f32x4*)(src + (size_t)i * 8), b = *(const GAS f32x4*)(src + (size_t)i * 8 + 4);
        v4u o; o.x = pk2(a.x, a.y); o.y = pk2(a.z, a.w); o.z = pk2(b.x, b.y); o.w = pk2(b.z, b.w);
        *(GAS v4u*)(dst + (size_t)i * 8) = o;
    }
}
__device__ __forceinline__ void mods_phase(Frame& F) {
    LAS float* sv = (LAS float*)F.lds;
    LAS f32x4* red = (LAS f32x4*)(F.lds + 24576);
    const float* c_lat = F.in[8]; const float* c_ctx = F.in[9]; const float* w_mod = F.in[10]; const float* b_mod = F.in[11];
    float* mods = (float*)(F.ws + WS_MODS);
    for (int i = F.tid; i < 3 * 2048; i += NTHR) { const int g = i >> 11, k = i & 2047; const float c = (g == 0) ? c_ctx[k] : c_lat[(g - 1) * 2048 + k]; sv[i] = c / (1.f + __expf(-c)); }
    __syncthreads();
    for (int cb = blockIdx.x; cb < 256; cb += F.G) {
        const int l = cb >> 7, col0 = (cb & 127) * 144;
        if (F.tid < 504) {
            const int c4 = F.tid % 36, kg = F.tid / 36;
            const GAS f32x4* wp = (const GAS f32x4*)(w_mod + (size_t)l * 2048 * 18432 + col0 + 4 * c4);
            f32x4 a0 = {0.f, 0.f, 0.f, 0.f}, a1 = a0, a2 = a0;
#pragma unroll 4
            for (int k = kg; k < 2048; k += 14) { const f32x4 w = wp[(size_t)k * 4608]; a0 += sv[k] * w; a1 += sv[2048 + k] * w; a2 += sv[4096 + k] * w; }
            red[(kg * 3 + 0) * 36 + c4] = a0; red[(kg * 3 + 1) * 36 + c4] = a1; red[(kg * 3 + 2) * 36 + c4] = a2;
        }
        __syncthreads();
        if (F.tid < 108) {
            const int g = F.tid / 36, c4 = F.tid % 36; f32x4 s = *(const GAS f32x4*)(b_mod + (size_t)l * 18432 + col0 + 4 * c4);
            for (int kg = 0; kg < 14; ++kg) s += red[(kg * 3 + g) * 36 + c4];
            *(GAS f32x4*)(mods + (size_t)(l * 3 + g) * 18432 + col0 + 4 * c4) = s;
        }
        __syncthreads();
    }
}
__device__ __forceinline__ void prologue(Frame& F) {
    unsigned char* ws = F.ws;
    for (int l = 0; l < 2; ++l) {
        unsigned char* wl = ws + WS_W + (size_t)l * W_LAYER;
        transpose_matrix(F, F.in[13] + (size_t)l * DM * NGU, DM, NGU, (bf16*)(wl + W_GU1));
        transpose_matrix(F, F.in[14] + (size_t)l * FF * DM, FF, DM, (bf16*)(wl + W_D1));
        transpose_matrix(F, F.in[15] + (size_t)l * DM * DIN, DM, DIN, (bf16*)(wl + W_IN));
        for (int i = 0; i < 3; ++i) transpose_matrix(F, F.in[20] + (size_t)(l * 3 + i) * 1024 * DM, 1024, DM, (bf16*)(wl + W_B) + (size_t)i * DM * 1024);
        transpose_matrix(F, F.in[21] + (size_t)l * DM * DM, DM, DM, (bf16*)(wl + W_O));
        transpose_matrix(F, F.in[22] + (size_t)l * DM * NGU, DM, NGU, (bf16*)(wl + W_GU2));
        transpose_matrix(F, F.in[23] + (size_t)l * FF * DM, FF, DM, (bf16*)(wl + W_D2));
    }
    cvt_array(F, F.in[2], (bf16*)(ws + WS_CACHE), 524288 / 8);
    cvt_array(F, F.in[3], (bf16*)(ws + WS_CACHE + 1 * MiB), 524288 / 8);
    cvt_array(F, F.in[6], (bf16*)(ws + WS_CACHE + 2 * MiB), 524288 / 8);
    cvt_array(F, F.in[7], (bf16*)(ws + WS_CACHE + 3 * MiB), 524288 / 8);
    cvt_array(F, F.in[4], (bf16*)(ws + WS_CACHE + 4 * MiB), 2097152 / 8);
    cvt_array(F, F.in[5], (bf16*)(ws + WS_CACHE + 8 * MiB), 2097152 / 8);
    { float* ct = (float*)(ws + WS_ROPE); float* st = ct + 2048;
      for (int i = blockIdx.x * NTHR + F.tid; i < 2048; i += F.G * NTHR) { const int pos = i >> 5, f = i & 31;
          const float inv = exp2f(-(float)f * (13.287712379549449f / 32.0f)); const float ang = (float)pos * inv;
          const float kf = rintf(ang * 0.6366197723675814f); float r = fmaf(-kf, 1.5707962512969971f, ang); r = fmaf(-kf, 7.5497894158615964e-08f, r); r = fmaf(-kf, 5.3903029534742384e-15f, r);
          const float r2 = r * r;
          const float sn = r + r * r2 * (-1.6666667e-1f + r2 * (8.3333338e-3f + r2 * (-1.9841270e-4f + r2 * 2.7557319e-6f)));
          const float cs = 1.0f + r2 * (-0.5f + r2 * (4.1666668e-2f + r2 * (-1.3888889e-3f + r2 * (2.4801587e-5f + r2 * -2.7557319e-7f))));
          const int q = ((int)kf) & 3; const float sv_ = (q == 0) ? sn : (q == 1) ? cs : (q == 2) ? -sn : -cs, cv_ = (q == 0) ? cs : (q == 1) ? -sn : (q == 2) ? -cs : sn;
          ct[i] = cv_; st[i] = sv_; } }
    __syncthreads();
    mods_phase(F);
}

__device__ __forceinline__ void adaln_phase(Frame& F, int l, int which, bool from_inputs, const float* Y, float coef, int gate_l, int gate_chunk) {
    float* X = F.out; bf16* H = (bf16*)(F.ws + WS_H); const float* mods = (const float*)(F.ws + WS_MODS);
    const float* gn = F.in[12] + (size_t)(l * 3 + which) * DM;
    const int gw = blockIdx.x * NWAVES + F.wave, NGW = F.G * NWAVES, lane = F.lane;
    for (int row = gw; row < RT; row += NGW) {
        const int g = row < R_CTX ? 0 : 1 + ((row - R_CTX) >> 12);
        const float* src = from_inputs ? (row < R_CTX ? F.in[0] + (size_t)row * DM : F.in[1] + (size_t)(row - R_CTX) * DM) : X + (size_t)row * DM;
        f32x4 v[8];
#pragma unroll
        for (int j = 0; j < 8; ++j) v[j] = ((const GAS f32x4*)src)[64 * j + lane];
        if (Y) {
            const GAS f32x4* yr = (const GAS f32x4*)(Y + (size_t)row * DM); const GAS f32x4* gt = (const GAS f32x4*)(mods + (size_t)(gate_l * 3 + g) * 18432 + gate_chunk * DM);
#pragma unroll
            for (int j = 0; j < 8; ++j) v[j] += coef * gt[64 * j + lane] * yr[64 * j + lane];
        }
        if (Y || from_inputs) {
#pragma unroll
            for (int j = 0; j < 8; ++j) ((GAS f32x4*)(X + (size_t)row * DM))[64 * j + lane] = v[j];
        }
        float ss = 0.f;
#pragma unroll
        for (int j = 0; j < 8; ++j) ss += (v[j].x * v[j].x + v[j].y * v[j].y) + (v[j].z * v[j].z + v[j].w * v[j].w);
        const float rstd = 1.0f / sqrtf(wave_sum(ss) * (1.0f / DM) + EPS_N);
        const GAS f32x4* gnp = (const GAS f32x4*)gn; const float* mg = mods + (size_t)(l * 3 + g) * 18432 + (size_t)which * 3 * DM;
        const GAS f32x4* shp = (const GAS f32x4*)mg; const GAS f32x4* scp = (const GAS f32x4*)(mg + DM);
        GAS unsigned long long* o8 = (GAS unsigned long long*)(H + (size_t)row * DM);
#pragma unroll
        for (int j = 0; j < 8; ++j) {
            const f32x4 a = gnp[64 * j + lane] * (1.0f + scp[64 * j + lane]) * rstd, b = shp[64 * j + lane]; const f32x4 h = v[j] * a + b;
            o8[64 * j + lane] = (unsigned long long)pk2(h.x, h.y) | ((unsigned long long)pk2(h.z, h.w) << 32);
        }
    }
}
__device__ __forceinline__ void final_phase(Frame& F, const float* Y, float coef, int gate_l, int gate_chunk) {
    float* X = F.out; const float* mods = (const float*)(F.ws + WS_MODS); const GAS f32x4* gf = (const GAS f32x4*)F.in[24];
    const int gw = blockIdx.x * NWAVES + F.wave, NGW = F.G * NWAVES, lane = F.lane;
    for (int row = gw; row < RT; row += NGW) {
        const int g = row < R_CTX ? 0 : 1 + ((row - R_CTX) >> 12);
        GAS f32x4* xr = (GAS f32x4*)(X + (size_t)row * DM);
        f32x4 v[8];
#pragma unroll
        for (int j = 0; j < 8; ++j) v[j] = xr[64 * j + lane];
        if (Y) {
            const GAS f32x4* yr = (const GAS f32x4*)(Y + (size_t)row * DM); const GAS f32x4* gt = (const GAS f32x4*)(mods + (size_t)(gate_l * 3 + g) * 18432 + gate_chunk * DM);
#pragma unroll
            for (int j = 0; j < 8; ++j) v[j] += coef * gt[64 * j + lane] * yr[64 * j + lane];
        }
        float ss = 0.f;
#pragma unroll
        for (int j = 0; j < 8; ++j) ss += (v[j].x * v[j].x + v[j].y * v[j].y) + (v[j].z * v[j].z + v[j].w * v[j].w);
        const float rstd = 1.0f / sqrtf(wave_sum(ss) * (1.0f / DM) + EPS_N);
#pragma unroll
        for (int j = 0; j < 8; ++j) xr[64 * j + lane] = v[j] * rstd * gf[64 * j + lane];
    }
}
__device__ __forceinline__ void swiglu_phase(Frame& F) {
    const bf16* Z = (const bf16*)(F.ws + WS_Z); bf16* A = (bf16*)(F.ws + WS_ACT);
    const int total = RT * (FF / 8);
    for (int i = blockIdx.x * NTHR + F.tid; i < total; i += F.G * NTHR) {
        const int row = i / (FF / 8), c8 = i % (FF / 8);
        const v4u a = *(const GAS v4u*)(Z + (size_t)row * NGU + 8 * c8), b = *(const GAS v4u*)(Z + (size_t)row * NGU + FF + 8 * c8);
        v4u o;
#pragma unroll
        for (int q = 0; q < 4; ++q) { const float a0 = bflo(a[q]), a1 = bfhi(a[q]), b0 = bflo(b[q]), b1 = bfhi(b[q]);
            o[q] = pk2(a0 / (1.f + __expf(-a0)) * b0, a1 / (1.f + __expf(-a1)) * b1); }
        *(GAS v4u*)(A + (size_t)row * FF + 8 * c8) = o;
    }
}
__device__ __forceinline__ void post_phase(Frame& F, int l) {
    const bf16* Z = (const bf16*)(F.ws + WS_Z); unsigned char* qb = F.ws + WS_QKVG;
    bf16* QA = (bf16*)qb; bf16* QB = (bf16*)(qb + 24 * MiB); bf16* QC = (bf16*)(qb + 48 * MiB); bf16* KB = (bf16*)(qb + 72 * MiB); bf16* VB = (bf16*)(qb + 96 * MiB);
    bf16* KA = (bf16*)(qb + 120 * MiB); bf16* VA = (bf16*)(qb + 126 * MiB); bf16* KC = (bf16*)(qb + 132 * MiB); bf16* VC = (bf16*)(qb + 138 * MiB); bf16* GT = (bf16*)(qb + 144 * MiB);
    const float* gq = F.in[16] + l * HD; const float* gk = F.in[17] + l * HD;
    const float* ct = (const float*)(F.ws + WS_ROPE); const float* st = ct + 2048;
    const int gw = blockIdx.x * NWAVES + F.wave, NGW = F.G * NWAVES, lane = F.lane;
    for (int row = gw; row < RT; row += NGW) {
        const bool isctx = row < R_CTX; const int n = (row - R_CTX) & 4095, rpos = n >> 6, cpos = n & 63, fi = lane & 31;
        const float c0 = ct[rpos * 32 + fi], s0 = st[rpos * 32 + fi], c1 = ct[cpos * 32 + fi], s1 = st[cpos * 32 + fi];
        const bf16* z = Z + (size_t)row * DIN;
        const int cb = row >> 8, tt = row & 255;
        for (int s = 0; s < 48; ++s) {
            float v0 = bf2f(z[s * 128 + lane]), v1 = bf2f(z[s * 128 + 64 + lane]);
            if (s < 10) { const float ss = wave_sum(v0 * v0 + v1 * v1); const float rstd = 1.0f / sqrtf(ss * (1.0f / HD) + EPS_N); const float* gg = s < 8 ? gq : gk;
                v0 *= rstd * gg[lane]; v1 *= rstd * gg[64 + lane]; }
            const bool rope = (s < 10) || (s >= 36 && s < 46);
            if (rope && !isctx) { const float p0 = __shfl_xor(v0, 32), p1 = __shfl_xor(v1, 32);
                if (lane < 32) { v0 = v0 * c0 - p0 * s0; v1 = v1 * c1 - p1 * s1; } else { v0 = v0 * c0 + p0 * s0; v1 = v1 * c1 + p1 * s1; } }
            bf16* dst; float* fo = nullptr;
            if (s < 8) dst = QA + (size_t)row * 1024 + s * 128;
            else if (s < 10) { dst = KA + (size_t)row * 256 + (s - 8) * 128; fo = F.out + OUT_KGQA + ((size_t)(cb * 2 + l) * 256 + tt) * 256 + (s - 8) * 128; }
            else if (s < 12) { dst = VA + (size_t)row * 256 + (s - 10) * 128; fo = F.out + OUT_VGQA + ((size_t)(cb * 2 + l) * 256 + tt) * 256 + (s - 10) * 128; }
            else if (s < 20) dst = QB + (size_t)row * 1024 + (s - 12) * 128;
            else if (s < 28) { dst = KB + (size_t)row * 1024 + (s - 20) * 128; fo = F.out + OUT_KNAT + ((size_t)(cb * 2 + l) * 256 + tt) * 1024 + (s - 20) * 128; }
            else if (s < 36) { dst = VB + (size_t)row * 1024 + (s - 28) * 128; fo = F.out + OUT_VNAT + ((size_t)(cb * 2 + l) * 256 + tt) * 1024 + (s - 28) * 128; }
            else if (s < 44) dst = QC + (size_t)row * 1024 + (s - 36) * 128;
            else if (s < 46) { dst = KC + (size_t)row * 256 + (s - 44) * 128; fo = F.out + OUT_KWIN + ((size_t)(cb * 2 + l) * 256 + tt) * 256 + (s - 44) * 128; }
            else { dst = VC + (size_t)row * 256 + (s - 46) * 128; fo = F.out + OUT_VWIN + ((size_t)(cb * 2 + l) * 256 + tt) * 256 + (s - 46) * 128; }
            dst[lane] = (bf16)f2bf(v0); dst[64 + lane] = (bf16)f2bf(v1);
            if (fo && isctx) { fo[lane] = v0; fo[64 + lane] = v1; }
        }
#pragma unroll 4
        for (int j = 0; j < 12; ++j) {
            const v4u a = *(const GAS v4u*)(z + 6144 + (j * 64 + lane) * 8); v4u o;
#pragma unroll
            for (int q = 0; q < 4; ++q) o[q] = pk2(sigm(bflo(a[q])), sigm(bfhi(a[q])));
            *(GAS v4u*)(GT + (size_t)row * 6144 + (j * 64 + lane) * 8) = o;
        }
    }
}
__device__ __forceinline__ void combine_phase(Frame& F) {
    const float* Y3 = (const float*)(F.ws + WS_Z); const bf16* GT = (const bf16*)(F.ws + WS_QKVG + 144 * MiB); bf16* Mb = (bf16*)(F.ws + WS_H);
    const int total = RT * (DM / 4);
    for (int i = blockIdx.x * NTHR + F.tid; i < total; i += F.G * NTHR) {
        const int row = i >> 9, c4 = i & 511; f32x4 m = {0.f, 0.f, 0.f, 0.f};
#pragma unroll
        for (int b = 0; b < 3; ++b) {
            const f32x4 y = *(const GAS f32x4*)(Y3 + (size_t)b * RT * DM + (size_t)row * DM + 4 * c4);
            const unsigned long long gg = *(const GAS unsigned long long*)(GT + (size_t)row * 6144 + b * DM + 4 * c4);
            const unsigned g0 = (unsigned)gg, g1 = (unsigned)(gg >> 32);
            m.x += bflo(g0) * y.x; m.y += bfhi(g0) * y.y; m.z += bflo(g1) * y.z; m.w += bfhi(g1) * y.w;
        }
        *(GAS unsigned long long*)(Mb + (size_t)row * DM + 4 * c4) = (unsigned long long)pk2(m.x, m.y) | ((unsigned long long)pk2(m.z, m.w) << 32);
    }
}

struct SoftState { float m, l, o0, o1; };
__device__ __forceinline__ void att_key(SoftState& S, float q0, float q1, const bf16* kp, const bf16* vp, float bias, int lane) {
    const unsigned kk = *(const GAS unsigned*)(kp + 2 * lane), vv = *(const GAS unsigned*)(vp + 2 * lane);
    const float s = wave_sum(q0 * bflo(kk) + q1 * bfhi(kk)) * SM_SCALE + bias;
    const float mn = fmaxf(S.m, s), al = __expf(S.m - mn), p = __expf(s - mn);
    S.l = S.l * al + p; S.o0 = S.o0 * al + p * bflo(vv); S.o1 = S.o1 * al + p * bfhi(vv); S.m = mn;
}
__device__ __forceinline__ void attn_naive_phase(Frame& F, int l) {
    unsigned char* qb = F.ws + WS_QKVG;
    const bf16* QA = (const bf16*)qb; const bf16* QB = (const bf16*)(qb + 24 * MiB); const bf16* QC = (const bf16*)(qb + 48 * MiB); const bf16* KB = (const bf16*)(qb + 72 * MiB); const bf16* VB = (const bf16*)(qb + 96 * MiB);
    const bf16* KA = (const bf16*)(qb + 120 * MiB); const bf16* VA = (const bf16*)(qb + 126 * MiB); const bf16* KC = (const bf16*)(qb + 132 * MiB); const bf16* VC = (const bf16*)(qb + 138 * MiB);
    const bf16* CKA = (const bf16*)(F.ws + WS_CACHE); const bf16* CVA = (const bf16*)(F.ws + WS_CACHE + 1 * MiB); const bf16* CKC = (const bf16*)(F.ws + WS_CACHE + 2 * MiB); const bf16* CVC = (const bf16*)(F.ws + WS_CACHE + 3 * MiB);
    const bf16* CKB = (const bf16*)(F.ws + WS_CACHE + 4 * MiB); const bf16* CVB = (const bf16*)(F.ws + WS_CACHE + 8 * MiB);
    bf16* O = (bf16*)(F.ws + WS_ACT);
    const float* rpb = F.in[18]; const float* sink = F.in[19];
    const int gw = blockIdx.x * NWAVES + F.wave, NGW = F.G * NWAVES, lane = F.lane;
    for (int it = gw; it < RT * 24; it += NGW) {
        const int row = it / 24, bh = it % 24, br = bh >> 3, h = bh & 7;
        const bf16* Qp = (br == 0 ? QA : br == 1 ? QB : QC) + (size_t)row * 1024 + h * 128;
        const unsigned qq = *(const GAS unsigned*)(Qp + 2 * lane); const float q0 = bflo(qq), q1 = bfhi(qq);
        const int kvh = br == 1 ? h : (h >> 2), kvw = br == 1 ? 1024 : 256;
        const bf16* Kl = (br == 0 ? KA : br == 1 ? KB : KC) + kvh * 128; const bf16* Vl = (br == 0 ? VA : br == 1 ? VB : VC) + kvh * 128;
        SoftState S; S.m = -1e30f; S.l = 0.f; S.o0 = 0.f; S.o1 = 0.f;
        if (row < R_CTX) {
            const int base = row & ~255;
#pragma unroll 4
            for (int j = 0; j < 256; ++j) att_key(S, q0, q1, Kl + (size_t)(base + j) * kvw, Vl + (size_t)(base + j) * kvw, 0.f, lane);
        } else {
            const int b = (row - R_CTX) >> 12, n = (row - R_CTX) & 4095, lat0 = R_CTX + b * 4096;
            const bf16* Ck = (br == 0 ? CKA : br == 1 ? CKB : CKC) + (size_t)(b * 2 + l) * 512 * kvw + kvh * 128;
            const bf16* Cv = (br == 0 ? CVA : br == 1 ? CVB : CVC) + (size_t)(b * 2 + l) * 512 * kvw + kvh * 128;
#pragma unroll 4
            for (int j = 0; j < 512; ++j) att_key(S, q0, q1, Ck + (size_t)j * kvw, Cv + (size_t)j * kvw, 0.f, lane);
            if (br == 0) {
#pragma unroll 4
                for (int j = 0; j < 4096; ++j) att_key(S, q0, q1, Kl + (size_t)(lat0 + j) * kvw, Vl + (size_t)(lat0 + j) * kvw, 0.f, lane);
            } else if (br == 1) {
                const int r = n >> 6, c = n & 63; const int rs = min(max(r - 4, 0), 56), cs = min(max(c - 8, 0), 48);
                const float* rp = rpb + (size_t)(l * 8 + h) * 15 * 31;
                for (int dr = 0; dr < 8; ++dr)
#pragma unroll 4
                    for (int dc = 0; dc < 16; ++dc) { const int kn = (rs + dr) * 64 + cs + dc; const float bias = rp[(rs + dr - r + 7) * 31 + (cs + dc - c + 15)];
                        att_key(S, q0, q1, Kl + (size_t)(lat0 + kn) * kvw, Vl + (size_t)(lat0 + kn) * kvw, bias, lane); }
            } else {
                const int j0 = max(n - 128, 0), j1 = min(n + 128, 4095);
#pragma unroll 4
                for (int j = j0; j <= j1; ++j) att_key(S, q0, q1, Kl + (size_t)(lat0 + j) * kvw, Vl + (size_t)(lat0 + j) * kvw, 0.f, lane);
            }
        }
        if (br == 2) { const float s = sink[l * 8 + h]; const float mn = fmaxf(S.m, s), al = __expf(S.m - mn); S.l = S.l * al + __expf(s - mn); S.o0 *= al; S.o1 *= al; }
        const float rl = 1.0f / S.l;
        *(GAS unsigned*)(O + (size_t)br * RT * 1024 + (size_t)row * 1024 + h * 128 + 2 * lane) = pk2(S.o0 * rl, S.o1 * rl);
    }
}

namespace pg8 {
struct EpiF32 {
    static constexpr bool PERM = false, AFTER_DRAIN = false;
    float* C; int ldc;
    __device__ __forceinline__ void operator()(const f32x4 (&acc)[2][2][4][2], const Unit& u, int wr, int wc, int fr, int fq) const {
        const int row0 = u.pm * BM + wr * 64 + fr, col0 = u.pn * BM + wc * 32 + 4 * fq;
#pragma unroll
        for (int ai = 0; ai < 2; ++ai)
#pragma unroll
            for (int m = 0; m < 4; ++m) { float* rowp = C + (size_t)(row0 + ai * HALF + m * 16) * ldc + col0;
#pragma unroll
                for (int bj = 0; bj < 2; ++bj)
#pragma unroll
                    for (int n = 0; n < 2; ++n) *(f32x4*)(rowp + bj * HALF + n * 16) = acc[ai][bj][m][n]; }
    }
};
struct BranchOrder {
    int G, c;
    __device__ __forceinline__ bool next(int i, Unit& u) const { const int j = i / 3, br = i - 3 * j; const int tile = j * G + c; if (tile >= 384) return false;
        u.pm = br * 48 + (tile >> 3); u.pn = br * 8 + (tile & 7); return true; }
    __device__ __forceinline__ void a_ready(const Unit&) const {}
    __device__ __forceinline__ void done(const Unit&) const {}
};
struct EpiBranchF32 {
    static constexpr bool PERM = false, AFTER_DRAIN = false;
    float* Y3;
    __device__ __forceinline__ void operator()(const f32x4 (&acc)[2][2][4][2], const Unit& u, int wr, int wc, int fr, int fq) const {
        const int br = u.pm / 48, pm = u.pm - 48 * br, pn = u.pn & 7;
        const int row0 = pm * BM + wr * 64 + fr, col0 = pn * BM + wc * 32 + 4 * fq; float* base = Y3 + (size_t)br * 12288 * 2048;
#pragma unroll
        for (int ai = 0; ai < 2; ++ai)
#pragma unroll
            for (int m = 0; m < 4; ++m) { float* rowp = base + (size_t)(row0 + ai * HALF + m * 16) * 2048 + col0;
#pragma unroll
                for (int bj = 0; bj < 2; ++bj)
#pragma unroll
                    for (int n = 0; n < 2; ++n) *(f32x4*)(rowp + bj * HALF + n * 16) = acc[ai][bj][m][n]; }
    }
};
}

__global__ void __launch_bounds__(NTHR, 2) mega_fwd(Args args) {
    extern __shared__ __attribute__((aligned(16))) unsigned char lds[];
    Frame F;
    F.lds = (LAS unsigned char*)lds; F.tid = threadIdx.x; F.lane = F.tid & 63; F.wave = __builtin_amdgcn_readfirstlane(F.tid >> 6); F.G = gridDim.x;
    _Pragma("unroll") for (int i_ = 0; i_ < 25; ++i_) F.in[i_] = args.in[i_]; F.out = args.out; F.ws = args.ws;
    for (int u = F.tid; u < (LDS_BYTES - LDSCTL_OFF) / 4; u += NTHR) ((LAS unsigned*)(F.lds + LDSCTL_OFF))[u] = 0u;
    __syncthreads();
    volatile LAS unsigned* MISC = (volatile LAS unsigned*)(F.lds + MISC_OFF);
    XcdBarrier bar = xcd_barrier_post((unsigned*)(F.ws + WS_CTL) + CW_BAR, MISC + 8);
#define GRID_BAR() do { xcd_barrier(bar); F.tid = threadIdx.x; asm volatile("" : "+v"(F.tid)); F.lane = F.tid & 63; } while (0)
    unsigned char* ws = F.ws;
    bf16* H = (bf16*)(ws + WS_H); bf16* ACT = (bf16*)(ws + WS_ACT); bf16* Zb = (bf16*)(ws + WS_Z); float* Y = (float*)(ws + WS_Z);

    prologue(F); GRID_BAR();

    for (int l = 0; l < 2; ++l) {
        unsigned char* wl = ws + WS_W + (size_t)l * W_LAYER;
        adaln_phase(F, l, 0, l == 0, l == 0 ? nullptr : Y, 0.5f, l - 1, 8); GRID_BAR();
        { pg8::Gemm g{H, (const bf16*)(wl + W_GU1), RT, NGU, DM}; pg8::StaticOrder S; S.init(RT, NGU, F.G, (int)blockIdx.x);
          pg8::EpiBf16<0> E{Zb, NGU, nullptr, 0, 0, 1.f};
          pg8::gemm_phase<pg8::EpiBf16<0>, pg8::StaticOrder, true, true>(F.lds, g, S, E); }
        GRID_BAR();
        swiglu_phase(F); GRID_BAR();
        { pg8::Gemm g{ACT, (const bf16*)(wl + W_D1), RT, DM, FF}; pg8::StaticOrder S; S.init(RT, DM, F.G, (int)blockIdx.x);
          pg8::EpiF32 E{Y, DM};
          pg8::gemm_phase<pg8::EpiF32, pg8::StaticOrder, true, true>(F.lds, g, S, E); }
        GRID_BAR();
        adaln_phase(F, l, 1, false, Y, 0.5f, l, 2); GRID_BAR();
        { pg8::Gemm g{H, (const bf16*)(wl + W_IN), RT, DIN, DM}; pg8::StaticOrder S; S.init(RT, DIN, F.G, (int)blockIdx.x);
          pg8::EpiBf16<0> E{Zb, DIN, nullptr, 0, 0, 1.f};
          pg8::gemm_phase<pg8::EpiBf16<0>, pg8::StaticOrder, true, true>(F.lds, g, S, E); }
        GRID_BAR();
        post_phase(F, l); GRID_BAR();
        attn_naive_phase(F, l); GRID_BAR();
        { pg8::Gemm g{ACT  , (const bf16*)(wl + W_B), 3 * RT, 3 * DM, 1024}; pg8::BranchOrder S{F.G, (int)blockIdx.x};
          pg8::EpiBranchF32 E{Y};
          pg8::gemm_phase<pg8::EpiBranchF32, pg8::BranchOrder, true, true>(F.lds, g, S, E); }
        GRID_BAR();
        combine_phase(F); GRID_BAR();
        { pg8::Gemm g{H  , (const bf16*)(wl + W_O), RT, DM, DM}; pg8::StaticOrder S; S.init(RT, DM, F.G, (int)blockIdx.x);
          pg8::EpiF32 E{Y, DM};
          pg8::gemm_phase<pg8::EpiF32, pg8::StaticOrder, true, true>(F.lds, g, S, E); }
        GRID_BAR();
        adaln_phase(F, l, 2, false, Y, 1.0f, l, 5); GRID_BAR();
        { pg8::Gemm g{H, (const bf16*)(wl + W_GU2), RT, NGU, DM}; pg8::StaticOrder S; S.init(RT, NGU, F.G, (int)blockIdx.x);
          pg8::EpiBf16<0> E{Zb, NGU, nullptr, 0, 0, 1.f};
          pg8::gemm_phase<pg8::EpiBf16<0>, pg8::StaticOrder, true, true>(F.lds, g, S, E); }
        GRID_BAR();
        swiglu_phase(F); GRID_BAR();
        { pg8::Gemm g{ACT, (const bf16*)(wl + W_D2), RT, DM, FF}; pg8::StaticOrder S; S.init(RT, DM, F.G, (int)blockIdx.x);
          pg8::EpiF32 E{Y, DM};
          pg8::gemm_phase<pg8::EpiF32, pg8::StaticOrder, true, true>(F.lds, g, S, E); }
        GRID_BAR();
    }
    final_phase(F, Y, 0.5f, 1, 8);
#undef GRID_BAR
}

extern "C" void kernel_launch(void* const* d_in, const int* in_sizes, int n_in, void* d_out, int out_size, void* d_ws, size_t ws_size, hipStream_t stream) {
    static int grid = 0;
    if (grid == 0) {
        if (n_in != 25 || out_size != (int)OUT_TOTAL || ws_size < WS_END) { fprintf(stderr, "kernel_launch: unexpected shapes: n_in %d out %d ws %zu (need %zu)\n", n_in, out_size, ws_size, (size_t)WS_END); grid = -1; return; }
        int dev = 0, cus = 0, per_cu = 0;
        if (hipGetDevice(&dev) != hipSuccess || hipDeviceGetAttribute(&cus, hipDeviceAttributeMultiprocessorCount, dev) != hipSuccess) { grid = -1; return; }
        if (hipFuncSetAttribute((const void*)mega_fwd, hipFuncAttributeMaxDynamicSharedMemorySize, LDS_BYTES) != hipSuccess) { fprintf(stderr, "kernel_launch: hipFuncSetAttribute failed\n"); grid = -1; return; }
        if (hipOccupancyMaxActiveBlocksPerMultiprocessor(&per_cu, (const void*)mega_fwd, NTHR, LDS_BYTES) != hipSuccess || per_cu < 1) { fprintf(stderr, "kernel_launch: occupancy query says %d\n", per_cu); (void)hipGetLastError(); grid = -1; return; }
        grid = cus;
    }
    if (grid < 0) return;
    if (hipMemsetAsync((char*)d_ws + WS_CTL, 0, CTL_ZERO_BYTES, stream) != hipSuccess) return;
    Args a{};
    for (int i = 0; i < 25; ++i) a.in[i] = (const float*)d_in[i];
    a.out = (float*)d_out; a.ws = (unsigned char*)d_ws;
    hipLaunchKernelGGL(mega_fwd, dim3(grid), dim3(NTHR), LDS_BYTES, stream, a);
}
```

```cpp
#include <hip/hip_runtime.h>
#include <cstdio>
#include <cstdint>
namespace pg8 {
#define PG8_LAS __attribute__((address_space(3)))
typedef unsigned short bf16_t;
typedef short bf16x8 __attribute__((ext_vector_type(8)));
typedef float f32x4 __attribute__((ext_vector_type(4)));
typedef unsigned u32x4 __attribute__((ext_vector_type(4)));
constexpr int BM = 256, BK = 64, HALF = 128, HTB = HALF * BK * 2  , STAGE_BYTES = 8 * HTB, NXCD = 8, WGM = 8;

__host__ __device__ __forceinline__ int lds_byte(int r, int c) { const int st = (r >> 4) * 2 + (c >> 5), rr = r & 15, cc = c & 31, ob = rr * 64 + cc * 2; return st * 1024 + (ob ^ (((ob >> 9) & 1) << 5)); }
__host__ __device__ __forceinline__ void stage_rc(int b, int& R, int& C) { const int st = b / 1024, sb = b % 1024, swz = sb ^ (((sb >> 9) & 1) << 5); R = (st >> 1) * 16 + swz / 64; C = (st & 1) * 32 + (swz % 64) / 2; }
__host__ __device__ __forceinline__ int perm32(int rho) { const int n = rho >> 4, i = rho & 15; return 8 * (i >> 2) + 4 * n + (i & 3); }

struct Unit { int pm, pn; };
struct Gemm { const bf16_t* A; const bf16_t* Bt; int M, N, K; };

struct StaticOrder {
    int nM, nN, nwg, G, c;
    __host__ __device__ void init(int M, int N, int G_, int c_) { nM = M / BM; nN = N / BM; nwg = nM * nN; G = G_; c = c_; }
    __host__ __device__ bool next(int i, Unit& u) const {
        const long L = (long)i * G + c; if (L >= nwg) return false;
        int wgid = (int)L; { const int q = nwg / NXCD, r = nwg % NXCD, xcd = wgid % NXCD, off = wgid / NXCD; wgid = (xcd < r ? xcd * (q + 1) : r * (q + 1) + (xcd - r) * q) + off; }
        const int nig = WGM * nN, gid = wgid / nig, fm = gid * WGM, gsz = (nM - fm) < WGM ? (nM - fm) : WGM;
        u.pm = fm + ((wgid % nig) % gsz); u.pn = (wgid % nig) / gsz; return true;
    }
    __device__ __forceinline__ void a_ready(const Unit&) const {}
    __device__ __forceinline__ void done(const Unit&) const {}
};

__device__ __forceinline__ unsigned cvt_pk_bf16(float lo, float hi) { unsigned r; asm volatile("v_cvt_pk_bf16_f32 %0, %1, %2" : "=v"(r) : "v"(lo), "v"(hi)); return r; }
typedef float f32x2 __attribute__((ext_vector_type(2)));
__device__ __forceinline__ f32x2 gelu_pk(f32x2 v) {
    const f32x2 av = __builtin_elementwise_abs(v), d = av * 0.2316418882f + 1.0f;
    f32x2 t; t.x = __builtin_amdgcn_rcpf(d.x); t.y = __builtin_amdgcn_rcpf(d.y);
    f32x2 q = t * 0.5307027145f + (-0.7265760135f); q = q * t + 0.7107068705f; q = q * t + (-0.142248368f); q = q * t + 0.127414796f; q = q * t;
    const f32x2 s = (v * v) * (-0.72134752044f);
    f32x2 e; e.x = __builtin_amdgcn_exp2f(s.x); e.y = __builtin_amdgcn_exp2f(s.y);
    const f32x2 m = v * (q * e), r = v - m;
    f32x2 o; o.x = v.x < 0.f ? m.x : r.x; o.y = v.y < 0.f ? m.y : r.y; return o;
}

template <int ACT  > struct EpiBf16 {
    static constexpr bool PERM = true, AFTER_DRAIN = false; static_assert(ACT == 0 || ACT == 1, "EpiBf16: ACT is 0 (none) or 1 (gelu_pk)");
    bf16_t* O; int ldc; const float* bias; int split_cols; size_t split_stride; float scale0;
    __device__ __forceinline__ void operator()(const f32x4 (&acc)[2][2][4][2], const Unit& u, int wr, int wc, int fr, int fq) const {
        const int row0 = u.pm * BM + wr * 64 + fr; int colt = u.pn * BM; bf16_t* base = O;
        float sc = 1.f; if (split_cols) { const int t = colt / split_cols; base += (size_t)t * split_stride; colt -= t * split_cols; if (t == 0) sc = scale0; }
        const int col0 = colt + wc * 32 + 8 * fq, bcol0 = u.pn * BM + wc * 32 + 8 * fq;
        f32x4 bv[2][2];
#pragma unroll
        for (int bj = 0; bj < 2; ++bj)
#pragma unroll
            for (int n = 0; n < 2; ++n) bv[bj][n] = bias ? *(const f32x4*)(bias + bcol0 + bj * HALF + 4 * n) : (f32x4){0.f, 0.f, 0.f, 0.f};
#pragma unroll
        for (int ai = 0; ai < 2; ++ai)
#pragma unroll
            for (int m = 0; m < 4; ++m) { bf16_t* rowp = base + (size_t)(row0 + ai * HALF + m * 16) * ldc + col0;
#pragma unroll
                for (int bj = 0; bj < 2; ++bj) { f32x4 v0 = acc[ai][bj][m][0] + bv[bj][0], v1 = acc[ai][bj][m][1] + bv[bj][1];
                    if (ACT == 1) { f32x2 a = gelu_pk((f32x2){v0[0], v0[1]}), b = gelu_pk((f32x2){v0[2], v0[3]}), c = gelu_pk((f32x2){v1[0], v1[1]}), d = gelu_pk((f32x2){v1[2], v1[3]});
                        v0 = (f32x4){a.x, a.y, b.x, b.y}; v1 = (f32x4){c.x, c.y, d.x, d.y}; }
                    v0 = v0 * sc; v1 = v1 * sc; u32x4 w; w.x = cvt_pk_bf16(v0[0], v0[1]); w.y = cvt_pk_bf16(v0[2], v0[3]); w.z = cvt_pk_bf16(v1[0], v1[1]); w.w = cvt_pk_bf16(v1[2], v1[3]);
                    *(u32x4*)(rowp + bj * HALF) = w; } }
    }
};

template <class Epi, class Sched, bool ALIGN_EPI = false, bool SP2 = false>
__device__ __forceinline__ void gemm_phase(PG8_LAS unsigned char* lds, const Gemm g, const Sched& S, const Epi& E, const int tid_in) {
    int tid_l = tid_in; asm volatile("" : "+v"(tid_l));
    const int tid = tid_l, wid = __builtin_amdgcn_readfirstlane(tid >> 6), lane = tid & 63, wr = wid >> 2, wc = wid & 3, fr = lane & 15, fq = lane >> 4;
    const int K = g.K, nt = K / BK;
    unsigned voffA[2], voffB[2];
#pragma unroll
    for (int i = 0; i < 2; ++i) { int R, C; stage_rc(tid * 16 + i * 8192, R, C); const int Rb = Epi::PERM ? ((R & ~31) + perm32(R & 31)) : R;
        voffA[i] = (unsigned)(R * K + C) * 2u; voffB[i] = (unsigned)(Rb * K + C) * 2u; }
    const size_t kstep = (size_t)(BK * 2);
    const size_t hstep = (size_t)HALF * K * 2;
    const size_t tstep = 2 * hstep;
    const unsigned ldsw = (unsigned)wid * 1024u;
    const int aoff = lds_byte(wr * 64 + fr, fq * 8), boff = lds_byte(wc * 32 + fr, fq * 8);
#define PG8_SA(b, h) (((b) * 2 + (h)) * HTB)
#define PG8_SB(b, h) ((4 + (b) * 2 + (h)) * HTB)
#define PG8_STAGE(bufoff, gbase, voff) do { _Pragma("unroll") for (int _i = 0; _i < 2; ++_i) \
        __builtin_amdgcn_global_load_lds((const unsigned*)((const char*)(gbase) + (voff)[_i]), (PG8_LAS unsigned*)(lds + (bufoff) + ldsw + _i * 8192), 16, 0, 0); } while (0)
#define PG8_LDA(dst, b, h) do { _Pragma("unroll") for (int m = 0; m < 4; ++m) _Pragma("unroll") for (int k = 0; k < 2; ++k) dst[m][k] = *(const PG8_LAS bf16x8*)(lds + PG8_SA(b, h) + aoff + m * 2048 + k * 1024); } while (0)
#define PG8_LDB(dst, b, h) do { _Pragma("unroll") for (int n = 0; n < 2; ++n) _Pragma("unroll") for (int k = 0; k < 2; ++k) dst[n][k] = *(const PG8_LAS bf16x8*)(lds + PG8_SB(b, h) + boff + n * 2048 + k * 1024); } while (0)
#define PG8_MMA(ai, bj, At, Bt) do { __builtin_amdgcn_s_setprio(1); _Pragma("unroll") for (int m = 0; m < 4; ++m) _Pragma("unroll") for (int n = 0; n < 2; ++n) _Pragma("unroll") for (int k = 0; k < 2; ++k) \
        acc[ai][bj][m][n] = __builtin_amdgcn_mfma_f32_16x16x32_bf16(Bt[n][k], At[m][k], acc[ai][bj][m][n], 0, 0, 0); __builtin_amdgcn_s_setprio(0); } while (0)
#define PG8_WAIT_V(n) asm volatile("s_waitcnt vmcnt(" #n ")" ::: "memory")
#define PG8_WAIT_L(n) asm volatile("s_waitcnt lgkmcnt(" #n ")" ::: "memory")
#define PG8_BAR __builtin_amdgcn_s_barrier()
#define PG8_SCHED __builtin_amdgcn_sched_barrier(0)
    Unit cur, nxt; int ui = 0;
    if (!S.next(0, cur)) return;
    f32x4 acc[2][2][4][2];
#pragma unroll
    for (int a = 0; a < 2; ++a)
#pragma unroll
        for (int b = 0; b < 2; ++b)
#pragma unroll
            for (int m = 0; m < 4; ++m)
#pragma unroll
                for (int n = 0; n < 2; ++n) acc[a][b][m][n] = (f32x4){0.f, 0.f, 0.f, 0.f};
    bf16x8 At[4][2], B0[2][2], B1[2][2];
    const char* cA = (const char*)g.A + (size_t)cur.pm * tstep; const char* cB = (const char*)g.Bt + (size_t)cur.pn * tstep;
    S.a_ready(cur);
    if constexpr (SP2) {
        PG8_STAGE(PG8_SB(0, 0), cB, voffB); PG8_STAGE(PG8_SB(0, 1), cB + hstep, voffB); PG8_STAGE(PG8_SA(0, 0), cA, voffA); PG8_STAGE(PG8_SA(0, 1), cA + hstep, voffA);
        if (wr == 1) PG8_BAR;
        PG8_WAIT_V(2); PG8_BAR;
        PG8_STAGE(PG8_SB(1, 0), cB + kstep, voffB); PG8_STAGE(PG8_SA(1, 0), cA + kstep, voffA); PG8_STAGE(PG8_SB(1, 1), cB + hstep + kstep, voffB);
        PG8_WAIT_V(6); PG8_BAR;
    } else {
        PG8_STAGE(PG8_SB(0, 0), cB, voffB); PG8_STAGE(PG8_SA(0, 0), cA, voffA); PG8_STAGE(PG8_SB(0, 1), cB + hstep, voffB); PG8_STAGE(PG8_SA(0, 1), cA + hstep, voffA);
        if (wr == 1) PG8_BAR;
        PG8_WAIT_V(4); PG8_BAR;
        PG8_STAGE(PG8_SB(1, 0), cB + kstep, voffB); PG8_STAGE(PG8_SA(1, 0), cA + kstep, voffA); PG8_STAGE(PG8_SB(1, 1), cB + hstep + kstep, voffB);
        PG8_WAIT_V(6); PG8_BAR;
    }
    for (;;) {
        const bool has_next = S.next(ui + 1, nxt);
        const char* nA = has_next ? (const char*)g.A + (size_t)nxt.pm * tstep : cA; const char* nB = has_next ? (const char*)g.Bt + (size_t)nxt.pn * tstep : cB;
        for (int t = 0; t < nt; t += 2) {
            const bool last = (t == nt - 2);
            const char* a1 = cA + (size_t)(t + 1) * kstep;
            const char* a2 = last ? nA : cA + (size_t)(t + 2) * kstep; const char* b2 = last ? nB : cB + (size_t)(t + 2) * kstep;
            const char* a3 = a2 + kstep; const char* b3 = b2 + kstep;
            if (last && has_next) S.a_ready(nxt);
            if constexpr (SP2) {
            PG8_LDB(B0, 0, 0); PG8_LDB(B1, 0, 1); PG8_SCHED; PG8_LDA(At, 0, 0); PG8_STAGE(PG8_SA(1, 1), a1 + hstep, voffA);
            PG8_WAIT_V(8); PG8_WAIT_L(0); PG8_BAR; PG8_MMA(0, 0, At, B0); PG8_MMA(0, 1, At, B1); PG8_BAR; PG8_SCHED;
            PG8_LDA(At, 0, 1); PG8_STAGE(PG8_SB(0, 0), b2, voffB); PG8_STAGE(PG8_SB(0, 1), b2 + hstep, voffB); PG8_STAGE(PG8_SA(0, 0), a2, voffA);
            PG8_WAIT_V(8); PG8_WAIT_L(0); PG8_BAR; PG8_MMA(1, 0, At, B0); PG8_MMA(1, 1, At, B1); PG8_BAR; PG8_SCHED;
            PG8_LDB(B0, 1, 0); PG8_LDB(B1, 1, 1); PG8_SCHED; PG8_LDA(At, 1, 0); PG8_STAGE(PG8_SA(0, 1), a2 + hstep, voffA);
            PG8_WAIT_V(8); PG8_WAIT_L(0); PG8_BAR; PG8_MMA(0, 0, At, B0); PG8_MMA(0, 1, At, B1); PG8_BAR; PG8_SCHED;
            PG8_LDA(At, 1, 1); PG8_STAGE(PG8_SB(1, 0), b3, voffB); PG8_STAGE(PG8_SB(1, 1), b3 + hstep, voffB); PG8_STAGE(PG8_SA(1, 0), a3, voffA);
            PG8_WAIT_V(8); PG8_WAIT_L(0); PG8_BAR; PG8_MMA(1, 0, At, B0); PG8_MMA(1, 1, At, B1); PG8_BAR; PG8_SCHED;
            } else {
            PG8_LDB(B0, 0, 0); PG8_SCHED; PG8_LDA(At, 0, 0); PG8_STAGE(PG8_SA(1, 1), a1 + hstep, voffA);
            PG8_WAIT_L(8); PG8_BAR; PG8_WAIT_L(0); PG8_MMA(0, 0, At, B0); PG8_BAR; PG8_SCHED;
            PG8_LDB(B1, 0, 1); PG8_STAGE(PG8_SB(0, 0), b2, voffB);
            PG8_BAR; PG8_WAIT_L(0); PG8_MMA(0, 1, At, B1); PG8_BAR;
            PG8_LDA(At, 0, 1); PG8_STAGE(PG8_SA(0, 0), a2, voffA);
            PG8_BAR; PG8_WAIT_L(0); PG8_MMA(1, 0, At, B0); PG8_BAR; PG8_SCHED;
            PG8_STAGE(PG8_SB(0, 1), b2 + hstep, voffB);
            PG8_WAIT_V(6); PG8_BAR; PG8_MMA(1, 1, At, B1); PG8_BAR;
            PG8_LDB(B0, 1, 0); PG8_SCHED; PG8_LDA(At, 1, 0); PG8_STAGE(PG8_SA(0, 1), a2 + hstep, voffA);
            PG8_WAIT_L(8); PG8_BAR; PG8_WAIT_L(0); PG8_MMA(0, 0, At, B0); PG8_BAR; PG8_SCHED;
            PG8_LDB(B1, 1, 1); PG8_STAGE(PG8_SB(1, 0), b3, voffB);
            PG8_BAR; PG8_WAIT_L(0); PG8_MMA(0, 1, At, B1); PG8_BAR;
            PG8_LDA(At, 1, 1); PG8_STAGE(PG8_SA(1, 0), a3, voffA);
            PG8_BAR; PG8_WAIT_L(0); PG8_MMA(1, 0, At, B0); PG8_BAR; PG8_SCHED;
            PG8_STAGE(PG8_SB(1, 1), b3 + hstep, voffB);
            PG8_WAIT_V(6); PG8_BAR; PG8_MMA(1, 1, At, B1); PG8_BAR;
            }
        }
        if constexpr (ALIGN_EPI) { if (wr == 0) PG8_BAR; }
        if constexpr (!Epi::AFTER_DRAIN) { E(acc, cur, wr, wc, fr, fq); S.done(cur); }
        if (!has_next) break;
#pragma unroll
        for (int a = 0; a < 2; ++a)
#pragma unroll
            for (int b = 0; b < 2; ++b)
#pragma unroll
                for (int m = 0; m < 4; ++m)
#pragma unroll
                    for (int n = 0; n < 2; ++n) acc[a][b][m][n] = (f32x4){0.f, 0.f, 0.f, 0.f};
        cur = nxt; cA = nA; cB = nB; ++ui;
        if constexpr (ALIGN_EPI) { if (wr == 1) PG8_BAR; }
    }
    PG8_WAIT_V(0);
    if constexpr (!ALIGN_EPI) { if (wr == 0) PG8_BAR; }
    PG8_BAR;
    if constexpr (Epi::AFTER_DRAIN) { E.fused(acc, cur, wr, wc, fr, fq, lds, wid, lane); S.done(cur); }
#undef PG8_SA
#undef PG8_SB
#undef PG8_STAGE
#undef PG8_LDA
#undef PG8_LDB
#undef PG8_MMA
#undef PG8_WAIT_V
#undef PG8_WAIT_L
#undef PG8_BAR
#undef PG8_SCHED
}
}
#define GAS __attribute__((address_space(1)))
#define LAS __attribute__((address_space(3)))
typedef unsigned short bf16;
typedef unsigned v4u __attribute__((ext_vector_type(4)));
typedef float f32x4 __attribute__((ext_vector_type(4)));
typedef short bf16x8 __attribute__((ext_vector_type(8)));
typedef GAS unsigned gu32;
typedef GAS unsigned long long gu64;
#define RLX_AGENT __ATOMIC_RELAXED, __HIP_MEMORY_SCOPE_AGENT
#define LDS_WAIT() asm volatile("s_waitcnt lgkmcnt(0)" ::: "memory")
#define VM_WAIT() asm volatile("s_waitcnt vmcnt(0)" ::: "memory")
__device__ __forceinline__ unsigned long long rt() { return __builtin_amdgcn_s_memrealtime(); }
__device__ __forceinline__ unsigned f2bf(float f) { unsigned u = __builtin_bit_cast(unsigned, f); return (u + 0x7fffu + ((u >> 16) & 1u)) >> 16; }
__device__ __forceinline__ unsigned pk2(float lo, float hi) { return f2bf(lo) | (f2bf(hi) << 16); }

#define XB_TMO      128
#define XB_XCNT(j)  (256  + 64 * (j))
#define XB_XSUB(j)  (1280 + 64 * (j))
#define XB_XGEN(j)  (2304 + 64 * (j))
#define XB_TOP      3328
#define XB_TOPGEN   3392
#define XCD_BAR_WORDS 3456
#define XB_SPIN_CAP (1u << 18)

__device__ __forceinline__ unsigned xb_ld(unsigned* p)              { return __hip_atomic_load(p, __ATOMIC_RELAXED, __HIP_MEMORY_SCOPE_AGENT); }
__device__ __forceinline__ unsigned xb_add(unsigned* p, unsigned v) { return __hip_atomic_fetch_add(p, v, __ATOMIC_RELAXED, __HIP_MEMORY_SCOPE_AGENT); }
__device__ __forceinline__ unsigned xb_xcc_id() { return (unsigned)__builtin_amdgcn_s_getreg((3 << 11) | 20) & 0xFu; }
#define XB_SPIN(cond, bar) do { unsigned _sp = 0; while (cond) { __builtin_amdgcn_s_sleep(1); \
    if ((++_sp & 255u) == 0u) { if (xb_ld(&(bar)[XB_TMO])) break; if (_sp > XB_SPIN_CAP) { atomicAdd(&(bar)[XB_TMO], 1u); break; } } } } while (0)

struct XcdBarrier {
    unsigned* bar; unsigned x;
    volatile LAS unsigned* st;
};

__device__ __forceinline__ XcdBarrier xcd_barrier_post(unsigned* bar, volatile LAS unsigned* st, const int tid) {
    XcdBarrier b; b.bar = bar; b.x = xb_xcc_id(); b.st = st;
    if (tid == 0) (void)xb_add(&bar[XB_XCNT(b.x)], 1u);
    return b;
}
__device__ __forceinline__ void xcd_barrier_complete(unsigned* bar, unsigned x, unsigned& nloc, unsigned& nx) {
    const unsigned G = gridDim.x * gridDim.y * gridDim.z;
    unsigned sum, cnt, mine, sp = 0u;
    for (;;) {
        sum = 0u; cnt = 0u; mine = 0u;
#pragma unroll
        for (unsigned j = 0; j < 16; ++j) { const unsigned c = xb_ld(&bar[XB_XCNT(j)]); sum += c; cnt += (c > 0u) ? 1u : 0u; mine = (j == x) ? c : mine; }
        if (sum == G) break;
        __builtin_amdgcn_s_sleep(1);
        if ((++sp & 255u) == 0u) { if (xb_ld(&bar[XB_TMO])) break; if (sp > XB_SPIN_CAP) { atomicAdd(&bar[XB_TMO], 1u); break; } }
    }
    nloc = mine > 0u ? mine : 1u; nx = cnt > 0u ? cnt : 1u;
}

__device__ __forceinline__ void xcd_barrier(const XcdBarrier& b, const int tid) {
    asm volatile("s_waitcnt vmcnt(0)" ::: "memory");
    __syncthreads();
    if (tid == 0) {
        unsigned* bar = b.bar;
        __builtin_amdgcn_s_waitcnt(0);
        unsigned nloc = b.st[0], nx = b.st[1];
        if (nloc == 0u) { xcd_barrier_complete(bar, b.x, nloc, nx); b.st[0] = nloc; b.st[1] = nx; }
        const unsigned old = xb_add(&bar[XB_XSUB(b.x)], 1u);
        const unsigned gen = old / nloc;
        if (old + 1u == (gen + 1u) * nloc) {
            __builtin_amdgcn_fence(__ATOMIC_RELEASE, "agent");
            asm volatile("s_waitcnt vmcnt(0)" ::: "memory");
            const unsigned og = xb_add(&bar[XB_TOP], 1u);
            const unsigned tg = og / nx;
            if (og + 1u == (tg + 1u) * nx) xb_add(&bar[XB_TOPGEN], 1u);
            else XB_SPIN(xb_ld(&bar[XB_TOPGEN]) == tg, bar);
            __builtin_amdgcn_fence(__ATOMIC_ACQUIRE, "agent");
            xb_add(&bar[XB_XGEN(b.x)], 1u);
            asm volatile("s_waitcnt vmcnt(0)" ::: "memory");
        } else {
            XB_SPIN(xb_ld(&bar[XB_XGEN(b.x)]) == gen, bar);
            __builtin_amdgcn_fence(__ATOMIC_ACQUIRE, "agent");
            asm volatile("s_waitcnt vmcnt(0)" ::: "memory");
        }
    }
    __syncthreads();
}
namespace att {
typedef __attribute__((ext_vector_type(8))) short bf16x8;
typedef __attribute__((ext_vector_type(4))) short s16x4;
typedef __attribute__((ext_vector_type(16))) float f32x16;
typedef __attribute__((ext_vector_type(4))) unsigned u32x4;
typedef unsigned short bf16;
constexpr int D = 128, NW = 8, QBLK = 32, KVBLK = 64, LDQ = 1024;
constexpr float SCALE = 0.088388347648318440f, THR = 8.f;
constexpr int SHM_V = KVBLK * D * 2, SHM_K = KVBLK * D * 2;
constexpr int WS_OFF = 2 * SHM_V + 2 * SHM_K, TAB_OFF = WS_OFF + NW * 64 * 4, ATT_LDS_BYTES = TAB_OFF + 2048;
#define KSWZ(row, colB) ((row) * 256 + ((colB) ^ (((row) & 7) << 4)))
#define SBAR() __builtin_amdgcn_sched_barrier(0)
__device__ __forceinline__ int crow(int r, int hi) { return (r & 3) + 8 * (r >> 2) + 4 * hi; }
__device__ __forceinline__ unsigned cvtpk(float lo, float hi) { unsigned r; asm volatile("v_cvt_pk_bf16_f32 %0, %1, %2" : "=v"(r) : "v"(lo), "v"(hi)); return r; }
__device__ __forceinline__ bf16x8 ld8(const bf16* p) { return *reinterpret_cast<const bf16x8*>(p); }

__device__ __forceinline__ void partialSM(f32x16& p0, f32x16& p1, float& m_reg, float& mn, float& alpha) {
  constexpr float C = SCALE * 1.4426950408889634f;
  float pmax = p0[0]; for (int r = 1; r < 16; ++r) pmax = fmaxf(pmax, p0[r]); for (int r = 0; r < 16; ++r) pmax = fmaxf(pmax, p1[r]);
  { auto rr = __builtin_amdgcn_permlane32_swap(__float_as_uint(pmax), __float_as_uint(pmax), false, false);
    pmax = fmaxf(__uint_as_float(rr[0]), __uint_as_float(rr[1])); }
  if (__builtin_expect(__all(pmax - m_reg <= THR / SCALE), 1)) { mn = m_reg; alpha = 1.f; }
  else { mn = fmaxf(m_reg, pmax); alpha = __builtin_amdgcn_exp2f((m_reg - mn) * C); m_reg = mn; }
  float mnC = -mn * C;
  for (int r = 0; r < 16; ++r) p0[r] = fmaf(p0[r], C, mnC); for (int r = 0; r < 16; ++r) p1[r] = fmaf(p1[r], C, mnC);
  for (int r = 0; r < 16; ++r) p0[r] = __builtin_amdgcn_exp2f(p0[r]);
}
__device__ __forceinline__ void finishSM(f32x16& p0, f32x16& p1, float alpha, float& l_reg, bf16x8& pa0, bf16x8& pa1, bf16x8& pa2, bf16x8& pa3) {
  for (int r = 0; r < 16; ++r) p1[r] = __builtin_amdgcn_exp2f(p1[r]);
  float ps = 0; for (int r = 0; r < 16; ++r) ps += p0[r]; for (int r = 0; r < 16; ++r) ps += p1[r];
  { auto rr = __builtin_amdgcn_permlane32_swap(__float_as_uint(ps), __float_as_uint(ps), false, false);
    ps = __uint_as_float(rr[0]) + __uint_as_float(rr[1]); }
  l_reg = l_reg * alpha + ps;
#define PK4(P, BASE, OUT) do { unsigned a0 = cvtpk(P[BASE + 0], P[BASE + 1]), a1 = cvtpk(P[BASE + 2], P[BASE + 3]);   \
    unsigned b0 = cvtpk(P[BASE + 4], P[BASE + 5]), b1 = cvtpk(P[BASE + 6], P[BASE + 7]);                              \
    auto r0 = __builtin_amdgcn_permlane32_swap(a0, b0, false, false); auto r1 = __builtin_amdgcn_permlane32_swap(a1, b1, false, false); \
    u32x4 w = {r0[0], r1[0], r0[1], r1[1]}; OUT = *reinterpret_cast<bf16x8*>(&w); } while (0)
  PK4(p0, 0, pa0); PK4(p0, 8, pa1); PK4(p1, 0, pa2); PK4(p1, 8, pa3);
#undef PK4
}
__device__ __forceinline__ void qkt(f32x16& p0, f32x16& p1, const bf16* Ks, const bf16x8* qr, int r32, int hi) {
  p0 = f32x16{}; p1 = f32x16{};
  const char* kb[4];
#pragma unroll
  for (int dd = 0; dd < 4; ++dd) kb[dd] = (const char*)Ks + KSWZ(r32, (dd * 16 + hi * 8) * 2);
#pragma unroll
  for (int d0 = 0; d0 < 8; ++d0) { const char* a = kb[d0 & 3] + (d0 >> 2) * 128;
    bf16x8 b0 = *reinterpret_cast<const bf16x8*>(a);
    bf16x8 b1 = *reinterpret_cast<const bf16x8*>(a + 32 * 256);
    p0 = __builtin_amdgcn_mfma_f32_32x32x16_bf16(b0, qr[d0], p0, 0, 0, 0);
    p1 = __builtin_amdgcn_mfma_f32_32x32x16_bf16(b1, qr[d0], p1, 0, 0, 0); }
}
__device__ __forceinline__ int v_st(int k, int c) { const int kk = (k & ~0xC) | ((k & 4) << 1) | ((k & 8) >> 1); return ((kk >> 3) * 4 + (c >> 5)) * 512 + ((kk & 7) * 32 + (c & 31)) * 2; }
__device__ __forceinline__ int v_rd_base(int lane) { return ((lane & 3) << 3) | (((lane >> 2) & 3) << 6) | (((lane >> 4) & 1) << 5) | (((lane >> 5) & 1) << 8); }
constexpr int v_rd_off(int d0, int ks, int half) { return d0 * 512 + ks * 4096 + half * 2048; }
template <int OFF> __device__ __forceinline__ s16x4 tr_read(int vb) {
  s16x4 r; asm volatile("ds_read_b64_tr_b16 %0, %1 offset:%2" : "=&v"(r) : "v"(vb), "i"(OFF) : "memory"); return r;
}
template <int D0> __device__ __forceinline__ void pv_one(f32x16& od, int vb, bf16x8 pa0, bf16x8 pa1, bf16x8 pa2, bf16x8 pa3) {
  const s16x4 l0 = tr_read<v_rd_off(D0, 0, 0)>(vb), h0 = tr_read<v_rd_off(D0, 0, 1)>(vb), l1 = tr_read<v_rd_off(D0, 1, 0)>(vb), h1 = tr_read<v_rd_off(D0, 1, 1)>(vb);
  const s16x4 l2 = tr_read<v_rd_off(D0, 2, 0)>(vb), h2 = tr_read<v_rd_off(D0, 2, 1)>(vb), l3 = tr_read<v_rd_off(D0, 3, 0)>(vb), h3 = tr_read<v_rd_off(D0, 3, 1)>(vb);
  asm volatile("s_waitcnt lgkmcnt(0)" ::: "memory"); SBAR();
#define PK(L, H) (bf16x8){L[0], L[1], L[2], L[3], H[0], H[1], H[2], H[3]}
  od = __builtin_amdgcn_mfma_f32_32x32x16_bf16(pa0, PK(l0, h0), od, 0, 0, 0);
  od = __builtin_amdgcn_mfma_f32_32x32x16_bf16(pa1, PK(l1, h1), od, 0, 0, 0);
  od = __builtin_amdgcn_mfma_f32_32x32x16_bf16(pa2, PK(l2, h2), od, 0, 0, 0);
  od = __builtin_amdgcn_mfma_f32_32x32x16_bf16(pa3, PK(l3, h3), od, 0, 0, 0);
#undef PK
}
__device__ __forceinline__ void pv_d0(f32x16* o, int vb, bf16x8 pa0, bf16x8 pa1, bf16x8 pa2, bf16x8 pa3) {
  pv_one<0>(o[0], vb, pa0, pa1, pa2, pa3); pv_one<1>(o[1], vb, pa0, pa1, pa2, pa3); pv_one<2>(o[2], vb, pa0, pa1, pa2, pa3); pv_one<3>(o[3], vb, pa0, pa1, pa2, pa3);
}

struct Unit {
  const bf16* Q; bf16* O;
  const bf16* K0; const bf16* V0;
  const bf16* K1; const bf16* V1;
  int n0, n1, ldk;
  int mode;
  int a, b;
  float sink2;
  const float* tab;
};
__device__ __forceinline__ void mask_nat(f32x16& p0, f32x16& p1, bool rowvis, int cs4, int cqb, const float* trow) {
  const float NEG = -__builtin_inff();
  if (!rowvis) {
#pragma unroll
    for (int r = 0; r < 16; ++r) { p0[r] = NEG; p1[r] = NEG; }
    return; }
#pragma unroll
  for (int r = 0; r < 16; ++r) { const int cc = (r & 3) + 8 * (r >> 2);
    { const int i0 = min(max(cc - cqb, 0), 30); const float bv = trow[i0]; p0[r] = ((unsigned)(cc - cs4) < 16u) ? p0[r] + bv : NEG; }
    { const int i1 = min(max(cc + 32 - cqb, 0), 30); const float bv = trow[i1]; p1[r] = ((unsigned)(cc + 32 - cs4) < 16u) ? p1[r] + bv : NEG; } }
}
__device__ __forceinline__ void mask_win(f32x16& p0, f32x16& p1, int dq) {
  const float NEG = -__builtin_inff();
#pragma unroll
  for (int r = 0; r < 16; ++r) { const int cc = (r & 3) + 8 * (r >> 2);
    if ((unsigned)(dq + cc) > 256u) p0[r] = NEG;
    if ((unsigned)(dq + cc + 32) > 256u) p1[r] = NEG; }
}

__device__ __forceinline__ void attn_unit(const Unit& U, char* lds, const int tid_in) {
  int tid_l = tid_in; asm volatile("" : "+v"(tid_l));
  const int tid = tid_l, wid = __builtin_amdgcn_readfirstlane(tid >> 6), lane = tid & 63, r32 = lane & 31, hi = lane >> 5;
  bf16* V_lds = (bf16*)lds; bf16* K_lds = (bf16*)(lds + 2 * SHM_V);
  float* ws = (float*)(lds + WS_OFF) + wid * 64; float* li_l = ws; float* al_l = ws + 32;
  float* tabL = (float*)(lds + TAB_OFF);
  if (U.mode == 1) { for (int i = tid; i < 465; i += 512) tabL[i] = U.tab[i] * (1.0f / SCALE); }
  float m_reg = -1e30f, l_reg = 0; f32x16 o[4] = {}; bf16x8 qr[8];
  const bf16* Qw = U.Q + (long)(wid * QBLK + r32) * LDQ + hi * 8;
#pragma unroll
  for (int d0 = 0; d0 < 8; ++d0) qr[d0] = ld8(Qw + d0 * 16);
  const int ldk = U.ldk, n0 = U.n0, NT = U.n0 + U.n1;
  const int sr = tid >> 4, sc = (tid & 15) * 8, vst0 = v_st(sr, sc), vst1 = v_st(32 + sr, sc);
  const int vb0 = (int)(uintptr_t)V_lds + v_rd_base(lane);
  struct { bf16x8 vs0, vs1, ks0, ks1; } sr_[1];
  const int maskA = U.a, maskB = U.b;
#define SLOAD(i, t) do { const int t_ = (t); const bf16* Kp_ = t_ < n0 ? U.K0 + (long)t_ * KVBLK * ldk : U.K1 + (long)(t_ - n0) * KVBLK * ldk;  \
    const bf16* Vp_ = t_ < n0 ? U.V0 + (long)t_ * KVBLK * ldk : U.V1 + (long)(t_ - n0) * KVBLK * ldk;                                         \
    sr_[i].vs0 = ld8(&Vp_[(long)sr * ldk + sc]); sr_[i].vs1 = ld8(&Vp_[(long)(32 + sr) * ldk + sc]);                                           \
    sr_[i].ks0 = ld8(&Kp_[(long)sr * ldk + sc]); sr_[i].ks1 = ld8(&Kp_[(long)(32 + sr) * ldk + sc]); } while (0)
#define SWRITE(b, i) do { *(bf16x8*)((char*)V_lds + (b) * SHM_V + vst0) = sr_[i].vs0;          \
    *(bf16x8*)((char*)V_lds + (b) * SHM_V + vst1) = sr_[i].vs1; int kc = sc * 2;               \
    *(bf16x8*)((char*)K_lds + (b) * SHM_K + KSWZ(sr, kc)) = sr_[i].ks0;                       \
    *(bf16x8*)((char*)K_lds + (b) * SHM_K + KSWZ(32 + sr, kc)) = sr_[i].ks1; } while (0)
#define SWAIT() asm volatile("s_waitcnt vmcnt(0)" ::: "memory")
#define RESC(a) do { if (__any((a) < 1.f)) { if (hi == 0) al_l[r32] = (a); asm volatile("s_waitcnt lgkmcnt(0)" ::: "memory"); \
    for (int d = 0; d < 4; ++d) for (int r = 0; r < 16; ++r) o[d][r] *= al_l[crow(r, hi)]; } } while (0)
#define MASK(P0, P1, t) do { if (U.mode != 0 && (t) >= n0) { const int tl_ = (t) - n0; int ln_ = lane; asm volatile("" : "+v"(ln_));     \
    const int r32_ = ln_ & 31, hi_ = ln_ >> 5;                                                                                                  \
    if (U.mode == 1) { const int rq_ = maskA + (wid >> 1), rsq_ = min(max(rq_ - 4, 0), 56), kr_ = maskB + tl_; const bool rv_ = (unsigned)(kr_ - rsq_) < 8u; const int dr_ = rv_ ? kr_ - rq_ + 7 : 0; \
        const int cq_ = 32 * (wid & 1) + r32_, cs_ = min(max(cq_ - 8, 0), 48);                                                                   \
        mask_nat(P0, P1, rv_, cs_ - 4 * hi_, cq_ - 15 - 4 * hi_, tabL + dr_ * 31); }                                                             \
    else { mask_win(P0, P1, maskB + tl_ * KVBLK - (maskA + 32 * wid + r32_) + 4 * hi_ + 128); } } } while (0)
  f32x16 pA0, pA1, pB0, pB1; float mnA, mnB, alA, alB; bf16x8 pa0, pa1, pa2, pa3;
  constexpr int SE = 0, SO = 0;
  SLOAD(SE, 0); asm volatile("s_waitcnt vmcnt(0)" ::: "memory"); SWRITE(0, SE); __syncthreads();
  qkt(pA0, pA1, K_lds, qr, r32, hi); MASK(pA0, pA1, 0); partialSM(pA0, pA1, m_reg, mnA, alA);
  SLOAD(SO, 1);
  SWAIT(); SWRITE(1, SO); __syncthreads();
  for (int j = 1; j + 1 < NT; j += 2) {
    SBAR(); qkt(pB0, pB1, (bf16*)((char*)K_lds + SHM_K), qr, r32, hi);
    finishSM(pA0, pA1, alA, l_reg, pa0, pa1, pa2, pa3); SBAR();
    SLOAD(SO, j + 1); SBAR();
    pv_d0(o, vb0, pa0, pa1, pa2, pa3); MASK(pB0, pB1, j); partialSM(pB0, pB1, m_reg, mnB, alB);
    __syncthreads(); SWAIT(); SWRITE(0, SE);
    RESC(alB); __syncthreads();
    SBAR(); qkt(pA0, pA1, K_lds, qr, r32, hi);
    finishSM(pB0, pB1, alB, l_reg, pa0, pa1, pa2, pa3); SBAR();
    SLOAD(SE, j + 2); SBAR();
    pv_d0(o, vb0 + (int)SHM_V, pa0, pa1, pa2, pa3); MASK(pA0, pA1, j + 1); partialSM(pA0, pA1, m_reg, mnA, alA);
    __syncthreads(); SWAIT(); SWRITE(1, SO);
    RESC(alA); __syncthreads();
  }
  SBAR(); qkt(pB0, pB1, (bf16*)((char*)K_lds + SHM_K), qr, r32, hi);
  finishSM(pA0, pA1, alA, l_reg, pa0, pa1, pa2, pa3); SBAR();
  pv_d0(o, vb0, pa0, pa1, pa2, pa3); MASK(pB0, pB1, NT - 1); partialSM(pB0, pB1, m_reg, mnB, alB);
  __syncthreads(); RESC(alB);
  finishSM(pB0, pB1, alB, l_reg, pa0, pa1, pa2, pa3); SBAR();
  pv_d0(o, vb0 + (int)SHM_V, pa0, pa1, pa2, pa3);
  l_reg += __builtin_amdgcn_exp2f(U.sink2 - m_reg * (SCALE * 1.4426950408889634f));
  if (hi == 0) li_l[r32] = l_reg; asm volatile("s_waitcnt lgkmcnt(0)" ::: "memory");
  float rli[16];
#pragma unroll
  for (int r = 0; r < 16; ++r) rli[r] = __builtin_amdgcn_rcpf(li_l[crow(r, hi)]);
  __syncthreads();
  { bf16* stg = (bf16*)(lds + wid * 8192);
#pragma unroll
    for (int r = 0; r < 16; ++r) { const int orow = crow(r, hi);
#pragma unroll
      for (int d0 = 0; d0 < 4; ++d0) stg[orow * 128 + d0 * 32 + r32] = (bf16)(cvtpk(o[d0][r] * rli[r], 0.f) & 0xffffu); }
    asm volatile("s_waitcnt lgkmcnt(0)" ::: "memory");
    bf16* Ow = U.O + (long)(wid * QBLK) * LDQ;
#pragma unroll
    for (int i = 0; i < 8; ++i) { const int row = 4 * i + (lane >> 4), ch = lane & 15; const u32x4 v = *(const u32x4*)(stg + row * 128 + ch * 8);
      *(u32x4*)(Ow + (long)row * LDQ + ch * 8) = v; } }
  __syncthreads();
#undef SLOAD
#undef SWRITE
#undef SWAIT
#undef RESC
#undef MASK
}
#undef KSWZ
#undef SBAR
}
constexpr int DM = 2048, R_CTX = 4096, R_LAT = 8192, RT = 12288, FF = 5632, NGU = 11264, DIN = 12288, HD = 128;
constexpr int NWAVES = 8, NTHR = 512;
constexpr float EPS_N = 1e-6f, SM_SCALE = 0.08838834764831845f;
constexpr size_t MiB = 1u << 20;
constexpr size_t WS_CTL = 0, CTL_ZERO_BYTES = 1 * MiB;
constexpr size_t WS_MODS = 1 * MiB;
constexpr size_t WS_ROPE = 2 * MiB;
constexpr size_t WS_CACHE = 4 * MiB;
constexpr size_t WS_W = 16 * MiB, W_LAYER = 200 * MiB;
constexpr size_t W_GU1 = 0, W_D1 = 44 * MiB, W_IN = 66 * MiB, W_B = 114 * MiB, W_O = 126 * MiB, W_GU2 = 134 * MiB, W_D2 = 178 * MiB;
constexpr size_t WS_H = 416 * MiB;
constexpr size_t WS_ACT = 464 * MiB;
constexpr size_t WS_Z = 596 * MiB;
constexpr size_t WS_QKVG = 884 * MiB;
constexpr size_t WS_END = 1172 * MiB;
constexpr int CW_BAR = 4096;
constexpr int EXCH_OFF = 131072, LDSCTL_OFF = 139264, MISC_OFF = LDSCTL_OFF + 320, LDS_BYTES = 147456;
constexpr size_t OUT_YP = 0, OUT_YS = 8388608, OUT_KGQA = 25165824, OUT_VGQA = 27262976, OUT_KNAT = 29360128, OUT_VNAT = 37748736, OUT_KWIN = 46137344, OUT_VWIN = 48234496, OUT_TOTAL = 50331648;

struct Args { const float* in[25]; float* out; unsigned char* ws; };

struct Frame {
    LAS unsigned char* lds;
    int tid, lane, wave, G, bid;
    float* out; unsigned char* ws;
};
#define CAS __attribute__((address_space(4)))
__device__ __forceinline__ const float* in_ptr(int k) { const CAS char* p = (const CAS char*)__builtin_amdgcn_kernarg_segment_ptr(); asm volatile("" : "+s"(p)); return *(const float* const CAS*)(p + 8 * k); }

__device__ __forceinline__ float wave_sum(float v) {
#pragma unroll
    for (int o = 1; o < 64; o <<= 1) v += __shfl_xor(v, o);
    return v;
}
__device__ __forceinline__ float bf2f(unsigned b) { return __uint_as_float(b << 16); }
__device__ __forceinline__ float bflo(unsigned w) { return __uint_as_float(w << 16); }
__device__ __forceinline__ float bfhi(unsigned w) { return __uint_as_float(w & 0xffff0000u); }
__device__ __forceinline__ float sigm(float x) { return 1.f / (1.f + __expf(-x)); }

__device__ __forceinline__ void transpose_item(const float* W, int K, int N, bf16* WT, LAS float* scr, int k0, int n0, int lane) {
#pragma unroll 4
    for (int i = 0; i < 16; ++i) {
        const int k = 4 * i + (lane >> 4), n4 = lane & 15;
        const f32x4 v = *(const GAS f32x4*)(W + (size_t)(k0 + k) * N + n0 + 4 * n4);
        LAS float* s = scr + k * 65 + 4 * n4; s[0] = v.x; s[1] = v.y; s[2] = v.z; s[3] = v.w;
    }
    LDS_WAIT(); asm volatile("" ::: "memory");
    const int c = lane & 7;
#pragma unroll
    for (int j = 0; j < 8; ++j) {
        const int n = 8 * j + (lane >> 3); const LAS float* s = scr + (8 * c) * 65 + n;
        v4u o; o.x = pk2(s[0], s[65]); o.y = pk2(s[130], s[195]); o.z = pk2(s[260], s[325]); o.w = pk2(s[390], s[455]);
        *(GAS v4u*)(WT + (size_t)(n0 + n) * K + k0 + 8 * c) = o;
    }
    LDS_WAIT(); asm volatile("" ::: "memory");
}
__device__ __forceinline__ void transpose_matrix(Frame& F, const float* W, int K, int N, bf16* WT) {
    LAS float* scr = (LAS float*)(F.lds + F.wave * 16640);
    const int gw = F.bid * NWAVES + F.wave, NGW = F.G * NWAVES, nb = N / 64, items = (K / 64) * nb;
    for (int it = gw; it < items; it += NGW) transpose_item(W, K, N, WT, scr, 64 * (it / nb), 64 * (it % nb), F.lane);
}
__device__ __forceinline__ void cvt_array(Frame& F, const float* src, bf16* dst, int n8) {
    for (int i = F.bid * NTHR + F.tid; i < n8; i += F.G * NTHR) {
        const f32x4 a = *(const GAS f32x4*)(src + (size_t)i * 8), b = *(const GAS f32x4*)(src + (size_t)i * 8 + 4);
        v4u o; o.x = pk2(a.x, a.y); o.y = pk2(a.z, a.w); o.z = pk2(b.x, b.y); o.w = pk2(b.z, b.w);
        *(GAS v4u*)(dst + (size_t)i * 8) = o;
    }
}
__device__ __forceinline__ void mods_phase(Frame& F) {
    LAS float* sv = (LAS float*)F.lds;
    LAS f32x4* red = (LAS f32x4*)(F.lds + 24576);
    const float* c_lat = in_ptr(8); const float* c_ctx = in_ptr(9); const float* w_mod = in_ptr(10); const float* b_mod = in_ptr(11);
    float* mods = (float*)(F.ws + WS_MODS);
    for (int i = F.tid; i < 3 * 2048; i += NTHR) { const int g = i >> 11, k = i & 2047; const float c = (g == 0) ? c_ctx[k] : c_lat[(g - 1) * 2048 + k]; sv[i] = c / (1.f + __expf(-c)); }
    __syncthreads();
    for (int cb = F.bid; cb < 256; cb += F.G) {
        const int l = cb >> 7, col0 = (cb & 127) * 144;
        if (F.tid < 504) {
            const int c4 = F.tid % 36, kg = F.tid / 36;
            const GAS f32x4* wp = (const GAS f32x4*)(w_mod + (size_t)l * 2048 * 18432 + col0 + 4 * c4);
            f32x4 a0 = {0.f, 0.f, 0.f, 0.f}, a1 = a0, a2 = a0;
#pragma unroll 4
            for (int k = kg; k < 2048; k += 14) { const f32x4 w = wp[(size_t)k * 4608]; a0 += sv[k] * w; a1 += sv[2048 + k] * w; a2 += sv[4096 + k] * w; }
            red[(kg * 3 + 0) * 36 + c4] = a0; red[(kg * 3 + 1) * 36 + c4] = a1; red[(kg * 3 + 2) * 36 + c4] = a2;
        }
        __syncthreads();
        if (F.tid < 108) {
            const int g = F.tid / 36, c4 = F.tid % 36; f32x4 s = *(const GAS f32x4*)(b_mod + (size_t)l * 18432 + col0 + 4 * c4);
            for (int kg = 0; kg < 14; ++kg) s += red[(kg * 3 + g) * 36 + c4];
            *(GAS f32x4*)(mods + (size_t)(l * 3 + g) * 18432 + col0 + 4 * c4) = s;
        }
        __syncthreads();
    }
}
__device__ __forceinline__ void prologue(Frame& F) {
    unsigned char* ws = F.ws;
    for (int l = 0; l < 2; ++l) {
        unsigned char* wl = ws + WS_W + (size_t)l * W_LAYER;
        transpose_matrix(F, in_ptr(13) + (size_t)l * DM * NGU, DM, NGU, (bf16*)(wl + W_GU1));
        transpose_matrix(F, in_ptr(14) + (size_t)l * FF * DM, FF, DM, (bf16*)(wl + W_D1));
        transpose_matrix(F, in_ptr(15) + (size_t)l * DM * DIN, DM, DIN, (bf16*)(wl + W_IN));
        for (int i = 0; i < 3; ++i) transpose_matrix(F, in_ptr(20) + (size_t)(l * 3 + i) * 1024 * DM, 1024, DM, (bf16*)(wl + W_B) + (size_t)i * DM * 1024);
        transpose_matrix(F, in_ptr(21) + (size_t)l * DM * DM, DM, DM, (bf16*)(wl + W_O));
        transpose_matrix(F, in_ptr(22) + (size_t)l * DM * NGU, DM, NGU, (bf16*)(wl + W_GU2));
        transpose_matrix(F, in_ptr(23) + (size_t)l * FF * DM, FF, DM, (bf16*)(wl + W_D2));
    }
    cvt_array(F, in_ptr(2), (bf16*)(ws + WS_CACHE), 524288 / 8);
    cvt_array(F, in_ptr(3), (bf16*)(ws + WS_CACHE + 1 * MiB), 524288 / 8);
    cvt_array(F, in_ptr(6), (bf16*)(ws + WS_CACHE + 2 * MiB), 524288 / 8);
    cvt_array(F, in_ptr(7), (bf16*)(ws + WS_CACHE + 3 * MiB), 524288 / 8);
    cvt_array(F, in_ptr(4), (bf16*)(ws + WS_CACHE + 4 * MiB), 2097152 / 8);
    cvt_array(F, in_ptr(5), (bf16*)(ws + WS_CACHE + 8 * MiB), 2097152 / 8);
    { float* ct = (float*)(ws + WS_ROPE); float* st = ct + 2048;
      for (int i = F.bid * NTHR + F.tid; i < 2048; i += F.G * NTHR) { const int pos = i >> 5, f = i & 31;
          const float inv = exp2f(-(float)f * (13.287712379549449f / 32.0f)); const float ang = (float)pos * inv;
          const float kf = rintf(ang * 0.6366197723675814f); float r = fmaf(-kf, 1.5707962512969971f, ang); r = fmaf(-kf, 7.5497894158615964e-08f, r); r = fmaf(-kf, 5.3903029534742384e-15f, r);
          const float r2 = r * r;
          const float sn = r + r * r2 * (-1.6666667e-1f + r2 * (8.3333338e-3f + r2 * (-1.9841270e-4f + r2 * 2.7557319e-6f)));
          const float cs = 1.0f + r2 * (-0.5f + r2 * (4.1666668e-2f + r2 * (-1.3888889e-3f + r2 * (2.4801587e-5f + r2 * -2.7557319e-7f))));
          const int q = ((int)kf) & 3; const float sv_ = (q == 0) ? sn : (q == 1) ? cs : (q == 2) ? -sn : -cs, cv_ = (q == 0) ? cs : (q == 1) ? -sn : (q == 2) ? -cs : sn;
          ct[i] = cv_; st[i] = sv_; } }
    __syncthreads();
    mods_phase(F);
}

__device__ __forceinline__ void adaln_phase(Frame& F, int l, int which, bool from_inputs, const float* Y, float coef, int gate_l, int gate_chunk) {
    float* X = F.out; bf16* H = (bf16*)(F.ws + WS_H); const float* mods = (const float*)(F.ws + WS_MODS);
    const float* gn = in_ptr(12) + (size_t)(l * 3 + which) * DM;
    const int gw = F.bid * NWAVES + F.wave, NGW = F.G * NWAVES, lane = F.lane;
    for (int row = gw; row < RT; row += NGW) {
        const int g = row < R_CTX ? 0 : 1 + ((row - R_CTX) >> 12);
        const float* src = from_inputs ? (row < R_CTX ? in_ptr(0) + (size_t)row * DM : in_ptr(1) + (size_t)(row - R_CTX) * DM) : X + (size_t)row * DM;
        f32x4 v[8];
#pragma unroll
        for (int j = 0; j < 8; ++j) v[j] = ((const GAS f32x4*)src)[64 * j + lane];
        if (Y) {
            const GAS f32x4* yr = (const GAS f32x4*)(Y + (size_t)row * DM); const GAS f32x4* gt = (const GAS f32x4*)(mods + (size_t)(gate_l * 3 + g) * 18432 + gate_chunk * DM);
#pragma unroll
            for (int j = 0; j < 8; ++j) v[j] += coef * gt[64 * j + lane] * yr[64 * j + lane];
        }
        if (Y || from_inputs) {
#pragma unroll
            for (int j = 0; j < 8; ++j) ((GAS f32x4*)(X + (size_t)row * DM))[64 * j + lane] = v[j];
        }
        float ss = 0.f;
#pragma unroll
        for (int j = 0; j < 8; ++j) ss += (v[j].x * v[j].x + v[j].y * v[j].y) + (v[j].z * v[j].z + v[j].w * v[j].w);
        const float rstd = 1.0f / sqrtf(wave_sum(ss) * (1.0f / DM) + EPS_N);
        const GAS f32x4* gnp = (const GAS f32x4*)gn; const float* mg = mods + (size_t)(l * 3 + g) * 18432 + (size_t)which * 3 * DM;
        const GAS f32x4* shp = (const GAS f32x4*)mg; const GAS f32x4* scp = (const GAS f32x4*)(mg + DM);
        GAS unsigned long long* o8 = (GAS unsigned long long*)(H + (size_t)row * DM);
#pragma unroll
        for (int j = 0; j < 8; ++j) {
            const f32x4 a = gnp[64 * j + lane] * (1.0f + scp[64 * j + lane]) * rstd, b = shp[64 * j + lane]; const f32x4 h = v[j] * a + b;
            o8[64 * j + lane] = (unsigned long long)pk2(h.x, h.y) | ((unsigned long long)pk2(h.z, h.w) << 32);
        }
    }
}
__device__ __forceinline__ void final_phase(Frame& F, const float* Y, float coef, int gate_l, int gate_chunk) {
    float* X = F.out; const float* mods = (const float*)(F.ws + WS_MODS); const GAS f32x4* gf = (const GAS f32x4*)in_ptr(24);
    const int gw = F.bid * NWAVES + F.wave, NGW = F.G * NWAVES, lane = F.lane;
    for (int row = gw; row < RT; row += NGW) {
        const int g = row < R_CTX ? 0 : 1 + ((row - R_CTX) >> 12);
        GAS f32x4* xr = (GAS f32x4*)(X + (size_t)row * DM);
        f32x4 v[8];
#pragma unroll
        for (int j = 0; j < 8; ++j) v[j] = xr[64 * j + lane];
        if (Y) {
            const GAS f32x4* yr = (const GAS f32x4*)(Y + (size_t)row * DM); const GAS f32x4* gt = (const GAS f32x4*)(mods + (size_t)(gate_l * 3 + g) * 18432 + gate_chunk * DM);
#pragma unroll
            for (int j = 0; j < 8; ++j) v[j] += coef * gt[64 * j + lane] * yr[64 * j + lane];
        }
        float ss = 0.f;
#pragma unroll
        for (int j = 0; j < 8; ++j) ss += (v[j].x * v[j].x + v[j].y * v[j].y) + (v[j].z * v[j].z + v[j].w * v[j].w);
        const float rstd = 1.0f / sqrtf(wave_sum(ss) * (1.0f / DM) + EPS_N);
#pragma unroll
        for (int j = 0; j < 8; ++j) xr[64 * j + lane] = v[j] * rstd * gf[64 * j + lane];
    }
}
__device__ __forceinline__ void swiglu_phase(Frame& F) {
    const bf16* Z = (const bf16*)(F.ws + WS_Z); bf16* A = (bf16*)(F.ws + WS_ACT);
    const int total = RT * (FF / 8);
    for (int i = F.bid * NTHR + F.tid; i < total; i += F.G * NTHR) {
        const int row = i / (FF / 8), c8 = i % (FF / 8);
        const v4u a = *(const GAS v4u*)(Z + (size_t)row * NGU + 8 * c8), b = *(const GAS v4u*)(Z + (size_t)row * NGU + FF + 8 * c8);
        v4u o;
#pragma unroll
        for (int q = 0; q < 4; ++q) { const float a0 = bflo(a[q]), a1 = bfhi(a[q]), b0 = bflo(b[q]), b1 = bfhi(b[q]);
            o[q] = pk2(a0 / (1.f + __expf(-a0)) * b0, a1 / (1.f + __expf(-a1)) * b1); }
        *(GAS v4u*)(A + (size_t)row * FF + 8 * c8) = o;
    }
}
__device__ __forceinline__ void post_phase(Frame& F, int l) {
    const bf16* Z = (const bf16*)(F.ws + WS_Z); unsigned char* qb = F.ws + WS_QKVG;
    bf16* QA = (bf16*)qb; bf16* QB = (bf16*)(qb + 24 * MiB); bf16* QC = (bf16*)(qb + 48 * MiB); bf16* KB = (bf16*)(qb + 72 * MiB); bf16* VB = (bf16*)(qb + 96 * MiB);
    bf16* KA = (bf16*)(qb + 120 * MiB); bf16* VA = (bf16*)(qb + 126 * MiB); bf16* KC = (bf16*)(qb + 132 * MiB); bf16* VC = (bf16*)(qb + 138 * MiB); bf16* GT = (bf16*)(qb + 144 * MiB);
    const float* gq = in_ptr(16) + l * HD; const float* gk = in_ptr(17) + l * HD;
    const float* ct = (const float*)(F.ws + WS_ROPE); const float* st = ct + 2048;
    const int gw = F.bid * NWAVES + F.wave, NGW = F.G * NWAVES, lane = F.lane;
    for (int row = gw; row < RT; row += NGW) {
        const bool isctx = row < R_CTX; const int n = (row - R_CTX) & 4095, rpos = n >> 6, cpos = n & 63, fi = lane & 31;
        const float c0 = ct[rpos * 32 + fi], s0 = st[rpos * 32 + fi], c1 = ct[cpos * 32 + fi], s1 = st[cpos * 32 + fi];
        const bf16* z = Z + (size_t)row * DIN;
        const int cb = row >> 8, tt = row & 255;
        for (int s = 0; s < 48; ++s) {
            float v0 = bf2f(z[s * 128 + lane]), v1 = bf2f(z[s * 128 + 64 + lane]);
            if (s < 10) { const float ss = wave_sum(v0 * v0 + v1 * v1); const float rstd = 1.0f / sqrtf(ss * (1.0f / HD) + EPS_N); const float* gg = s < 8 ? gq : gk;
                v0 *= rstd * gg[lane]; v1 *= rstd * gg[64 + lane]; }
            const bool rope = (s < 10) || (s >= 36 && s < 46);
            if (rope && !isctx) { const float p0 = __shfl_xor(v0, 32), p1 = __shfl_xor(v1, 32);
                if (lane < 32) { v0 = v0 * c0 - p0 * s0; v1 = v1 * c1 - p1 * s1; } else { v0 = v0 * c0 + p0 * s0; v1 = v1 * c1 + p1 * s1; } }
            bf16* dst; float* fo = nullptr;
            if (s < 8) dst = QA + (size_t)row * 1024 + s * 128;
            else if (s < 10) { dst = KA + (size_t)row * 256 + (s - 8) * 128; fo = F.out + OUT_KGQA + ((size_t)(cb * 2 + l) * 256 + tt) * 256 + (s - 8) * 128; }
            else if (s < 12) { dst = VA + (size_t)row * 256 + (s - 10) * 128; fo = F.out + OUT_VGQA + ((size_t)(cb * 2 + l) * 256 + tt) * 256 + (s - 10) * 128; }
            else if (s < 20) dst = QB + (size_t)row * 1024 + (s - 12) * 128;
            else if (s < 28) { dst = KB + (size_t)row * 1024 + (s - 20) * 128; fo = F.out + OUT_KNAT + ((size_t)(cb * 2 + l) * 256 + tt) * 1024 + (s - 20) * 128; }
            else if (s < 36) { dst = VB + (size_t)row * 1024 + (s - 28) * 128; fo = F.out + OUT_VNAT + ((size_t)(cb * 2 + l) * 256 + tt) * 1024 + (s - 28) * 128; }
            else if (s < 44) dst = QC + (size_t)row * 1024 + (s - 36) * 128;
            else if (s < 46) { dst = KC + (size_t)row * 256 + (s - 44) * 128; fo = F.out + OUT_KWIN + ((size_t)(cb * 2 + l) * 256 + tt) * 256 + (s - 44) * 128; }
            else { dst = VC + (size_t)row * 256 + (s - 46) * 128; fo = F.out + OUT_VWIN + ((size_t)(cb * 2 + l) * 256 + tt) * 256 + (s - 46) * 128; }
            dst[lane] = (bf16)f2bf(v0); dst[64 + lane] = (bf16)f2bf(v1);
            if (fo && isctx) { fo[lane] = v0; fo[64 + lane] = v1; }
        }
#pragma unroll 4
        for (int j = 0; j < 12; ++j) {
            const v4u a = *(const GAS v4u*)(z + 6144 + (j * 64 + lane) * 8); v4u o;
#pragma unroll
            for (int q = 0; q < 4; ++q) o[q] = pk2(sigm(bflo(a[q])), sigm(bfhi(a[q])));
            *(GAS v4u*)(GT + (size_t)row * 6144 + (j * 64 + lane) * 8) = o;
        }
    }
}
__device__ __forceinline__ void combine_phase(Frame& F) {
    const float* Y3 = (const float*)(F.ws + WS_Z); const bf16* GT = (const bf16*)(F.ws + WS_QKVG + 144 * MiB); bf16* Mb = (bf16*)(F.ws + WS_H);
    const int total = RT * (DM / 4);
    for (int i = F.bid * NTHR + F.tid; i < total; i += F.G * NTHR) {
        const int row = i >> 9, c4 = i & 511; f32x4 m = {0.f, 0.f, 0.f, 0.f};
#pragma unroll
        for (int b = 0; b < 3; ++b) {
            const f32x4 y = *(const GAS f32x4*)(Y3 + (size_t)b * RT * DM + (size_t)row * DM + 4 * c4);
            const unsigned long long gg = *(const GAS unsigned long long*)(GT + (size_t)row * 6144 + b * DM + 4 * c4);
            const unsigned g0 = (unsigned)gg, g1 = (unsigned)(gg >> 32);
            m.x += bflo(g0) * y.x; m.y += bfhi(g0) * y.y; m.z += bflo(g1) * y.z; m.w += bfhi(g1) * y.w;
        }
        *(GAS unsigned long long*)(Mb + (size_t)row * DM + 4 * c4) = (unsigned long long)pk2(m.x, m.y) | ((unsigned long long)pk2(m.z, m.w) << 32);
    }
}

__device__ __forceinline__ bool make_unit(Frame& F, int l, int id, att::Unit& U) {
    if (id >= 1152) return false;
    unsigned char* qb = F.ws + WS_QKVG;
    const bf16* QA = (const bf16*)qb; const bf16* QB = (const bf16*)(qb + 24 * MiB); const bf16* QC = (const bf16*)(qb + 48 * MiB); const bf16* KB = (const bf16*)(qb + 72 * MiB); const bf16* VB = (const bf16*)(qb + 96 * MiB);
    const bf16* KA = (const bf16*)(qb + 120 * MiB); const bf16* VA = (const bf16*)(qb + 126 * MiB); const bf16* KC = (const bf16*)(qb + 132 * MiB); const bf16* VC = (const bf16*)(qb + 138 * MiB);
    const bf16* CKA = (const bf16*)(F.ws + WS_CACHE); const bf16* CVA = (const bf16*)(F.ws + WS_CACHE + 1 * MiB); const bf16* CKC = (const bf16*)(F.ws + WS_CACHE + 2 * MiB); const bf16* CVC = (const bf16*)(F.ws + WS_CACHE + 3 * MiB);
    const bf16* CKB = (const bf16*)(F.ws + WS_CACHE + 4 * MiB); const bf16* CVB = (const bf16*)(F.ws + WS_CACHE + 8 * MiB);
    bf16* O = (bf16*)(F.ws + WS_ACT);
    const float LOG2E = 1.4426950408889634f;
    U.mode = 0; U.a = 0; U.b = 0; U.sink2 = -__builtin_inff(); U.tab = in_ptr(18); U.n0 = 0;
    if (id < 768) {
        const int type = id >> 8, v = id & 255, xcd = v & 7, j = v >> 3; int b, h, q;
        if (type != 1) { const int combo = xcd >> 1, idx = (xcd & 1) * 32 + j; b = combo >> 1; h = (combo & 1) * 4 + (idx >> 4); q = idx & 15; }
        else { const int combo = xcd * 2 + (j >> 4); b = combo >> 3; h = combo & 7; q = j & 15; }
        const size_t lat0 = R_CTX + (size_t)b * 4096, row0 = lat0 + (size_t)q * 256, cb = (size_t)(b * 2 + l) * 512;
        U.n0 = 8;
        if (type == 0) { const int kvh = h >> 2; U.ldk = 256;
            U.Q = QA + row0 * 1024 + h * 128; U.O = O + row0 * 1024 + h * 128;
            U.K0 = CKA + cb * 256 + kvh * 128; U.V0 = CVA + cb * 256 + kvh * 128; U.K1 = KA + lat0 * 256 + kvh * 128; U.V1 = VA + lat0 * 256 + kvh * 128; U.n1 = 64; }
        else if (type == 1) { U.ldk = 1024; const int R0 = q * 4, kr0 = min(max(R0 - 4, 0), 52);
            U.Q = QB + row0 * 1024 + h * 128; U.O = O + (size_t)RT * 1024 + row0 * 1024 + h * 128;
            U.K0 = CKB + cb * 1024 + h * 128; U.V0 = CVB + cb * 1024 + h * 128; U.K1 = KB + (lat0 + (size_t)kr0 * 64) * 1024 + h * 128; U.V1 = VB + (lat0 + (size_t)kr0 * 64) * 1024 + h * 128; U.n1 = 12;
            U.mode = 1; U.a = R0; U.b = kr0; U.tab = in_ptr(18) + (size_t)(l * 8 + h) * 465; }
        else { const int kvh = h >> 2; U.ldk = 256; const int kp0 = max(q * 256 - 128, 0), kp1 = min(q * 256 + 384, 4096);
            U.Q = QC + row0 * 1024 + h * 128; U.O = O + (size_t)2 * RT * 1024 + row0 * 1024 + h * 128;
            U.K0 = CKC + cb * 256 + kvh * 128; U.V0 = CVC + cb * 256 + kvh * 128; U.K1 = KC + (lat0 + kp0) * 256 + kvh * 128; U.V1 = VC + (lat0 + kp0) * 256 + kvh * 128; U.n1 = (kp1 - kp0) >> 6;
            U.mode = 2; U.a = q * 256; U.b = kp0; U.sink2 = in_ptr(19)[l * 8 + h] * LOG2E; }
    } else {
        const int v = id - 768, b = v / 24, rem = v - 24 * b, br = rem >> 3, h = rem & 7; const size_t row0 = (size_t)b * 256;
        const int kvh = br == 1 ? h : (h >> 2); U.ldk = br == 1 ? 1024 : 256;
        const bf16* Qx = br == 0 ? QA : br == 1 ? QB : QC; const bf16* Kx = br == 0 ? KA : br == 1 ? KB : KC; const bf16* Vx = br == 0 ? VA : br == 1 ? VB : VC;
        U.Q = Qx + row0 * 1024 + h * 128; U.O = O + (size_t)br * RT * 1024 + row0 * 1024 + h * 128;
        U.K1 = Kx + row0 * U.ldk + kvh * 128; U.V1 = Vx + row0 * U.ldk + kvh * 128; U.K0 = U.K1; U.V0 = U.V1; U.n1 = 4;
        if (br == 2) U.sink2 = in_ptr(19)[l * 8 + h] * LOG2E;
    }
    return true;
}
__device__ __forceinline__ void attn_phase(Frame& F, int l, char* lds) {
    for (int id = F.bid; ; id += F.G) { att::Unit U; if (!make_unit(F, l, id, U)) break; att::attn_unit(U, lds, F.tid); }
}

namespace pg8 {
struct EpiF32 {
    static constexpr bool PERM = false, AFTER_DRAIN = false;
    float* C; int ldc;
    __device__ __forceinline__ void operator()(const f32x4 (&acc)[2][2][4][2], const Unit& u, int wr, int wc, int fr, int fq) const {
        const int row0 = u.pm * BM + wr * 64 + fr, col0 = u.pn * BM + wc * 32 + 4 * fq;
#pragma unroll
        for (int ai = 0; ai < 2; ++ai)
#pragma unroll
            for (int m = 0; m < 4; ++m) { float* rowp = C + (size_t)(row0 + ai * HALF + m * 16) * ldc + col0;
#pragma unroll
                for (int bj = 0; bj < 2; ++bj)
#pragma unroll
                    for (int n = 0; n < 2; ++n) *(f32x4*)(rowp + bj * HALF + n * 16) = acc[ai][bj][m][n]; }
    }
};
struct BranchOrder {
    int G, c;
    __device__ __forceinline__ bool next(int i, Unit& u) const { const int j = i / 3, br = i - 3 * j; const int tile = j * G + c; if (tile >= 384) return false;
        u.pm = br * 48 + (tile >> 3); u.pn = br * 8 + (tile & 7); return true; }
    __device__ __forceinline__ void a_ready(const Unit&) const {}
    __device__ __forceinline__ void done(const Unit&) const {}
};
struct EpiBranchF32 {
    static constexpr bool PERM = false, AFTER_DRAIN = false;
    float* Y3;
    __device__ __forceinline__ void operator()(const f32x4 (&acc)[2][2][4][2], const Unit& u, int wr, int wc, int fr, int fq) const {
        const int br = u.pm / 48, pm = u.pm - 48 * br, pn = u.pn & 7;
        const int row0 = pm * BM + wr * 64 + fr, col0 = pn * BM + wc * 32 + 4 * fq; float* base = Y3 + (size_t)br * 12288 * 2048;
#pragma unroll
        for (int ai = 0; ai < 2; ++ai)
#pragma unroll
            for (int m = 0; m < 4; ++m) { float* rowp = base + (size_t)(row0 + ai * HALF + m * 16) * 2048 + col0;
#pragma unroll
                for (int bj = 0; bj < 2; ++bj)
#pragma unroll
                    for (int n = 0; n < 2; ++n) *(f32x4*)(rowp + bj * HALF + n * 16) = acc[ai][bj][m][n]; }
    }
};
}

__global__ void __launch_bounds__(NTHR, 2) mega_fwd(Args args) {
    extern __shared__ __attribute__((aligned(16))) unsigned char lds[];
    Frame F;
    F.lds = (LAS unsigned char*)lds; F.tid = threadIdx.x; F.lane = F.tid & 63; F.wave = __builtin_amdgcn_readfirstlane(F.tid >> 6); F.G = gridDim.x; F.bid = blockIdx.x;
    F.out = (float*)in_ptr(25); F.ws = (unsigned char*)in_ptr(26);
    for (int u = F.tid; u < (LDS_BYTES - LDSCTL_OFF) / 4; u += NTHR) ((LAS unsigned*)(F.lds + LDSCTL_OFF))[u] = 0u;
    __syncthreads();
    volatile LAS unsigned* MISC = (volatile LAS unsigned*)(F.lds + MISC_OFF);
    XcdBarrier bar = xcd_barrier_post((unsigned*)(F.ws + WS_CTL) + CW_BAR, MISC + 8, F.tid);
#define GRID_BAR() do { asm volatile("" : "+s"(bar.bar), "+s"(bar.x)); xcd_barrier(bar, F.tid); asm volatile("v_mbcnt_lo_u32_b32 %0, -1, 0\n\tv_mbcnt_hi_u32_b32 %0, -1, %0" : "=v"(F.lane)); \
    asm volatile("" : "+s"(F.wave), "+s"(F.bid), "+s"(F.G), "+s"(F.ws), "+s"(F.out)); F.tid = F.wave * 64 + F.lane; } while (0)
    unsigned char* ws = F.ws;
    bf16* H = (bf16*)(ws + WS_H); bf16* ACT = (bf16*)(ws + WS_ACT); bf16* Zb = (bf16*)(ws + WS_Z); float* Y = (float*)(ws + WS_Z);

    prologue(F); GRID_BAR();

    for (int l = 0; l < 2; ++l) {
        unsigned char* wl = ws + WS_W + (size_t)l * W_LAYER;
        adaln_phase(F, l, 0, l == 0, l == 0 ? nullptr : Y, 0.5f, l - 1, 8); GRID_BAR();
        { pg8::Gemm g{H, (const bf16*)(wl + W_GU1), RT, NGU, DM}; pg8::StaticOrder S; S.init(RT, NGU, F.G, (int)F.bid);
          pg8::EpiBf16<0> E{Zb, NGU, nullptr, 0, 0, 1.f};
          pg8::gemm_phase<pg8::EpiBf16<0>, pg8::StaticOrder, true, true>(F.lds, g, S, E, F.tid); }
        GRID_BAR();
        swiglu_phase(F); GRID_BAR();
        { pg8::Gemm g{ACT, (const bf16*)(wl + W_D1), RT, DM, FF}; pg8::StaticOrder S; S.init(RT, DM, F.G, (int)F.bid);
          pg8::EpiF32 E{Y, DM};
          pg8::gemm_phase<pg8::EpiF32, pg8::StaticOrder, true, true>(F.lds, g, S, E, F.tid); }
        GRID_BAR();
        adaln_phase(F, l, 1, false, Y, 0.5f, l, 2); GRID_BAR();
        { pg8::Gemm g{H, (const bf16*)(wl + W_IN), RT, DIN, DM}; pg8::StaticOrder S; S.init(RT, DIN, F.G, (int)F.bid);
          pg8::EpiBf16<0> E{Zb, DIN, nullptr, 0, 0, 1.f};
          pg8::gemm_phase<pg8::EpiBf16<0>, pg8::StaticOrder, true, true>(F.lds, g, S, E, F.tid); }
        GRID_BAR();
        post_phase(F, l); GRID_BAR();
        attn_phase(F, l, (char*)lds); GRID_BAR();
        { pg8::Gemm g{ACT  , (const bf16*)(wl + W_B), 3 * RT, 3 * DM, 1024}; pg8::BranchOrder S{F.G, (int)F.bid};
          pg8::EpiBranchF32 E{Y};
          pg8::gemm_phase<pg8::EpiBranchF32, pg8::BranchOrder, true, true>(F.lds, g, S, E, F.tid); }
        GRID_BAR();
        combine_phase(F); GRID_BAR();
        { pg8::Gemm g{H  , (const bf16*)(wl + W_O), RT, DM, DM}; pg8::StaticOrder S; S.init(RT, DM, F.G, (int)F.bid);
          pg8::EpiF32 E{Y, DM};
          pg8::gemm_phase<pg8::EpiF32, pg8::StaticOrder, true, true>(F.lds, g, S, E, F.tid); }
        GRID_BAR();
        adaln_phase(F, l, 2, false, Y, 1.0f, l, 5); GRID_BAR();
        { pg8::Gemm g{H, (const bf16*)(wl + W_GU2), RT, NGU, DM}; pg8::StaticOrder S; S.init(RT, NGU, F.G, (int)F.bid);
          pg8::EpiBf16<0> E{Zb, NGU, nullptr, 0, 0, 1.f};
          pg8::gemm_phase<pg8::EpiBf16<0>, pg8::StaticOrder, true, true>(F.lds, g, S, E, F.tid); }
        GRID_BAR();
        swiglu_phase(F); GRID_BAR();
        { pg8::Gemm g{ACT, (const bf16*)(wl + W_D2), RT, DM, FF}; pg8::StaticOrder S; S.init(RT, DM, F.G, (int)F.bid);
          pg8::EpiF32 E{Y, DM};
          pg8::gemm_phase<pg8::EpiF32, pg8::StaticOrder, true, true>(F.lds, g, S, E, F.tid); }
        GRID_BAR();
    }
    final_phase(F, Y, 0.5f, 1, 8);
#undef GRID_BAR
}

extern "C" void kernel_launch(void* const* d_in, const int* in_sizes, int n_in, void* d_out, int out_size, void* d_ws, size_t ws_size, hipStream_t stream) {
    static int grid = 0;
    if (grid == 0) {
        if (n_in != 25 || out_size != (int)OUT_TOTAL || ws_size < WS_END) { fprintf(stderr, "kernel_launch: unexpected shapes: n_in %d out %d ws %zu (need %zu)\n", n_in, out_size, ws_size, (size_t)WS_END); grid = -1; return; }
        int dev = 0, cus = 0, per_cu = 0;
        if (hipGetDevice(&dev) != hipSuccess || hipDeviceGetAttribute(&cus, hipDeviceAttributeMultiprocessorCount, dev) != hipSuccess) { grid = -1; return; }
        if (hipFuncSetAttribute((const void*)mega_fwd, hipFuncAttributeMaxDynamicSharedMemorySize, LDS_BYTES) != hipSuccess) { fprintf(stderr, "kernel_launch: hipFuncSetAttribute failed\n"); grid = -1; return; }
        if (hipOccupancyMaxActiveBlocksPerMultiprocessor(&per_cu, (const void*)mega_fwd, NTHR, LDS_BYTES) != hipSuccess || per_cu < 1) { fprintf(stderr, "kernel_launch: occupancy query says %d\n", per_cu); (void)hipGetLastError(); grid = -1; return; }
        grid = cus;
    }
    if (grid < 0) return;
    if (hipMemsetAsync((char*)d_ws + WS_CTL, 0, CTL_ZERO_BYTES, stream) != hipSuccess) return;
    Args a{};
    for (int i = 0; i < 25; ++i) a.in[i] = (const float*)d_in[i];
    a.out = (float*)d_out; a.ws = (unsigned char*)d_ws;
    hipLaunchKernelGGL(mega_fwd, dim3(grid), dim3(NTHR), LDS_BYTES, stream, a);
}
```

```cpp
#include <hip/hip_runtime.h>
#include <cstdio>
#include <cstdint>
namespace pg8 {
#define PG8_LAS __attribute__((address_space(3)))
typedef unsigned short bf16_t;
typedef short bf16x8 __attribute__((ext_vector_type(8)));
typedef float f32x4 __attribute__((ext_vector_type(4)));
typedef unsigned u32x4 __attribute__((ext_vector_type(4)));
constexpr int BM = 256, BK = 64, HALF = 128, HTB = HALF * BK * 2  , STAGE_BYTES = 8 * HTB, NXCD = 8, WGM = 8;

__host__ __device__ __forceinline__ int lds_byte(int r, int c) { const int st = (r >> 4) * 2 + (c >> 5), rr = r & 15, cc = c & 31, ob = rr * 64 + cc * 2; return st * 1024 + (ob ^ (((ob >> 9) & 1) << 5)); }
__host__ __device__ __forceinline__ void stage_rc(int b, int& R, int& C) { const int st = b / 1024, sb = b % 1024, swz = sb ^ (((sb >> 9) & 1) << 5); R = (st >> 1) * 16 + swz / 64; C = (st & 1) * 32 + (swz % 64) / 2; }
__host__ __device__ __forceinline__ int perm32(int rho) { const int n = rho >> 4, i = rho & 15; return 8 * (i >> 2) + 4 * n + (i & 3); }

struct Unit { int pm, pn; };
struct Gemm { const bf16_t* A; const bf16_t* Bt; int M, N, K; };

struct StaticOrder {
    int nM, nN, nwg, G, c;
    __host__ __device__ void init(int M, int N, int G_, int c_) { nM = M / BM; nN = N / BM; nwg = nM * nN; G = G_; c = c_; }
    __host__ __device__ bool next(int i, Unit& u) const {
        const long L = (long)i * G + c; if (L >= nwg) return false;
        int wgid = (int)L; { const int q = nwg / NXCD, r = nwg % NXCD, xcd = wgid % NXCD, off = wgid / NXCD; wgid = (xcd < r ? xcd * (q + 1) : r * (q + 1) + (xcd - r) * q) + off; }
        const int nig = WGM * nN, gid = wgid / nig, fm = gid * WGM, gsz = (nM - fm) < WGM ? (nM - fm) : WGM;
        u.pm = fm + ((wgid % nig) % gsz); u.pn = (wgid % nig) / gsz; return true;
    }
    __device__ __forceinline__ void a_ready(const Unit&) const {}
    __device__ __forceinline__ void done(const Unit&) const {}
};

__device__ __forceinline__ unsigned cvt_pk_bf16(float lo, float hi) { unsigned r; asm volatile("v_cvt_pk_bf16_f32 %0, %1, %2" : "=v"(r) : "v"(lo), "v"(hi)); return r; }
typedef float f32x2 __attribute__((ext_vector_type(2)));
__device__ __forceinline__ f32x2 gelu_pk(f32x2 v) {
    const f32x2 av = __builtin_elementwise_abs(v), d = av * 0.2316418882f + 1.0f;
    f32x2 t; t.x = __builtin_amdgcn_rcpf(d.x); t.y = __builtin_amdgcn_rcpf(d.y);
    f32x2 q = t * 0.5307027145f + (-0.7265760135f); q = q * t + 0.7107068705f; q = q * t + (-0.142248368f); q = q * t + 0.127414796f; q = q * t;
    const f32x2 s = (v * v) * (-0.72134752044f);
    f32x2 e; e.x = __builtin_amdgcn_exp2f(s.x); e.y = __builtin_amdgcn_exp2f(s.y);
    const f32x2 m = v * (q * e), r = v - m;
    f32x2 o; o.x = v.x < 0.f ? m.x : r.x; o.y = v.y < 0.f ? m.y : r.y; return o;
}

template <int ACT  > struct EpiBf16 {
    static constexpr bool PERM = true, AFTER_DRAIN = false; static_assert(ACT == 0 || ACT == 1, "EpiBf16: ACT is 0 (none) or 1 (gelu_pk)");
    bf16_t* O; int ldc; const float* bias; int split_cols; size_t split_stride; float scale0;
    __device__ __forceinline__ void operator()(const f32x4 (&acc)[2][2][4][2], const Unit& u, int wr, int wc, int fr, int fq) const {
        const int row0 = u.pm * BM + wr * 64 + fr; int colt = u.pn * BM; bf16_t* base = O;
        float sc = 1.f; if (split_cols) { const int t = colt / split_cols; base += (size_t)t * split_stride; colt -= t * split_cols; if (t == 0) sc = scale0; }
        const int col0 = colt + wc * 32 + 8 * fq, bcol0 = u.pn * BM + wc * 32 + 8 * fq;
        f32x4 bv[2][2];
#pragma unroll
        for (int bj = 0; bj < 2; ++bj)
#pragma unroll
            for (int n = 0; n < 2; ++n) bv[bj][n] = bias ? *(const f32x4*)(bias + bcol0 + bj * HALF + 4 * n) : (f32x4){0.f, 0.f, 0.f, 0.f};
#pragma unroll
        for (int ai = 0; ai < 2; ++ai)
#pragma unroll
            for (int m = 0; m < 4; ++m) { bf16_t* rowp = base + (size_t)(row0 + ai * HALF + m * 16) * ldc + col0;
#pragma unroll
                for (int bj = 0; bj < 2; ++bj) { f32x4 v0 = acc[ai][bj][m][0] + bv[bj][0], v1 = acc[ai][bj][m][1] + bv[bj][1];
                    if (ACT == 1) { f32x2 a = gelu_pk((f32x2){v0[0], v0[1]}), b = gelu_pk((f32x2){v0[2], v0[3]}), c = gelu_pk((f32x2){v1[0], v1[1]}), d = gelu_pk((f32x2){v1[2], v1[3]});
                        v0 = (f32x4){a.x, a.y, b.x, b.y}; v1 = (f32x4){c.x, c.y, d.x, d.y}; }
                    v0 = v0 * sc; v1 = v1 * sc; u32x4 w; w.x = cvt_pk_bf16(v0[0], v0[1]); w.y = cvt_pk_bf16(v0[2], v0[3]); w.z = cvt_pk_bf16(v1[0], v1[1]); w.w = cvt_pk_bf16(v1[2], v1[3]);
                    *(u32x4*)(rowp + bj * HALF) = w; } }
    }
};

template <class Epi, class Sched, bool ALIGN_EPI = false, bool SP2 = false>
__device__ __forceinline__ void gemm_phase(PG8_LAS unsigned char* lds, const Gemm g, const Sched& S, const Epi& E, const int tid_in) {
    int tid_l = tid_in; asm volatile("" : "+v"(tid_l));
    const int tid = tid_l, wid = __builtin_amdgcn_readfirstlane(tid >> 6), lane = tid & 63, wr = wid >> 2, wc = wid & 3, fr = lane & 15, fq = lane >> 4;
    const int K = g.K, nt = K / BK;
    unsigned voffA[2], voffB[2];
#pragma unroll
    for (int i = 0; i < 2; ++i) { int R, C; stage_rc(tid * 16 + i * 8192, R, C); const int Rb = Epi::PERM ? ((R & ~31) + perm32(R & 31)) : R;
        voffA[i] = (unsigned)(R * K + C) * 2u; voffB[i] = (unsigned)(Rb * K + C) * 2u; }
    const size_t kstep = (size_t)(BK * 2);
    const size_t hstep = (size_t)HALF * K * 2;
    const size_t tstep = 2 * hstep;
    const unsigned ldsw = (unsigned)wid * 1024u;
    const int aoff = lds_byte(wr * 64 + fr, fq * 8), boff = lds_byte(wc * 32 + fr, fq * 8);
#define PG8_SA(b, h) (((b) * 2 + (h)) * HTB)
#define PG8_SB(b, h) ((4 + (b) * 2 + (h)) * HTB)
#define PG8_STAGE(bufoff, gbase, voff) do { _Pragma("unroll") for (int _i = 0; _i < 2; ++_i) \
        __builtin_amdgcn_global_load_lds((const unsigned*)((const char*)(gbase) + (voff)[_i]), (PG8_LAS unsigned*)(lds + (bufoff) + ldsw + _i * 8192), 16, 0, 0); } while (0)
#define PG8_LDA(dst, b, h) do { _Pragma("unroll") for (int m = 0; m < 4; ++m) _Pragma("unroll") for (int k = 0; k < 2; ++k) dst[m][k] = *(const PG8_LAS bf16x8*)(lds + PG8_SA(b, h) + aoff + m * 2048 + k * 1024); } while (0)
#define PG8_LDB(dst, b, h) do { _Pragma("unroll") for (int n = 0; n < 2; ++n) _Pragma("unroll") for (int k = 0; k < 2; ++k) dst[n][k] = *(const PG8_LAS bf16x8*)(lds + PG8_SB(b, h) + boff + n * 2048 + k * 1024); } while (0)
#define PG8_MMA(ai, bj, At, Bt) do { __builtin_amdgcn_s_setprio(1); _Pragma("unroll") for (int m = 0; m < 4; ++m) _Pragma("unroll") for (int n = 0; n < 2; ++n) _Pragma("unroll") for (int k = 0; k < 2; ++k) \
        acc[ai][bj][m][n] = __builtin_amdgcn_mfma_f32_16x16x32_bf16(Bt[n][k], At[m][k], acc[ai][bj][m][n], 0, 0, 0); __builtin_amdgcn_s_setprio(0); } while (0)
#define PG8_WAIT_V(n) asm volatile("s_waitcnt vmcnt(" #n ")" ::: "memory")
#define PG8_WAIT_L(n) asm volatile("s_waitcnt lgkmcnt(" #n ")" ::: "memory")
#define PG8_BAR __builtin_amdgcn_s_barrier()
#define PG8_SCHED __builtin_amdgcn_sched_barrier(0)
    Unit cur, nxt; int ui = 0;
    if (!S.next(0, cur)) return;
    f32x4 acc[2][2][4][2];
#pragma unroll
    for (int a = 0; a < 2; ++a)
#pragma unroll
        for (int b = 0; b < 2; ++b)
#pragma unroll
            for (int m = 0; m < 4; ++m)
#pragma unroll
                for (int n = 0; n < 2; ++n) acc[a][b][m][n] = (f32x4){0.f, 0.f, 0.f, 0.f};
    bf16x8 At[4][2], B0[2][2], B1[2][2];
    const char* cA = (const char*)g.A + (size_t)cur.pm * tstep; const char* cB = (const char*)g.Bt + (size_t)cur.pn * tstep;
    S.a_ready(cur);
    if constexpr (SP2) {
        PG8_STAGE(PG8_SB(0, 0), cB, voffB); PG8_STAGE(PG8_SB(0, 1), cB + hstep, voffB); PG8_STAGE(PG8_SA(0, 0), cA, voffA); PG8_STAGE(PG8_SA(0, 1), cA + hstep, voffA);
        if (wr == 1) PG8_BAR;
        PG8_WAIT_V(2); PG8_BAR;
        PG8_STAGE(PG8_SB(1, 0), cB + kstep, voffB); PG8_STAGE(PG8_SA(1, 0), cA + kstep, voffA); PG8_STAGE(PG8_SB(1, 1), cB + hstep + kstep, voffB);
        PG8_WAIT_V(6); PG8_BAR;
    } else {
        PG8_STAGE(PG8_SB(0, 0), cB, voffB); PG8_STAGE(PG8_SA(0, 0), cA, voffA); PG8_STAGE(PG8_SB(0, 1), cB + hstep, voffB); PG8_STAGE(PG8_SA(0, 1), cA + hstep, voffA);
        if (wr == 1) PG8_BAR;
        PG8_WAIT_V(4); PG8_BAR;
        PG8_STAGE(PG8_SB(1, 0), cB + kstep, voffB); PG8_STAGE(PG8_SA(1, 0), cA + kstep, voffA); PG8_STAGE(PG8_SB(1, 1), cB + hstep + kstep, voffB);
        PG8_WAIT_V(6); PG8_BAR;
    }
    for (;;) {
        const bool has_next = S.next(ui + 1, nxt);
        const char* nA = has_next ? (const char*)g.A + (size_t)nxt.pm * tstep : cA; const char* nB = has_next ? (const char*)g.Bt + (size_t)nxt.pn * tstep : cB;
        for (int t = 0; t < nt; t += 2) {
            const bool last = (t == nt - 2);
            const char* a1 = cA + (size_t)(t + 1) * kstep;
            const char* a2 = last ? nA : cA + (size_t)(t + 2) * kstep; const char* b2 = last ? nB : cB + (size_t)(t + 2) * kstep;
            const char* a3 = a2 + kstep; const char* b3 = b2 + kstep;
            if (last && has_next) S.a_ready(nxt);
            if constexpr (SP2) {
            PG8_LDB(B0, 0, 0); PG8_LDB(B1, 0, 1); PG8_SCHED; PG8_LDA(At, 0, 0); PG8_STAGE(PG8_SA(1, 1), a1 + hstep, voffA);
            PG8_WAIT_V(8); PG8_WAIT_L(0); PG8_BAR; PG8_MMA(0, 0, At, B0); PG8_MMA(0, 1, At, B1); PG8_BAR; PG8_SCHED;
            PG8_LDA(At, 0, 1); PG8_STAGE(PG8_SB(0, 0), b2, voffB); PG8_STAGE(PG8_SB(0, 1), b2 + hstep, voffB); PG8_STAGE(PG8_SA(0, 0), a2, voffA);
            PG8_WAIT_V(8); PG8_WAIT_L(0); PG8_BAR; PG8_MMA(1, 0, At, B0); PG8_MMA(1, 1, At, B1); PG8_BAR; PG8_SCHED;
            PG8_LDB(B0, 1, 0); PG8_LDB(B1, 1, 1); PG8_SCHED; PG8_LDA(At, 1, 0); PG8_STAGE(PG8_SA(0, 1), a2 + hstep, voffA);
            PG8_WAIT_V(8); PG8_WAIT_L(0); PG8_BAR; PG8_MMA(0, 0, At, B0); PG8_MMA(0, 1, At, B1); PG8_BAR; PG8_SCHED;
            PG8_LDA(At, 1, 1); PG8_STAGE(PG8_SB(1, 0), b3, voffB); PG8_STAGE(PG8_SB(1, 1), b3 + hstep, voffB); PG8_STAGE(PG8_SA(1, 0), a3, voffA);
            PG8_WAIT_V(8); PG8_WAIT_L(0); PG8_BAR; PG8_MMA(1, 0, At, B0); PG8_MMA(1, 1, At, B1); PG8_BAR; PG8_SCHED;
            } else {
            PG8_LDB(B0, 0, 0); PG8_SCHED; PG8_LDA(At, 0, 0); PG8_STAGE(PG8_SA(1, 1), a1 + hstep, voffA);
            PG8_WAIT_L(8); PG8_BAR; PG8_WAIT_L(0); PG8_MMA(0, 0, At, B0); PG8_BAR; PG8_SCHED;
            PG8_LDB(B1, 0, 1); PG8_STAGE(PG8_SB(0, 0), b2, voffB);
            PG8_BAR; PG8_WAIT_L(0); PG8_MMA(0, 1, At, B1); PG8_BAR;
            PG8_LDA(At, 0, 1); PG8_STAGE(PG8_SA(0, 0), a2, voffA);
            PG8_BAR; PG8_WAIT_L(0); PG8_MMA(1, 0, At, B0); PG8_BAR; PG8_SCHED;
            PG8_STAGE(PG8_SB(0, 1), b2 + hstep, voffB);
            PG8_WAIT_V(6); PG8_BAR; PG8_MMA(1, 1, At, B1); PG8_BAR;
            PG8_LDB(B0, 1, 0); PG8_SCHED; PG8_LDA(At, 1, 0); PG8_STAGE(PG8_SA(0, 1), a2 + hstep, voffA);
            PG8_WAIT_L(8); PG8_BAR; PG8_WAIT_L(0); PG8_MMA(0, 0, At, B0); PG8_BAR; PG8_SCHED;
            PG8_LDB(B1, 1, 1); PG8_STAGE(PG8_SB(1, 0), b3, voffB);
            PG8_BAR; PG8_WAIT_L(0); PG8_MMA(0, 1, At, B1); PG8_BAR;
            PG8_LDA(At, 1, 1); PG8_STAGE(PG8_SA(1, 0), a3, voffA);
            PG8_BAR; PG8_WAIT_L(0); PG8_MMA(1, 0, At, B0); PG8_BAR; PG8_SCHED;
            PG8_STAGE(PG8_SB(1, 1), b3 + hstep, voffB);
            PG8_WAIT_V(6); PG8_BAR; PG8_MMA(1, 1, At, B1); PG8_BAR;
            }
        }
        if constexpr (ALIGN_EPI) { if (wr == 0) PG8_BAR; }
        if constexpr (!Epi::AFTER_DRAIN) { E(acc, cur, wr, wc, fr, fq); S.done(cur); }
        if (!has_next) break;
#pragma unroll
        for (int a = 0; a < 2; ++a)
#pragma unroll
            for (int b = 0; b < 2; ++b)
#pragma unroll
                for (int m = 0; m < 4; ++m)
#pragma unroll
                    for (int n = 0; n < 2; ++n) acc[a][b][m][n] = (f32x4){0.f, 0.f, 0.f, 0.f};
        cur = nxt; cA = nA; cB = nB; ++ui;
        if constexpr (ALIGN_EPI) { if (wr == 1) PG8_BAR; }
    }
    PG8_WAIT_V(0);
    if constexpr (!ALIGN_EPI) { if (wr == 0) PG8_BAR; }
    PG8_BAR;
    if constexpr (Epi::AFTER_DRAIN) { E.fused(acc, cur, wr, wc, fr, fq, lds, wid, lane); S.done(cur); }
#undef PG8_SA
#undef PG8_SB
#undef PG8_STAGE
#undef PG8_LDA
#undef PG8_LDB
#undef PG8_MMA
#undef PG8_WAIT_V
#undef PG8_WAIT_L
#undef PG8_BAR
#undef PG8_SCHED
}
}
#define GAS __attribute__((address_space(1)))
#define LAS __attribute__((address_space(3)))
typedef unsigned short bf16;
typedef unsigned v4u __attribute__((ext_vector_type(4)));
typedef float f32x4 __attribute__((ext_vector_type(4)));
typedef short bf16x8 __attribute__((ext_vector_type(8)));
typedef GAS unsigned gu32;
typedef GAS unsigned long long gu64;
#define RLX_AGENT __ATOMIC_RELAXED, __HIP_MEMORY_SCOPE_AGENT
#define LDS_WAIT() asm volatile("s_waitcnt lgkmcnt(0)" ::: "memory")
#define VM_WAIT() asm volatile("s_waitcnt vmcnt(0)" ::: "memory")
__device__ __forceinline__ unsigned long long rt() { return __builtin_amdgcn_s_memrealtime(); }
__device__ __forceinline__ unsigned f2bf(float f) { unsigned u = __builtin_bit_cast(unsigned, f); return (u + 0x7fffu + ((u >> 16) & 1u)) >> 16; }
__device__ __forceinline__ unsigned pk2(float lo, float hi) { return f2bf(lo) | (f2bf(hi) << 16); }

#define XB_TMO      128
#define XB_XCNT(j)  (256  + 64 * (j))
#define XB_XSUB(j)  (1280 + 64 * (j))
#define XB_XGEN(j)  (2304 + 64 * (j))
#define XB_TOP      3328
#define XB_TOPGEN   3392
#define XCD_BAR_WORDS 3456
#define XB_SPIN_CAP (1u << 18)

__device__ __forceinline__ unsigned xb_ld(unsigned* p)              { return __hip_atomic_load(p, __ATOMIC_RELAXED, __HIP_MEMORY_SCOPE_AGENT); }
__device__ __forceinline__ unsigned xb_add(unsigned* p, unsigned v) { return __hip_atomic_fetch_add(p, v, __ATOMIC_RELAXED, __HIP_MEMORY_SCOPE_AGENT); }
__device__ __forceinline__ unsigned xb_xcc_id() { return (unsigned)__builtin_amdgcn_s_getreg((3 << 11) | 20) & 0xFu; }
#define XB_SPIN(cond, bar) do { unsigned _sp = 0; while (cond) { __builtin_amdgcn_s_sleep(1); \
    if ((++_sp & 255u) == 0u) { if (xb_ld(&(bar)[XB_TMO])) break; if (_sp > XB_SPIN_CAP) { atomicAdd(&(bar)[XB_TMO], 1u); break; } } } } while (0)

struct XcdBarrier {
    unsigned* bar; unsigned x;
    volatile LAS unsigned* st;
};

__device__ __forceinline__ XcdBarrier xcd_barrier_post(unsigned* bar, volatile LAS unsigned* st, const int tid) {
    XcdBarrier b; b.bar = bar; b.x = xb_xcc_id(); b.st = st;
    if (tid == 0) (void)xb_add(&bar[XB_XCNT(b.x)], 1u);
    return b;
}
__device__ __forceinline__ void xcd_barrier_complete(unsigned* bar, unsigned x, unsigned& nloc, unsigned& nx) {
    const unsigned G = gridDim.x * gridDim.y * gridDim.z;
    unsigned sum, cnt, mine, sp = 0u;
    for (;;) {
        sum = 0u; cnt = 0u; mine = 0u;
#pragma unroll
        for (unsigned j = 0; j < 16; ++j) { const unsigned c = xb_ld(&bar[XB_XCNT(j)]); sum += c; cnt += (c > 0u) ? 1u : 0u; mine = (j == x) ? c : mine; }
        if (sum == G) break;
        __builtin_amdgcn_s_sleep(1);
        if ((++sp & 255u) == 0u) { if (xb_ld(&bar[XB_TMO])) break; if (sp > XB_SPIN_CAP) { atomicAdd(&bar[XB_TMO], 1u); break; } }
    }
    nloc = mine > 0u ? mine : 1u; nx = cnt > 0u ? cnt : 1u;
}

__device__ __forceinline__ void xcd_barrier(const XcdBarrier& b, const int tid) {
    asm volatile("s_waitcnt vmcnt(0)" ::: "memory");
    __syncthreads();
    if (tid == 0) {
        unsigned* bar = b.bar;
        __builtin_amdgcn_s_waitcnt(0);
        unsigned nloc = b.st[0], nx = b.st[1];
        if (nloc == 0u) { xcd_barrier_complete(bar, b.x, nloc, nx); b.st[0] = nloc; b.st[1] = nx; }
        const unsigned old = xb_add(&bar[XB_XSUB(b.x)], 1u);
        const unsigned gen = old / nloc;
        if (old + 1u == (gen + 1u) * nloc) {
            __builtin_amdgcn_fence(__ATOMIC_RELEASE, "agent");
            asm volatile("s_waitcnt vmcnt(0)" ::: "memory");
            const unsigned og = xb_add(&bar[XB_TOP], 1u);
            const unsigned tg = og / nx;
            if (og + 1u == (tg + 1u) * nx) xb_add(&bar[XB_TOPGEN], 1u);
            else XB_SPIN(xb_ld(&bar[XB_TOPGEN]) == tg, bar);
            __builtin_amdgcn_fence(__ATOMIC_ACQUIRE, "agent");
            xb_add(&bar[XB_XGEN(b.x)], 1u);
            asm volatile("s_waitcnt vmcnt(0)" ::: "memory");
        } else {
            XB_SPIN(xb_ld(&bar[XB_XGEN(b.x)]) == gen, bar);
            __builtin_amdgcn_fence(__ATOMIC_ACQUIRE, "agent");
            asm volatile("s_waitcnt vmcnt(0)" ::: "memory");
        }
    }
    __syncthreads();
}
namespace att {
typedef __attribute__((ext_vector_type(8))) short bf16x8;
typedef __attribute__((ext_vector_type(4))) short s16x4;
typedef __attribute__((ext_vector_type(16))) float f32x16;
typedef __attribute__((ext_vector_type(4))) unsigned u32x4;
typedef unsigned short bf16;
constexpr int D = 128, NW = 8, QBLK = 32, KVBLK = 64, LDQ = 1024;
constexpr float SCALE = 0.088388347648318440f, THR = 8.f;
constexpr int SHM_V = KVBLK * D * 2, SHM_K = KVBLK * D * 2;
constexpr int WS_OFF = 2 * SHM_V + 2 * SHM_K, TAB_OFF = WS_OFF + NW * 64 * 4, ATT_LDS_BYTES = TAB_OFF + 2048;
#define KSWZ(row, colB) ((row) * 256 + ((colB) ^ (((row) & 7) << 4)))
#define SBAR() __builtin_amdgcn_sched_barrier(0)
__device__ __forceinline__ int crow(int r, int hi) { return (r & 3) + 8 * (r >> 2) + 4 * hi; }
__device__ __forceinline__ unsigned cvtpk(float lo, float hi) { unsigned r; asm volatile("v_cvt_pk_bf16_f32 %0, %1, %2" : "=v"(r) : "v"(lo), "v"(hi)); return r; }
__device__ __forceinline__ bf16x8 ld8(const bf16* p) { return *reinterpret_cast<const bf16x8*>(p); }

__device__ __forceinline__ void partialSM(f32x16& p0, f32x16& p1, float& m_reg, float& mn, float& alpha) {
  constexpr float C = SCALE * 1.4426950408889634f;
  float pmax = p0[0]; for (int r = 1; r < 16; ++r) pmax = fmaxf(pmax, p0[r]); for (int r = 0; r < 16; ++r) pmax = fmaxf(pmax, p1[r]);
  { auto rr = __builtin_amdgcn_permlane32_swap(__float_as_uint(pmax), __float_as_uint(pmax), false, false);
    pmax = fmaxf(__uint_as_float(rr[0]), __uint_as_float(rr[1])); }
  if (__builtin_expect(__all(pmax - m_reg <= THR / SCALE), 1)) { mn = m_reg; alpha = 1.f; }
  else { mn = fmaxf(m_reg, pmax); alpha = __builtin_amdgcn_exp2f((m_reg - mn) * C); m_reg = mn; }
  float mnC = -mn * C;
  for (int r = 0; r < 16; ++r) p0[r] = fmaf(p0[r], C, mnC); for (int r = 0; r < 16; ++r) p1[r] = fmaf(p1[r], C, mnC);
  for (int r = 0; r < 16; ++r) p0[r] = __builtin_amdgcn_exp2f(p0[r]);
}
__device__ __forceinline__ void finishSM(f32x16& p0, f32x16& p1, float alpha, float& l_reg, bf16x8& pa0, bf16x8& pa1, bf16x8& pa2, bf16x8& pa3) {
  for (int r = 0; r < 16; ++r) p1[r] = __builtin_amdgcn_exp2f(p1[r]);
  float ps = 0; for (int r = 0; r < 16; ++r) ps += p0[r]; for (int r = 0; r < 16; ++r) ps += p1[r];
  { auto rr = __builtin_amdgcn_permlane32_swap(__float_as_uint(ps), __float_as_uint(ps), false, false);
    ps = __uint_as_float(rr[0]) + __uint_as_float(rr[1]); }
  l_reg = l_reg * alpha + ps;
#define PK4(P, BASE, OUT) do { unsigned a0 = cvtpk(P[BASE + 0], P[BASE + 1]), a1 = cvtpk(P[BASE + 2], P[BASE + 3]);   \
    unsigned b0 = cvtpk(P[BASE + 4], P[BASE + 5]), b1 = cvtpk(P[BASE + 6], P[BASE + 7]);                              \
    auto r0 = __builtin_amdgcn_permlane32_swap(a0, b0, false, false); auto r1 = __builtin_amdgcn_permlane32_swap(a1, b1, false, false); \
    u32x4 w = {r0[0], r1[0], r0[1], r1[1]}; OUT = *reinterpret_cast<bf16x8*>(&w); } while (0)
  PK4(p0, 0, pa0); PK4(p0, 8, pa1); PK4(p1, 0, pa2); PK4(p1, 8, pa3);
#undef PK4
}
__device__ __forceinline__ void qkt(f32x16& p0, f32x16& p1, const bf16* Ks, const bf16x8* qr, int r32, int hi) {
  p0 = f32x16{}; p1 = f32x16{};
  const char* kb[4];
#pragma unroll
  for (int dd = 0; dd < 4; ++dd) kb[dd] = (const char*)Ks + KSWZ(r32, (dd * 16 + hi * 8) * 2);
#pragma unroll
  for (int d0 = 0; d0 < 8; ++d0) { const char* a = kb[d0 & 3] + (d0 >> 2) * 128;
    bf16x8 b0 = *reinterpret_cast<const bf16x8*>(a);
    bf16x8 b1 = *reinterpret_cast<const bf16x8*>(a + 32 * 256);
    p0 = __builtin_amdgcn_mfma_f32_32x32x16_bf16(b0, qr[d0], p0, 0, 0, 0);
    p1 = __builtin_amdgcn_mfma_f32_32x32x16_bf16(b1, qr[d0], p1, 0, 0, 0); }
}
__device__ __forceinline__ int v_st(int k, int c) { const int kk = (k & ~0xC) | ((k & 4) << 1) | ((k & 8) >> 1); return ((kk >> 3) * 4 + (c >> 5)) * 512 + ((kk & 7) * 32 + (c & 31)) * 2; }
__device__ __forceinline__ int v_rd_base(int lane) { return ((lane & 3) << 3) | (((lane >> 2) & 3) << 6) | (((lane >> 4) & 1) << 5) | (((lane >> 5) & 1) << 8); }
constexpr int v_rd_off(int d0, int ks, int half) { return d0 * 512 + ks * 4096 + half * 2048; }
template <int OFF> __device__ __forceinline__ s16x4 tr_read(int vb) {
  s16x4 r; asm volatile("ds_read_b64_tr_b16 %0, %1 offset:%2" : "=&v"(r) : "v"(vb), "i"(OFF) : "memory"); return r;
}
template <int D0> __device__ __forceinline__ void pv_one(f32x16& od, int vb, bf16x8 pa0, bf16x8 pa1, bf16x8 pa2, bf16x8 pa3) {
  const s16x4 l0 = tr_read<v_rd_off(D0, 0, 0)>(vb), h0 = tr_read<v_rd_off(D0, 0, 1)>(vb), l1 = tr_read<v_rd_off(D0, 1, 0)>(vb), h1 = tr_read<v_rd_off(D0, 1, 1)>(vb);
  const s16x4 l2 = tr_read<v_rd_off(D0, 2, 0)>(vb), h2 = tr_read<v_rd_off(D0, 2, 1)>(vb), l3 = tr_read<v_rd_off(D0, 3, 0)>(vb), h3 = tr_read<v_rd_off(D0, 3, 1)>(vb);
  asm volatile("s_waitcnt lgkmcnt(0)" ::: "memory"); SBAR();
#define PK(L, H) (bf16x8){L[0], L[1], L[2], L[3], H[0], H[1], H[2], H[3]}
  od = __builtin_amdgcn_mfma_f32_32x32x16_bf16(pa0, PK(l0, h0), od, 0, 0, 0);
  od = __builtin_amdgcn_mfma_f32_32x32x16_bf16(pa1, PK(l1, h1), od, 0, 0, 0);
  od = __builtin_amdgcn_mfma_f32_32x32x16_bf16(pa2, PK(l2, h2), od, 0, 0, 0);
  od = __builtin_amdgcn_mfma_f32_32x32x16_bf16(pa3, PK(l3, h3), od, 0, 0, 0);
#undef PK
}
__device__ __forceinline__ void pv_d0(f32x16* o, int vb, bf16x8 pa0, bf16x8 pa1, bf16x8 pa2, bf16x8 pa3) {
  pv_one<0>(o[0], vb, pa0, pa1, pa2, pa3); pv_one<1>(o[1], vb, pa0, pa1, pa2, pa3); pv_one<2>(o[2], vb, pa0, pa1, pa2, pa3); pv_one<3>(o[3], vb, pa0, pa1, pa2, pa3);
}

struct Unit {
  const bf16* Q; bf16* O;
  const bf16* K0; const bf16* V0;
  const bf16* K1; const bf16* V1;
  int n0, n1, ldk;
  int mode;
  int a, b;
  float sink2;
  const float* tab;
};
__device__ __forceinline__ void mask_nat(f32x16& p0, f32x16& p1, bool rowvis, int cs4, int cqb, const float* trow) {
  const float NEG = -__builtin_inff();
  if (!rowvis) {
#pragma unroll
    for (int r = 0; r < 16; ++r) { p0[r] = NEG; p1[r] = NEG; }
    return; }
#pragma unroll
  for (int r = 0; r < 16; ++r) { const int cc = (r & 3) + 8 * (r >> 2);
    { const int i0 = min(max(cc - cqb, 0), 30); const float bv = trow[i0]; p0[r] = ((unsigned)(cc - cs4) < 16u) ? p0[r] + bv : NEG; }
    { const int i1 = min(max(cc + 32 - cqb, 0), 30); const float bv = trow[i1]; p1[r] = ((unsigned)(cc + 32 - cs4) < 16u) ? p1[r] + bv : NEG; } }
}
__device__ __forceinline__ void mask_win(f32x16& p0, f32x16& p1, int dq) {
  const float NEG = -__builtin_inff();
#pragma unroll
  for (int r = 0; r < 16; ++r) { const int cc = (r & 3) + 8 * (r >> 2);
    if ((unsigned)(dq + cc) > 256u) p0[r] = NEG;
    if ((unsigned)(dq + cc + 32) > 256u) p1[r] = NEG; }
}

__device__ __forceinline__ void attn_unit(const Unit& U, char* lds, const int tid_in) {
  int tid_l = tid_in; asm volatile("" : "+v"(tid_l));
  const int tid = tid_l, wid = __builtin_amdgcn_readfirstlane(tid >> 6), lane = tid & 63, r32 = lane & 31, hi = lane >> 5;
  bf16* V_lds = (bf16*)lds; bf16* K_lds = (bf16*)(lds + 2 * SHM_V);
  float* ws = (float*)(lds + WS_OFF) + wid * 64; float* li_l = ws; float* al_l = ws + 32;
  float* tabL = (float*)(lds + TAB_OFF);
  if (U.mode == 1) { for (int i = tid; i < 465; i += 512) tabL[i] = U.tab[i] * (1.0f / SCALE); }
  float m_reg = -1e30f, l_reg = 0; f32x16 o[4] = {}; bf16x8 qr[8];
  const bf16* Qw = U.Q + (long)(wid * QBLK + r32) * LDQ + hi * 8;
#pragma unroll
  for (int d0 = 0; d0 < 8; ++d0) qr[d0] = ld8(Qw + d0 * 16);
  const int ldk = U.ldk, n0 = U.n0, NT = U.n0 + U.n1;
  const int sr = tid >> 4, sc = (tid & 15) * 8, vst0 = v_st(sr, sc), vst1 = v_st(32 + sr, sc);
  const int vb0 = (int)(uintptr_t)V_lds + v_rd_base(lane);
  struct { bf16x8 vs0, vs1, ks0, ks1; } sr_[1];
  const int maskA = U.a, maskB = U.b;
#define SLOAD(i, t) do { const int t_ = (t); const bf16* Kp_ = t_ < n0 ? U.K0 + (long)t_ * KVBLK * ldk : U.K1 + (long)(t_ - n0) * KVBLK * ldk;  \
    const bf16* Vp_ = t_ < n0 ? U.V0 + (long)t_ * KVBLK * ldk : U.V1 + (long)(t_ - n0) * KVBLK * ldk;                                         \
    sr_[i].vs0 = ld8(&Vp_[(long)sr * ldk + sc]); sr_[i].vs1 = ld8(&Vp_[(long)(32 + sr) * ldk + sc]);                                           \
    sr_[i].ks0 = ld8(&Kp_[(long)sr * ldk + sc]); sr_[i].ks1 = ld8(&Kp_[(long)(32 + sr) * ldk + sc]); } while (0)
#define SWRITE(b, i) do { *(bf16x8*)((char*)V_lds + (b) * SHM_V + vst0) = sr_[i].vs0;          \
    *(bf16x8*)((char*)V_lds + (b) * SHM_V + vst1) = sr_[i].vs1; int kc = sc * 2;               \
    *(bf16x8*)((char*)K_lds + (b) * SHM_K + KSWZ(sr, kc)) = sr_[i].ks0;                       \
    *(bf16x8*)((char*)K_lds + (b) * SHM_K + KSWZ(32 + sr, kc)) = sr_[i].ks1; } while (0)
#define SWAIT() asm volatile("s_waitcnt vmcnt(0)" ::: "memory")
#define RESC(a) do { if (__any((a) < 1.f)) { if (hi == 0) al_l[r32] = (a); asm volatile("s_waitcnt lgkmcnt(0)" ::: "memory"); \
    for (int d = 0; d < 4; ++d) for (int r = 0; r < 16; ++r) o[d][r] *= al_l[crow(r, hi)]; } } while (0)
#define MASK(P0, P1, t) do { if (U.mode != 0 && (t) >= n0) { const int tl_ = (t) - n0; int ln_ = lane; asm volatile("" : "+v"(ln_));     \
    const int r32_ = ln_ & 31, hi_ = ln_ >> 5;                                                                                                  \
    if (U.mode == 1) { const int rq_ = maskA + (wid >> 1), rsq_ = min(max(rq_ - 4, 0), 56), kr_ = maskB + tl_; const bool rv_ = (unsigned)(kr_ - rsq_) < 8u; const int dr_ = rv_ ? kr_ - rq_ + 7 : 0; \
        const int cq_ = 32 * (wid & 1) + r32_, cs_ = min(max(cq_ - 8, 0), 48);                                                                   \
        mask_nat(P0, P1, rv_, cs_ - 4 * hi_, cq_ - 15 - 4 * hi_, tabL + dr_ * 31); }                                                             \
    else { mask_win(P0, P1, maskB + tl_ * KVBLK - (maskA + 32 * wid + r32_) + 4 * hi_ + 128); } } } while (0)
  f32x16 pA0, pA1, pB0, pB1; float mnA, mnB, alA, alB; bf16x8 pa0, pa1, pa2, pa3;
  constexpr int SE = 0, SO = 0;
  SLOAD(SE, 0); asm volatile("s_waitcnt vmcnt(0)" ::: "memory"); SWRITE(0, SE); __syncthreads();
  qkt(pA0, pA1, K_lds, qr, r32, hi); MASK(pA0, pA1, 0); partialSM(pA0, pA1, m_reg, mnA, alA);
  SLOAD(SO, 1);
  SWAIT(); SWRITE(1, SO); __syncthreads();
  for (int j = 1; j + 1 < NT; j += 2) {
    SBAR(); qkt(pB0, pB1, (bf16*)((char*)K_lds + SHM_K), qr, r32, hi);
    finishSM(pA0, pA1, alA, l_reg, pa0, pa1, pa2, pa3); SBAR();
    SLOAD(SO, j + 1); SBAR();
    pv_d0(o, vb0, pa0, pa1, pa2, pa3); MASK(pB0, pB1, j); partialSM(pB0, pB1, m_reg, mnB, alB);
    __syncthreads(); SWAIT(); SWRITE(0, SE);
    RESC(alB); __syncthreads();
    SBAR(); qkt(pA0, pA1, K_lds, qr, r32, hi);
    finishSM(pB0, pB1, alB, l_reg, pa0, pa1, pa2, pa3); SBAR();
    SLOAD(SE, j + 2); SBAR();
    pv_d0(o, vb0 + (int)SHM_V, pa0, pa1, pa2, pa3); MASK(pA0, pA1, j + 1); partialSM(pA0, pA1, m_reg, mnA, alA);
    __syncthreads(); SWAIT(); SWRITE(1, SO);
    RESC(alA); __syncthreads();
  }
  SBAR(); qkt(pB0, pB1, (bf16*)((char*)K_lds + SHM_K), qr, r32, hi);
  finishSM(pA0, pA1, alA, l_reg, pa0, pa1, pa2, pa3); SBAR();
  pv_d0(o, vb0, pa0, pa1, pa2, pa3); MASK(pB0, pB1, NT - 1); partialSM(pB0, pB1, m_reg, mnB, alB);
  __syncthreads(); RESC(alB);
  finishSM(pB0, pB1, alB, l_reg, pa0, pa1, pa2, pa3); SBAR();
  pv_d0(o, vb0 + (int)SHM_V, pa0, pa1, pa2, pa3);
  l_reg += __builtin_amdgcn_exp2f(U.sink2 - m_reg * (SCALE * 1.4426950408889634f));
  if (hi == 0) li_l[r32] = l_reg; asm volatile("s_waitcnt lgkmcnt(0)" ::: "memory");
  float rli[16];
#pragma unroll
  for (int r = 0; r < 16; ++r) rli[r] = __builtin_amdgcn_rcpf(li_l[crow(r, hi)]);
  __syncthreads();
  { bf16* stg = (bf16*)(lds + wid * 8192);
#pragma unroll
    for (int r = 0; r < 16; ++r) { const int orow = crow(r, hi);
#pragma unroll
      for (int d0 = 0; d0 < 4; ++d0) stg[orow * 128 + d0 * 32 + r32] = (bf16)(cvtpk(o[d0][r] * rli[r], 0.f) & 0xffffu); }
    asm volatile("s_waitcnt lgkmcnt(0)" ::: "memory");
    bf16* Ow = U.O + (long)(wid * QBLK) * LDQ;
#pragma unroll
    for (int i = 0; i < 8; ++i) { const int row = 4 * i + (lane >> 4), ch = lane & 15; const u32x4 v = *(const u32x4*)(stg + row * 128 + ch * 8);
      *(u32x4*)(Ow + (long)row * LDQ + ch * 8) = v; } }
  __syncthreads();
#undef SLOAD
#undef SWRITE
#undef SWAIT
#undef RESC
#undef MASK
}
#undef KSWZ
#undef SBAR
}
constexpr int DM = 2048, R_CTX = 4096, R_LAT = 8192, RT = 12288, FF = 5632, NGU = 11264, DIN = 12288, HD = 128;
constexpr int NWAVES = 8, NTHR = 512;
constexpr float EPS_N = 1e-6f, SM_SCALE = 0.08838834764831845f;
constexpr size_t MiB = 1u << 20;
constexpr size_t WS_CTL = 0, CTL_ZERO_BYTES = 1 * MiB;
constexpr size_t WS_MODS = 1 * MiB;
constexpr size_t WS_ROPE = 2 * MiB;
constexpr size_t WS_CACHE = 4 * MiB;
constexpr size_t WS_W = 16 * MiB, W_LAYER = 200 * MiB;
constexpr size_t W_GU1 = 0, W_D1 = 44 * MiB, W_IN = 66 * MiB, W_B = 114 * MiB, W_O = 126 * MiB, W_GU2 = 134 * MiB, W_D2 = 178 * MiB;
constexpr size_t WS_H = 416 * MiB;
constexpr size_t WS_ACT = 464 * MiB;
constexpr size_t WS_Z = 596 * MiB;
constexpr size_t WS_QKVG = 884 * MiB;
constexpr size_t WS_END = 1172 * MiB;
constexpr int CW_BAR = 4096;
constexpr int EXCH_OFF = 131072, LDSCTL_OFF = 139264, MISC_OFF = LDSCTL_OFF + 320, LDS_BYTES = 147456;
constexpr size_t OUT_YP = 0, OUT_YS = 8388608, OUT_KGQA = 25165824, OUT_VGQA = 27262976, OUT_KNAT = 29360128, OUT_VNAT = 37748736, OUT_KWIN = 46137344, OUT_VWIN = 48234496, OUT_TOTAL = 50331648;

constexpr int MAP_GU = 1, MAP_IN = 2;
struct Args { const float* in[25]; float* out; unsigned char* ws; };

struct Frame {
    LAS unsigned char* lds;
    int tid, lane, wave, G, bid;
    float* out; unsigned char* ws;
};
#define CAS __attribute__((address_space(4)))
__device__ __forceinline__ const float* in_ptr(int k) { const CAS char* p = (const CAS char*)__builtin_amdgcn_kernarg_segment_ptr(); asm volatile("" : "+s"(p)); return *(const float* const CAS*)(p + 8 * k); }

__device__ __forceinline__ float shx(float v, int mask, int lane) { return __uint_as_float((unsigned)__builtin_amdgcn_ds_bpermute((lane ^ mask) << 2, (int)__float_as_uint(v))); }
__device__ __forceinline__ float wave_sum(float v, int lane) {
#pragma unroll
    for (int o = 1; o < 64; o <<= 1) v += shx(v, o, lane);
    return v;
}
__device__ __forceinline__ float bf2f(unsigned b) { return __uint_as_float(b << 16); }
__device__ __forceinline__ float bflo(unsigned w) { return __uint_as_float(w << 16); }
__device__ __forceinline__ float bfhi(unsigned w) { return __uint_as_float(w & 0xffff0000u); }
__device__ __forceinline__ float sigm(float x) { return 1.f / (1.f + __expf(-x)); }

__device__ __forceinline__ int rowmap(int MAP, int s) {
    if (MAP == 1) { const int n = s >= FF ? 1 : 0, j = s - FF * n, pn = j >> 7, jj = j & 127, wc = jj >> 5, fq = (jj & 31) >> 3, bj = (jj & 7) >> 2, e = jj & 3;
        return 256 * pn + 128 * bj + 32 * wc + 16 * n + 4 * fq + e; }
    if (MAP == 2) { const int pn = s >> 8, c = s & 255, bj = c >> 7, d = c & 127; const bool ropet = pn < 5 || (pn >= 18 && pn < 23);
        if (ropet) { const int h2 = d >> 6, n = (d & 63) >> 5, w1 = (d & 31) >> 4, fq = (d & 15) >> 2, e = d & 3; return 256 * pn + 128 * bj + 32 * (2 * h2 + w1) + 16 * n + 4 * fq + e; }
        const int wc = d >> 5, fq = (d & 31) >> 3, n = (d & 7) >> 2, e = d & 3; return 256 * pn + 128 * bj + 32 * wc + 16 * n + 4 * fq + e; }
    return s;
}
__device__ __forceinline__ void transpose_item(const float* W, int K, int N, bf16* WT, LAS float* scr, int k0, int n0, int lane, int MAP) {
#pragma unroll 4
    for (int i = 0; i < 16; ++i) {
        const int k = 4 * i + (lane >> 4), n4 = lane & 15;
        const f32x4 v = *(const GAS f32x4*)(W + (size_t)(k0 + k) * N + n0 + 4 * n4);
        LAS float* s = scr + k * 65 + 4 * n4; s[0] = v.x; s[1] = v.y; s[2] = v.z; s[3] = v.w;
    }
    LDS_WAIT(); asm volatile("" ::: "memory");
    const int c = lane & 7;
#pragma unroll
    for (int j = 0; j < 8; ++j) {
        const int n = 8 * j + (lane >> 3); const LAS float* s = scr + (8 * c) * 65 + n;
        v4u o; o.x = pk2(s[0], s[65]); o.y = pk2(s[130], s[195]); o.z = pk2(s[260], s[325]); o.w = pk2(s[390], s[455]);
        *(GAS v4u*)(WT + (size_t)rowmap(MAP, n0 + n) * K + k0 + 8 * c) = o;
    }
    LDS_WAIT(); asm volatile("" ::: "memory");
}
__device__ __forceinline__ void transpose_matrix(Frame& F, const float* W, int K, int N, bf16* WT, int MAP) {
    LAS float* scr = (LAS float*)(F.lds + F.wave * 16640);
    const int gw = F.bid * NWAVES + F.wave, NGW = F.G * NWAVES, nb = N / 64, items = (K / 64) * nb;
    for (int it = gw; it < items; it += NGW) transpose_item(W, K, N, WT, scr, 64 * (it / nb), 64 * (it % nb), F.lane, MAP);
}
__device__ __forceinline__ void cvt_array(Frame& F, const float* src, bf16* dst, int n8) {
    for (int i = F.bid * NTHR + F.tid; i < n8; i += F.G * NTHR) {
        const f32x4 a = *(const GAS f32x4*)(src + (size_t)i * 8), b = *(const GAS f32x4*)(src + (size_t)i * 8 + 4);
        v4u o; o.x = pk2(a.x, a.y); o.y = pk2(a.z, a.w); o.z = pk2(b.x, b.y); o.w = pk2(b.z, b.w);
        *(GAS v4u*)(dst + (size_t)i * 8) = o;
    }
}
__device__ __forceinline__ void mods_phase(Frame& F) {
    LAS float* sv = (LAS float*)F.lds;
    LAS f32x4* red = (LAS f32x4*)(F.lds + 24576);
    const float* c_lat = in_ptr(8); const float* c_ctx = in_ptr(9); const float* w_mod = in_ptr(10); const float* b_mod = in_ptr(11);
    float* mods = (float*)(F.ws + WS_MODS);
    for (int i = F.tid; i < 3 * 2048; i += NTHR) { const int g = i >> 11, k = i & 2047; const float c = (g == 0) ? c_ctx[k] : c_lat[(g - 1) * 2048 + k]; sv[i] = c / (1.f + __expf(-c)); }
    __syncthreads();
    for (int cb = F.bid; cb < 256; cb += F.G) {
        const int l = cb >> 7, col0 = (cb & 127) * 144;
        if (F.tid < 504) {
            const int c4 = F.tid % 36, kg = F.tid / 36;
            const GAS f32x4* wp = (const GAS f32x4*)(w_mod + (size_t)l * 2048 * 18432 + col0 + 4 * c4);
            f32x4 a0 = {0.f, 0.f, 0.f, 0.f}, a1 = a0, a2 = a0;
#pragma unroll 4
            for (int k = kg; k < 2048; k += 14) { const f32x4 w = wp[(size_t)k * 4608]; a0 += sv[k] * w; a1 += sv[2048 + k] * w; a2 += sv[4096 + k] * w; }
            red[(kg * 3 + 0) * 36 + c4] = a0; red[(kg * 3 + 1) * 36 + c4] = a1; red[(kg * 3 + 2) * 36 + c4] = a2;
        }
        __syncthreads();
        if (F.tid < 108) {
            const int g = F.tid / 36, c4 = F.tid % 36; f32x4 s = *(const GAS f32x4*)(b_mod + (size_t)l * 18432 + col0 + 4 * c4);
            for (int kg = 0; kg < 14; ++kg) s += red[(kg * 3 + g) * 36 + c4];
            *(GAS f32x4*)(mods + (size_t)(l * 3 + g) * 18432 + col0 + 4 * c4) = s;
        }
        __syncthreads();
    }
}
__device__ __forceinline__ void prologue(Frame& F) {
    unsigned char* ws = F.ws;
    for (int l = 0; l < 2; ++l) {
        unsigned char* wl = ws + WS_W + (size_t)l * W_LAYER;
        transpose_matrix(F, in_ptr(13) + (size_t)l * DM * NGU, DM, NGU, (bf16*)(wl + W_GU1), MAP_GU);
        transpose_matrix(F, in_ptr(14) + (size_t)l * FF * DM, FF, DM, (bf16*)(wl + W_D1), 0);
        transpose_matrix(F, in_ptr(15) + (size_t)l * DM * DIN, DM, DIN, (bf16*)(wl + W_IN), MAP_IN);
        for (int i = 0; i < 3; ++i) transpose_matrix(F, in_ptr(20) + (size_t)(l * 3 + i) * 1024 * DM, 1024, DM, (bf16*)(wl + W_B) + (size_t)i * DM * 1024, 0);
        transpose_matrix(F, in_ptr(21) + (size_t)l * DM * DM, DM, DM, (bf16*)(wl + W_O), 0);
        transpose_matrix(F, in_ptr(22) + (size_t)l * DM * NGU, DM, NGU, (bf16*)(wl + W_GU2), MAP_GU);
        transpose_matrix(F, in_ptr(23) + (size_t)l * FF * DM, FF, DM, (bf16*)(wl + W_D2), 0);
    }
    cvt_array(F, in_ptr(2), (bf16*)(ws + WS_CACHE), 524288 / 8);
    cvt_array(F, in_ptr(3), (bf16*)(ws + WS_CACHE + 1 * MiB), 524288 / 8);
    cvt_array(F, in_ptr(6), (bf16*)(ws + WS_CACHE + 2 * MiB), 524288 / 8);
    cvt_array(F, in_ptr(7), (bf16*)(ws + WS_CACHE + 3 * MiB), 524288 / 8);
    cvt_array(F, in_ptr(4), (bf16*)(ws + WS_CACHE + 4 * MiB), 2097152 / 8);
    cvt_array(F, in_ptr(5), (bf16*)(ws + WS_CACHE + 8 * MiB), 2097152 / 8);
    { float* ct = (float*)(ws + WS_ROPE); float* st = ct + 2048;
      for (int i = F.bid * NTHR + F.tid; i < 2048; i += F.G * NTHR) { const int pos = i >> 5, f = i & 31;
          const float inv = exp2f(-(float)f * (13.287712379549449f / 32.0f)); const float ang = (float)pos * inv;
          const float kf = rintf(ang * 0.6366197723675814f); float r = fmaf(-kf, 1.5707962512969971f, ang); r = fmaf(-kf, 7.5497894158615964e-08f, r); r = fmaf(-kf, 5.3903029534742384e-15f, r);
          const float r2 = r * r;
          const float sn = r + r * r2 * (-1.6666667e-1f + r2 * (8.3333338e-3f + r2 * (-1.9841270e-4f + r2 * 2.7557319e-6f)));
          const float cs = 1.0f + r2 * (-0.5f + r2 * (4.1666668e-2f + r2 * (-1.3888889e-3f + r2 * (2.4801587e-5f + r2 * -2.7557319e-7f))));
          const int q = ((int)kf) & 3; const float sv_ = (q == 0) ? sn : (q == 1) ? cs : (q == 2) ? -sn : -cs, cv_ = (q == 0) ? cs : (q == 1) ? -sn : (q == 2) ? -cs : sn;
          ct[i] = cv_; st[i] = sv_; } }
    __syncthreads();
    mods_phase(F);
}

__device__ __forceinline__ void adaln_phase(Frame& F, int l, int which, bool from_inputs) {
    const float* X = F.out; bf16* H = (bf16*)(F.ws + WS_H); const float* mods = (const float*)(F.ws + WS_MODS);
    const float* gn = in_ptr(12) + (size_t)(l * 3 + which) * DM; const float* xin0 = in_ptr(0); const float* xin1 = in_ptr(1);
    const int gw = F.bid * NWAVES + F.wave, NGW = F.G * NWAVES, lane = F.lane;
    for (int row = gw; row < RT; row += NGW) {
        const int g = row < R_CTX ? 0 : 1 + ((row - R_CTX) >> 12);
        const float* src = from_inputs ? (row < R_CTX ? xin0 + (size_t)row * DM : xin1 + (size_t)(row - R_CTX) * DM) : X + (size_t)row * DM;
        f32x4 v[8];
#pragma unroll
        for (int j = 0; j < 8; ++j) v[j] = ((const GAS f32x4*)src)[64 * j + lane];
        float ss = 0.f;
#pragma unroll
        for (int j = 0; j < 8; ++j) ss += (v[j].x * v[j].x + v[j].y * v[j].y) + (v[j].z * v[j].z + v[j].w * v[j].w);
        const float rstd = 1.0f / sqrtf(wave_sum(ss, lane) * (1.0f / DM) + EPS_N);
        const GAS f32x4* gnp = (const GAS f32x4*)gn; const float* mg = mods + (size_t)(l * 3 + g) * 18432 + (size_t)which * 3 * DM;
        const GAS f32x4* shp = (const GAS f32x4*)mg; const GAS f32x4* scp = (const GAS f32x4*)(mg + DM);
        GAS unsigned long long* o8 = (GAS unsigned long long*)(H + (size_t)row * DM);
#pragma unroll
        for (int j = 0; j < 8; ++j) {
            const f32x4 a = gnp[64 * j + lane] * (1.0f + scp[64 * j + lane]) * rstd, b = shp[64 * j + lane]; const f32x4 h = v[j] * a + b;
            o8[64 * j + lane] = (unsigned long long)pk2(h.x, h.y) | ((unsigned long long)pk2(h.z, h.w) << 32);
        }
    }
}
__device__ __forceinline__ void final_phase(Frame& F) {
    float* X = F.out; const GAS f32x4* gf = (const GAS f32x4*)in_ptr(24);
    const int gw = F.bid * NWAVES + F.wave, NGW = F.G * NWAVES, lane = F.lane;
    for (int row = gw; row < RT; row += NGW) {
        GAS f32x4* xr = (GAS f32x4*)(X + (size_t)row * DM);
        f32x4 v[8];
#pragma unroll
        for (int j = 0; j < 8; ++j) v[j] = xr[64 * j + lane];
        float ss = 0.f;
#pragma unroll
        for (int j = 0; j < 8; ++j) ss += (v[j].x * v[j].x + v[j].y * v[j].y) + (v[j].z * v[j].z + v[j].w * v[j].w);
        const float rstd = 1.0f / sqrtf(wave_sum(ss, lane) * (1.0f / DM) + EPS_N);
#pragma unroll
        for (int j = 0; j < 8; ++j) xr[64 * j + lane] = v[j] * rstd * gf[64 * j + lane];
    }
}
__device__ __forceinline__ bool make_unit(Frame& F, int l, int id, att::Unit& U) {
    if (id >= 1152) return false;
    unsigned char* qb = F.ws + WS_QKVG;
    const bf16* QA = (const bf16*)qb; const bf16* QB = (const bf16*)(qb + 24 * MiB); const bf16* QC = (const bf16*)(qb + 48 * MiB); const bf16* KB = (const bf16*)(qb + 72 * MiB); const bf16* VB = (const bf16*)(qb + 96 * MiB);
    const bf16* KA = (const bf16*)(qb + 120 * MiB); const bf16* VA = (const bf16*)(qb + 126 * MiB); const bf16* KC = (const bf16*)(qb + 132 * MiB); const bf16* VC = (const bf16*)(qb + 138 * MiB);
    const bf16* CKA = (const bf16*)(F.ws + WS_CACHE); const bf16* CVA = (const bf16*)(F.ws + WS_CACHE + 1 * MiB); const bf16* CKC = (const bf16*)(F.ws + WS_CACHE + 2 * MiB); const bf16* CVC = (const bf16*)(F.ws + WS_CACHE + 3 * MiB);
    const bf16* CKB = (const bf16*)(F.ws + WS_CACHE + 4 * MiB); const bf16* CVB = (const bf16*)(F.ws + WS_CACHE + 8 * MiB);
    bf16* O = (bf16*)(F.ws + WS_ACT);
    const float LOG2E = 1.4426950408889634f;
    U.mode = 0; U.a = 0; U.b = 0; U.sink2 = -__builtin_inff(); U.tab = in_ptr(18); U.n0 = 0;
    if (id < 768) {
        const int type = id >> 8, v = id & 255, xcd = v & 7, j = v >> 3; int b, h, q;
        if (type != 1) { const int combo = xcd >> 1, idx = (xcd & 1) * 32 + j; b = combo >> 1; h = (combo & 1) * 4 + (idx >> 4); q = idx & 15; }
        else { const int combo = xcd * 2 + (j >> 4); b = combo >> 3; h = combo & 7; q = j & 15; }
        const size_t lat0 = R_CTX + (size_t)b * 4096, row0 = lat0 + (size_t)q * 256, cb = (size_t)(b * 2 + l) * 512;
        U.n0 = 8;
        if (type == 0) { const int kvh = h >> 2; U.ldk = 256;
            U.Q = QA + row0 * 1024 + h * 128; U.O = O + row0 * 1024 + h * 128;
            U.K0 = CKA + cb * 256 + kvh * 128; U.V0 = CVA + cb * 256 + kvh * 128; U.K1 = KA + lat0 * 256 + kvh * 128; U.V1 = VA + lat0 * 256 + kvh * 128; U.n1 = 64; }
        else if (type == 1) { U.ldk = 1024; const int R0 = q * 4, kr0 = min(max(R0 - 4, 0), 52);
            U.Q = QB + row0 * 1024 + h * 128; U.O = O + (size_t)RT * 1024 + row0 * 1024 + h * 128;
            U.K0 = CKB + cb * 1024 + h * 128; U.V0 = CVB + cb * 1024 + h * 128; U.K1 = KB + (lat0 + (size_t)kr0 * 64) * 1024 + h * 128; U.V1 = VB + (lat0 + (size_t)kr0 * 64) * 1024 + h * 128; U.n1 = 12;
            U.mode = 1; U.a = R0; U.b = kr0; U.tab = in_ptr(18) + (size_t)(l * 8 + h) * 465; }
        else { const int kvh = h >> 2; U.ldk = 256; const int kp0 = max(q * 256 - 128, 0), kp1 = min(q * 256 + 384, 4096);
            U.Q = QC + row0 * 1024 + h * 128; U.O = O + (size_t)2 * RT * 1024 + row0 * 1024 + h * 128;
            U.K0 = CKC + cb * 256 + kvh * 128; U.V0 = CVC + cb * 256 + kvh * 128; U.K1 = KC + (lat0 + kp0) * 256 + kvh * 128; U.V1 = VC + (lat0 + kp0) * 256 + kvh * 128; U.n1 = (kp1 - kp0) >> 6;
            U.mode = 2; U.a = q * 256; U.b = kp0; U.sink2 = in_ptr(19)[l * 8 + h] * LOG2E; }
    } else {
        const int v = id - 768, b = v / 24, rem = v - 24 * b, br = rem >> 3, h = rem & 7; const size_t row0 = (size_t)b * 256;
        const int kvh = br == 1 ? h : (h >> 2); U.ldk = br == 1 ? 1024 : 256;
        const bf16* Qx = br == 0 ? QA : br == 1 ? QB : QC; const bf16* Kx = br == 0 ? KA : br == 1 ? KB : KC; const bf16* Vx = br == 0 ? VA : br == 1 ? VB : VC;
        U.Q = Qx + row0 * 1024 + h * 128; U.O = O + (size_t)br * RT * 1024 + row0 * 1024 + h * 128;
        U.K1 = Kx + row0 * U.ldk + kvh * 128; U.V1 = Vx + row0 * U.ldk + kvh * 128; U.K0 = U.K1; U.V0 = U.V1; U.n1 = 4;
        if (br == 2) U.sink2 = in_ptr(19)[l * 8 + h] * LOG2E;
    }
    return true;
}
__device__ __forceinline__ void attn_phase(Frame& F, int l, char* lds) {
    for (int id = F.bid; ; id += F.G) { att::Unit U; if (!make_unit(F, l, id, U)) break; att::attn_unit(U, lds, F.tid); }
}

namespace pg8 {
struct EpiSwiglu {
    static constexpr bool PERM = false, AFTER_DRAIN = false;
    bf16_t* ACT;
    __device__ __forceinline__ void operator()(const f32x4 (&acc)[2][2][4][2], const Unit& u, int wr, int wc, int fr, int fq) const {
        const int row0 = u.pm * BM + wr * 64 + fr, col0 = u.pn * 128 + wc * 32 + 8 * fq;
#pragma unroll
        for (int ai = 0; ai < 2; ++ai)
#pragma unroll
            for (int m = 0; m < 4; ++m) { u32x4 w;
#pragma unroll
                for (int bj = 0; bj < 2; ++bj) { const f32x4 a = acc[ai][bj][m][0], b = acc[ai][bj][m][1]; f32x4 r;
#pragma unroll
                    for (int e = 0; e < 4; ++e) r[e] = a[e] * __builtin_amdgcn_rcpf(1.0f + __expf(-a[e])) * b[e];
                    w[2 * bj] = cvt_pk_bf16(r[0], r[1]); w[2 * bj + 1] = cvt_pk_bf16(r[2], r[3]); }
                *(u32x4*)(ACT + (size_t)(row0 + ai * HALF + m * 16) * 5632 + col0) = w; }
    }
};
struct EpiResid {
    static constexpr bool PERM = false, AFTER_DRAIN = false;
    float* X; const float* base_ctx; const float* base_lat; const float* gate; float coef;
    __device__ __forceinline__ void operator()(const f32x4 (&acc)[2][2][4][2], const Unit& u, int wr, int wc, int fr, int fq) const {
        const int col0 = u.pn * BM + wc * 32 + 4 * fq;
        const int grp = u.pm < 16 ? 0 : (u.pm < 32 ? 1 : 2);
        const float* bs = u.pm < 16 ? base_ctx + (size_t)u.pm * BM * 2048 : base_lat + (size_t)(u.pm - 16) * BM * 2048;
        f32x4 gv[2][2];
#pragma unroll
        for (int bj = 0; bj < 2; ++bj)
#pragma unroll
            for (int n = 0; n < 2; ++n) gv[bj][n] = *(const f32x4*)(gate + (size_t)grp * 18432 + col0 + bj * HALF + n * 16) * coef;
#pragma unroll
        for (int ai = 0; ai < 2; ++ai)
#pragma unroll
            for (int m = 0; m < 4; ++m) { const int rl = wr * 64 + fr + ai * HALF + m * 16; const size_t off = (size_t)rl * 2048 + col0;
#pragma unroll
                for (int bj = 0; bj < 2; ++bj)
#pragma unroll
                    for (int n = 0; n < 2; ++n) { const f32x4 b = *(const f32x4*)(bs + off + bj * HALF + n * 16);
                        *(f32x4*)(X + (size_t)u.pm * BM * 2048 + off + bj * HALF + n * 16) = b + gv[bj][n] * acc[ai][bj][m][n]; } }
    }
};
struct EpiBranch {
    static constexpr bool PERM = false, AFTER_DRAIN = false;
    float* M32; bf16_t* Mb; const bf16_t* GT;
    __device__ __forceinline__ void operator()(const f32x4 (&acc)[2][2][4][2], const Unit& u, int wr, int wc, int fr, int fq) const {
        const int br = u.pm / 48, pm = u.pm - 48 * br, pn = u.pn & 7;
        const int row0 = pm * BM + wr * 64 + fr, col0 = pn * BM + wc * 32 + 4 * fq;
#pragma unroll
        for (int ai = 0; ai < 2; ++ai)
#pragma unroll
            for (int m = 0; m < 4; ++m) { const size_t row = (size_t)(row0 + ai * HALF + m * 16);
#pragma unroll
                for (int bj = 0; bj < 2; ++bj)
#pragma unroll
                    for (int n = 0; n < 2; ++n) { const int col = col0 + bj * HALF + n * 16;
                        const unsigned long long gg = *(const unsigned long long*)(GT + row * 6144 + br * 2048 + col); const unsigned g0 = (unsigned)gg, g1 = (unsigned)(gg >> 32);
                        f32x4 v = acc[ai][bj][m][n]; v[0] *= __uint_as_float(g0 << 16); v[1] *= __uint_as_float(g0 & 0xffff0000u); v[2] *= __uint_as_float(g1 << 16); v[3] *= __uint_as_float(g1 & 0xffff0000u);
                        float* mp = M32 + row * 2048 + col;
                        if (br == 0) *(f32x4*)mp = v;
                        else if (br == 1) *(f32x4*)mp = *(const f32x4*)mp + v;
                        else { const f32x4 t = *(const f32x4*)mp + v; *(unsigned long long*)(Mb + row * 2048 + col) = (unsigned long long)cvt_pk_bf16(t[0], t[1]) | ((unsigned long long)cvt_pk_bf16(t[2], t[3]) << 32); } } }
    }
};
struct EpiInproj {
    static constexpr bool PERM = false, AFTER_DRAIN = false;
    unsigned char* qkvg; float* out; const float* gq; const float* gk; const float* ropec; int l; PG8_LAS float* P;
    __device__ __forceinline__ void operator()(const f32x4 (&acc)[2][2][4][2], const Unit& u, int wr, int wc, int fr, int fq) const {
        constexpr size_t MiB_ = 1u << 20;
        const int pn = u.pn; const bool isctx = u.pm < 16;
        bf16_t* dst; int dld; float* fo = nullptr; int fld = 0; int kind = 0, norm = 0;
        if (pn < 4)        { dst = (bf16_t*)qkvg + pn * 256; dld = 1024; kind = 1; norm = 1; }
        else if (pn == 4)  { dst = (bf16_t*)(qkvg + 120 * MiB_); dld = 256; kind = 1; norm = 2; fo = out + 25165824; fld = 256; }
        else if (pn == 5)  { dst = (bf16_t*)(qkvg + 126 * MiB_); dld = 256; fo = out + 27262976; fld = 256; }
        else if (pn < 10)  { dst = (bf16_t*)(qkvg + 24 * MiB_) + (pn - 6) * 256; dld = 1024; }
        else if (pn < 14)  { dst = (bf16_t*)(qkvg + 72 * MiB_) + (pn - 10) * 256; dld = 1024; fo = out + 29360128 + (pn - 10) * 256; fld = 1024; }
        else if (pn < 18)  { dst = (bf16_t*)(qkvg + 96 * MiB_) + (pn - 14) * 256; dld = 1024; fo = out + 37748736 + (pn - 14) * 256; fld = 1024; }
        else if (pn < 22)  { dst = (bf16_t*)(qkvg + 48 * MiB_) + (pn - 18) * 256; dld = 1024; kind = 1; }
        else if (pn == 22) { dst = (bf16_t*)(qkvg + 132 * MiB_); dld = 256; kind = 1; fo = out + 46137344; fld = 256; }
        else if (pn == 23) { dst = (bf16_t*)(qkvg + 138 * MiB_); dld = 256; fo = out + 48234496; fld = 256; }
        else               { dst = (bf16_t*)(qkvg + 144 * MiB_) + (pn - 24) * 256; dld = 6144; kind = 2; }
        if (!isctx) fo = nullptr;
        const int rl0 = wr * 64 + fr;
        const size_t grow0 = (size_t)u.pm * BM;
        const size_t frow0 = ((size_t)(u.pm * 2 + l)) * 256;
        if (kind != 1) {
            const int c0 = 32 * wc + 8 * fq;
#pragma unroll
            for (int ai = 0; ai < 2; ++ai)
#pragma unroll
                for (int m = 0; m < 4; ++m) { const int rl = rl0 + ai * HALF + m * 16;
#pragma unroll
                    for (int bj = 0; bj < 2; ++bj) { f32x4 a = acc[ai][bj][m][0], b = acc[ai][bj][m][1];
                        if (kind == 2) {
#pragma unroll
                            for (int e = 0; e < 4; ++e) { a[e] = __builtin_amdgcn_rcpf(1.0f + __expf(-a[e])); b[e] = __builtin_amdgcn_rcpf(1.0f + __expf(-b[e])); } }
                        u32x4 w; w.x = cvt_pk_bf16(a[0], a[1]); w.y = cvt_pk_bf16(a[2], a[3]); w.z = cvt_pk_bf16(b[0], b[1]); w.w = cvt_pk_bf16(b[2], b[3]);
                        *(u32x4*)(dst + (grow0 + rl) * dld + bj * HALF + c0) = w;
                        if (fo) { float* fp = fo + (frow0 + rl) * fld + bj * HALF + c0; *(f32x4*)fp = a; *(f32x4*)(fp + 4) = b; } } }
            return;
        }
        const int db = 64 * (wc >> 1) + 16 * (wc & 1) + 4 * fq;
        if (norm) {
#pragma unroll
            for (int ai = 0; ai < 2; ++ai)
#pragma unroll
                for (int m = 0; m < 4; ++m)
#pragma unroll
                    for (int bj = 0; bj < 2; ++bj) { const f32x4 a = acc[ai][bj][m][0], b = acc[ai][bj][m][1];
                        float ss = (a[0] * a[0] + a[1] * a[1]) + (a[2] * a[2] + a[3] * a[3]) + (b[0] * b[0] + b[1] * b[1]) + (b[2] * b[2] + b[3] * b[3]);
                        ss += shx(ss, 16, 16 * fq + fr); ss += shx(ss, 32, 16 * fq + fr);
                        if (fq == 0) P[((rl0 + ai * HALF + m * 16) * 2 + bj) * 4 + wc] = ss; }
            asm volatile("s_waitcnt lgkmcnt(0)" ::: "memory"); __builtin_amdgcn_s_barrier(); asm volatile("" ::: "memory");
        }
        f32x4 g0 = {1.f, 1.f, 1.f, 1.f}, g1 = g0;
        if (norm) { const float* gg = norm == 1 ? gq : gk; g0 = *(const f32x4*)(gg + db); g1 = *(const f32x4*)(gg + db + 32); }
        const int fi = 16 * (wc & 1) + 4 * fq;
#pragma unroll
        for (int ai = 0; ai < 2; ++ai)
#pragma unroll
            for (int m = 0; m < 4; ++m) { const int rl = rl0 + ai * HALF + m * 16;
                f32x4 cs = {1.f, 1.f, 1.f, 1.f}, sn = {0.f, 0.f, 0.f, 0.f};
                if (!isctx) { const int nl = (int)((grow0 + rl - 4096) & 4095); const int pos = (wc >> 1) ? (nl & 63) : (nl >> 6);
                    cs = *(const f32x4*)(ropec + pos * 32 + fi); sn = *(const f32x4*)(ropec + 2048 + pos * 32 + fi); }
#pragma unroll
                for (int bj = 0; bj < 2; ++bj) { f32x4 a = acc[ai][bj][m][0], b = acc[ai][bj][m][1];
                    if (norm) { const f32x4 pp = *(const PG8_LAS f32x4*)(P + (rl * 2 + bj) * 4); const float rstd = 1.0f / sqrtf(((pp[0] + pp[1]) + (pp[2] + pp[3])) * (1.0f / 128.0f) + 1e-6f);
                        a = a * rstd * g0; b = b * rstd * g1; }
                    const f32x4 y1 = a * cs - b * sn, y2 = b * cs + a * sn;
                    bf16_t* dp = dst + (grow0 + rl) * dld + bj * HALF + db;
                    *(unsigned long long*)dp = (unsigned long long)cvt_pk_bf16(y1[0], y1[1]) | ((unsigned long long)cvt_pk_bf16(y1[2], y1[3]) << 32);
                    *(unsigned long long*)(dp + 32) = (unsigned long long)cvt_pk_bf16(y2[0], y2[1]) | ((unsigned long long)cvt_pk_bf16(y2[2], y2[3]) << 32);
                    if (fo) { float* fp = fo + (frow0 + rl) * fld + bj * HALF + db; *(f32x4*)fp = y1; *(f32x4*)(fp + 32) = y2; } } }
    }
};
struct EpiF32 {
    static constexpr bool PERM = false, AFTER_DRAIN = false;
    float* C; int ldc;
    __device__ __forceinline__ void operator()(const f32x4 (&acc)[2][2][4][2], const Unit& u, int wr, int wc, int fr, int fq) const {
        const int row0 = u.pm * BM + wr * 64 + fr, col0 = u.pn * BM + wc * 32 + 4 * fq;
#pragma unroll
        for (int ai = 0; ai < 2; ++ai)
#pragma unroll
            for (int m = 0; m < 4; ++m) { float* rowp = C + (size_t)(row0 + ai * HALF + m * 16) * ldc + col0;
#pragma unroll
                for (int bj = 0; bj < 2; ++bj)
#pragma unroll
                    for (int n = 0; n < 2; ++n) *(f32x4*)(rowp + bj * HALF + n * 16) = acc[ai][bj][m][n]; }
    }
};
struct BranchOrder {
    int G, c;
    __device__ __forceinline__ bool next(int i, Unit& u) const { const int j = i / 3, br = i - 3 * j; const int tile = j * G + c; if (tile >= 384) return false;
        u.pm = br * 48 + (tile >> 3); u.pn = br * 8 + (tile & 7); return true; }
    __device__ __forceinline__ void a_ready(const Unit&) const {}
    __device__ __forceinline__ void done(const Unit&) const {}
};
struct EpiBranchF32 {
    static constexpr bool PERM = false, AFTER_DRAIN = false;
    float* Y3;
    __device__ __forceinline__ void operator()(const f32x4 (&acc)[2][2][4][2], const Unit& u, int wr, int wc, int fr, int fq) const {
        const int br = u.pm / 48, pm = u.pm - 48 * br, pn = u.pn & 7;
        const int row0 = pm * BM + wr * 64 + fr, col0 = pn * BM + wc * 32 + 4 * fq; float* base = Y3 + (size_t)br * 12288 * 2048;
#pragma unroll
        for (int ai = 0; ai < 2; ++ai)
#pragma unroll
            for (int m = 0; m < 4; ++m) { float* rowp = base + (size_t)(row0 + ai * HALF + m * 16) * 2048 + col0;
#pragma unroll
                for (int bj = 0; bj < 2; ++bj)
#pragma unroll
                    for (int n = 0; n < 2; ++n) *(f32x4*)(rowp + bj * HALF + n * 16) = acc[ai][bj][m][n]; }
    }
};
}

__global__ void __launch_bounds__(NTHR, 2) mega_fwd(Args args) {
    extern __shared__ __attribute__((aligned(16))) unsigned char lds[];
    Frame F;
    F.lds = (LAS unsigned char*)lds; F.tid = threadIdx.x; F.lane = F.tid & 63; F.wave = __builtin_amdgcn_readfirstlane(F.tid >> 6); F.G = gridDim.x; F.bid = blockIdx.x;
    F.out = (float*)in_ptr(25); F.ws = (unsigned char*)in_ptr(26);
    for (int u = F.tid; u < (LDS_BYTES - LDSCTL_OFF) / 4; u += NTHR) ((LAS unsigned*)(F.lds + LDSCTL_OFF))[u] = 0u;
    __syncthreads();
    volatile LAS unsigned* MISC = (volatile LAS unsigned*)(F.lds + MISC_OFF);
    XcdBarrier bar = xcd_barrier_post((unsigned*)(F.ws + WS_CTL) + CW_BAR, MISC + 8, F.tid);
#define RELAUNDER() do { asm volatile("v_mbcnt_lo_u32_b32 %0, -1, 0\n\tv_mbcnt_hi_u32_b32 %0, -1, %0" : "=v"(F.lane)); \
    asm volatile("" : "+s"(F.wave), "+s"(F.bid), "+s"(F.G), "+s"(F.ws), "+s"(F.out), "+s"(bar.bar), "+s"(bar.x)); F.tid = F.wave * 64 + F.lane; } while (0)
#define GRID_BAR() do { RELAUNDER(); xcd_barrier(bar, F.tid); RELAUNDER(); } while (0)

    prologue(F); GRID_BAR();

    for (int l = 0; l < 2; ++l) {
        unsigned char* wl = F.ws + WS_W + (size_t)l * W_LAYER;
        const float* modl = (const float*)(F.ws + WS_MODS) + (size_t)l * 3 * 18432;
        adaln_phase(F, l, 0, l == 0); GRID_BAR();
        { pg8::Gemm g{(const bf16*)(F.ws + WS_H), (const bf16*)(wl + W_GU1), RT, NGU, DM}; pg8::StaticOrder S; S.init(RT, NGU, F.G, F.bid);
          pg8::EpiSwiglu E{(bf16*)(F.ws + WS_ACT)};
          pg8::gemm_phase<pg8::EpiSwiglu, pg8::StaticOrder, true, true>(F.lds, g, S, E, F.tid); }
        GRID_BAR();
        { pg8::Gemm g{(const bf16*)(F.ws + WS_ACT), (const bf16*)(wl + W_D1), RT, DM, FF}; pg8::StaticOrder S; S.init(RT, DM, F.G, F.bid);
          pg8::EpiResid E{F.out, l == 0 ? in_ptr(0) : F.out, l == 0 ? in_ptr(1) : F.out + (size_t)R_CTX * DM, modl + 2 * DM, 0.5f};
          pg8::gemm_phase<pg8::EpiResid, pg8::StaticOrder, true, true>(F.lds, g, S, E, F.tid); }
        GRID_BAR();
        adaln_phase(F, l, 1, false); GRID_BAR();
        { pg8::Gemm g{(const bf16*)(F.ws + WS_H), (const bf16*)(wl + W_IN), RT, DIN, DM}; pg8::StaticOrder S; S.init(RT, DIN, F.G, F.bid);
          pg8::EpiInproj E{F.ws + WS_QKVG, F.out, in_ptr(16) + l * HD, in_ptr(17) + l * HD, (const float*)(F.ws + WS_ROPE), l, (LAS float*)(F.lds + EXCH_OFF)};
          pg8::gemm_phase<pg8::EpiInproj, pg8::StaticOrder, true, true>(F.lds, g, S, E, F.tid); }
        GRID_BAR();
        attn_phase(F, l, (char*)lds); GRID_BAR();
        { pg8::Gemm g{(const bf16*)(F.ws + WS_ACT)  , (const bf16*)(wl + W_B), 3 * RT, 3 * DM, 1024}; pg8::BranchOrder S{F.G, F.bid};
          pg8::EpiBranch E{(float*)(F.ws + WS_Z), (bf16*)(F.ws + WS_H), (const bf16*)(F.ws + WS_QKVG + 144 * MiB)};
          pg8::gemm_phase<pg8::EpiBranch, pg8::BranchOrder, true, true>(F.lds, g, S, E, F.tid); }
        GRID_BAR();
        { pg8::Gemm g{(const bf16*)(F.ws + WS_H)  , (const bf16*)(wl + W_O), RT, DM, DM}; pg8::StaticOrder S; S.init(RT, DM, F.G, F.bid);
          pg8::EpiResid E{F.out, F.out, F.out + (size_t)R_CTX * DM, modl + 5 * DM, 1.0f};
          pg8::gemm_phase<pg8::EpiResid, pg8::StaticOrder, true, true>(F.lds, g, S, E, F.tid); }
        GRID_BAR();
        adaln_phase(F, l, 2, false); GRID_BAR();
        { pg8::Gemm g{(const bf16*)(F.ws + WS_H), (const bf16*)(wl + W_GU2), RT, NGU, DM}; pg8::StaticOrder S; S.init(RT, NGU, F.G, F.bid);
          pg8::EpiSwiglu E{(bf16*)(F.ws + WS_ACT)};
          pg8::gemm_phase<pg8::EpiSwiglu, pg8::StaticOrder, true, true>(F.lds, g, S, E, F.tid); }
        GRID_BAR();
        { pg8::Gemm g{(const bf16*)(F.ws + WS_ACT), (const bf16*)(wl + W_D2), RT, DM, FF}; pg8::StaticOrder S; S.init(RT, DM, F.G, F.bid);
          pg8::EpiResid E{F.out, F.out, F.out + (size_t)R_CTX * DM, modl + 8 * DM, 0.5f};
          pg8::gemm_phase<pg8::EpiResid, pg8::StaticOrder, true, true>(F.lds, g, S, E, F.tid); }
        GRID_BAR();
    }
    final_phase(F);
#undef GRID_BAR
}

extern "C" void kernel_launch(void* const* d_in, const int* in_sizes, int n_in, void* d_out, int out_size, void* d_ws, size_t ws_size, hipStream_t stream) {
    static int grid = 0;
    if (grid == 0) {
        if (n_in != 25 || out_size != (int)OUT_TOTAL || ws_size < WS_END) { fprintf(stderr, "kernel_launch: unexpected shapes: n_in %d out %d ws %zu (need %zu)\n", n_in, out_size, ws_size, (size_t)WS_END); grid = -1; return; }
        int dev = 0, cus = 0, per_cu = 0;
        if (hipGetDevice(&dev) != hipSuccess || hipDeviceGetAttribute(&cus, hipDeviceAttributeMultiprocessorCount, dev) != hipSuccess) { grid = -1; return; }
        if (hipFuncSetAttribute((const void*)mega_fwd, hipFuncAttributeMaxDynamicSharedMemorySize, LDS_BYTES) != hipSuccess) { fprintf(stderr, "kernel_launch: hipFuncSetAttribute failed\n"); grid = -1; return; }
        if (hipOccupancyMaxActiveBlocksPerMultiprocessor(&per_cu, (const void*)mega_fwd, NTHR, LDS_BYTES) != hipSuccess || per_cu < 1) { fprintf(stderr, "kernel_launch: occupancy query says %d\n", per_cu); (void)hipGetLastError(); grid = -1; return; }
        grid = cus;
    }
    if (grid < 0) return;
    if (hipMemsetAsync((char*)d_ws + WS_CTL, 0, CTL_ZERO_BYTES, stream) != hipSuccess) return;
    Args a{};
    for (int i = 0; i < 25; ++i) a.in[i] = (const float*)d_in[i];
    a.out = (float*)d_out; a.ws = (unsigned char*)d_ws;
    hipLaunchKernelGGL(mega_fwd, dim3(grid), dim3(NTHR), LDS_BYTES, stream, a);
}
```

```cpp
#include <hip/hip_runtime.h>
#include <cstdio>
#include <cstdint>
namespace pg8 {
#define PG8_LAS __attribute__((address_space(3)))
typedef unsigned short bf16_t;
typedef short bf16x8 __attribute__((ext_vector_type(8)));
typedef float f32x4 __attribute__((ext_vector_type(4)));
typedef unsigned u32x4 __attribute__((ext_vector_type(4)));
constexpr int BM = 256, BK = 64, HALF = 128, HTB = HALF * BK * 2  , STAGE_BYTES = 8 * HTB, NXCD = 8, WGM = 8;

__host__ __device__ __forceinline__ int lds_byte(int r, int c) { const int st = (r >> 4) * 2 + (c >> 5), rr = r & 15, cc = c & 31, ob = rr * 64 + cc * 2; return st * 1024 + (ob ^ (((ob >> 9) & 1) << 5)); }
__host__ __device__ __forceinline__ void stage_rc(int b, int& R, int& C) { const int st = b / 1024, sb = b % 1024, swz = sb ^ (((sb >> 9) & 1) << 5); R = (st >> 1) * 16 + swz / 64; C = (st & 1) * 32 + (swz % 64) / 2; }
__host__ __device__ __forceinline__ int perm32(int rho) { const int n = rho >> 4, i = rho & 15; return 8 * (i >> 2) + 4 * n + (i & 3); }

struct Unit { int pm, pn; };
struct Gemm { const bf16_t* A; const bf16_t* Bt; int M, N, K; };

struct StaticOrder {
    int nM, nN, nwg, G, c;
    __host__ __device__ void init(int M, int N, int G_, int c_) { nM = M / BM; nN = N / BM; nwg = nM * nN; G = G_; c = c_; }
    __host__ __device__ bool next(int i, Unit& u) const {
        const long L = (long)i * G + c; if (L >= nwg) return false;
        int wgid = (int)L; { const int q = nwg / NXCD, r = nwg % NXCD, xcd = wgid % NXCD, off = wgid / NXCD; wgid = (xcd < r ? xcd * (q + 1) : r * (q + 1) + (xcd - r) * q) + off; }
        const int nig = WGM * nN, gid = wgid / nig, fm = gid * WGM, gsz = (nM - fm) < WGM ? (nM - fm) : WGM;
        u.pm = fm + ((wgid % nig) % gsz); u.pn = (wgid % nig) / gsz; return true;
    }
    __device__ __forceinline__ void a_ready(const Unit&) const {}
    __device__ __forceinline__ void done(const Unit&) const {}
};

__device__ __forceinline__ unsigned cvt_pk_bf16(float lo, float hi) { unsigned r; asm volatile("v_cvt_pk_bf16_f32 %0, %1, %2" : "=v"(r) : "v"(lo), "v"(hi)); return r; }
typedef float f32x2 __attribute__((ext_vector_type(2)));
__device__ __forceinline__ f32x2 gelu_pk(f32x2 v) {
    const f32x2 av = __builtin_elementwise_abs(v), d = av * 0.2316418882f + 1.0f;
    f32x2 t; t.x = __builtin_amdgcn_rcpf(d.x); t.y = __builtin_amdgcn_rcpf(d.y);
    f32x2 q = t * 0.5307027145f + (-0.7265760135f); q = q * t + 0.7107068705f; q = q * t + (-0.142248368f); q = q * t + 0.127414796f; q = q * t;
    const f32x2 s = (v * v) * (-0.72134752044f);
    f32x2 e; e.x = __builtin_amdgcn_exp2f(s.x); e.y = __builtin_amdgcn_exp2f(s.y);
    const f32x2 m = v * (q * e), r = v - m;
    f32x2 o; o.x = v.x < 0.f ? m.x : r.x; o.y = v.y < 0.f ? m.y : r.y; return o;
}

template <int ACT  > struct EpiBf16 {
    static constexpr bool PERM = true, AFTER_DRAIN = false; static_assert(ACT == 0 || ACT == 1, "EpiBf16: ACT is 0 (none) or 1 (gelu_pk)");
    bf16_t* O; int ldc; const float* bias; int split_cols; size_t split_stride; float scale0;
    __device__ __forceinline__ void operator()(const f32x4 (&acc)[2][2][4][2], const Unit& u, int wr, int wc, int fr, int fq) const {
        const int row0 = u.pm * BM + wr * 64 + fr; int colt = u.pn * BM; bf16_t* base = O;
        float sc = 1.f; if (split_cols) { const int t = colt / split_cols; base += (size_t)t * split_stride; colt -= t * split_cols; if (t == 0) sc = scale0; }
        const int col0 = colt + wc * 32 + 8 * fq, bcol0 = u.pn * BM + wc * 32 + 8 * fq;
        f32x4 bv[2][2];
#pragma unroll
        for (int bj = 0; bj < 2; ++bj)
#pragma unroll
            for (int n = 0; n < 2; ++n) bv[bj][n] = bias ? *(const f32x4*)(bias + bcol0 + bj * HALF + 4 * n) : (f32x4){0.f, 0.f, 0.f, 0.f};
#pragma unroll
        for (int ai = 0; ai < 2; ++ai)
#pragma unroll
            for (int m = 0; m < 4; ++m) { bf16_t* rowp = base + (size_t)(row0 + ai * HALF + m * 16) * ldc + col0;
#pragma unroll
                for (int bj = 0; bj < 2; ++bj) { f32x4 v0 = acc[ai][bj][m][0] + bv[bj][0], v1 = acc[ai][bj][m][1] + bv[bj][1];
                    if (ACT == 1) { f32x2 a = gelu_pk((f32x2){v0[0], v0[1]}), b = gelu_pk((f32x2){v0[2], v0[3]}), c = gelu_pk((f32x2){v1[0], v1[1]}), d = gelu_pk((f32x2){v1[2], v1[3]});
                        v0 = (f32x4){a.x, a.y, b.x, b.y}; v1 = (f32x4){c.x, c.y, d.x, d.y}; }
                    v0 = v0 * sc; v1 = v1 * sc; u32x4 w; w.x = cvt_pk_bf16(v0[0], v0[1]); w.y = cvt_pk_bf16(v0[2], v0[3]); w.z = cvt_pk_bf16(v1[0], v1[1]); w.w = cvt_pk_bf16(v1[2], v1[3]);
                    *(u32x4*)(rowp + bj * HALF) = w; } }
    }
};

template <class Epi, class Sched, bool ALIGN_EPI = false, bool SP2 = false>
__device__ __forceinline__ void gemm_phase(PG8_LAS unsigned char* lds, const Gemm g, const Sched& S, const Epi& E, const int tid_in) {
    int tid_l = tid_in; asm volatile("" : "+v"(tid_l));
    const int tid = tid_l, wid = __builtin_amdgcn_readfirstlane(tid >> 6), lane = tid & 63, wr = wid >> 2, wc = wid & 3, fr = lane & 15, fq = lane >> 4;
    const int K = g.K, nt = K / BK;
    unsigned voffA[2], voffB[2];
#pragma unroll
    for (int i = 0; i < 2; ++i) { int R, C; stage_rc(tid * 16 + i * 8192, R, C); const int Rb = Epi::PERM ? ((R & ~31) + perm32(R & 31)) : R;
        voffA[i] = (unsigned)(R * K + C) * 2u; voffB[i] = (unsigned)(Rb * K + C) * 2u; }
    const size_t kstep = (size_t)(BK * 2);
    const size_t hstep = (size_t)HALF * K * 2;
    const size_t tstep = 2 * hstep;
    const unsigned ldsw = (unsigned)wid * 1024u;
    const int aoff = lds_byte(wr * 64 + fr, fq * 8), boff = lds_byte(wc * 32 + fr, fq * 8);
#define PG8_SA(b, h) (((b) * 2 + (h)) * HTB)
#define PG8_SB(b, h) ((4 + (b) * 2 + (h)) * HTB)
#define PG8_STAGE(bufoff, gbase, voff) do { _Pragma("unroll") for (int _i = 0; _i < 2; ++_i) \
        __builtin_amdgcn_global_load_lds((const unsigned*)((const char*)(gbase) + (voff)[_i]), (PG8_LAS unsigned*)(lds + (bufoff) + ldsw + _i * 8192), 16, 0, 0); } while (0)
#define PG8_LDA(dst, b, h) do { _Pragma("unroll") for (int m = 0; m < 4; ++m) _Pragma("unroll") for (int k = 0; k < 2; ++k) dst[m][k] = *(const PG8_LAS bf16x8*)(lds + PG8_SA(b, h) + aoff + m * 2048 + k * 1024); } while (0)
#define PG8_LDB(dst, b, h) do { _Pragma("unroll") for (int n = 0; n < 2; ++n) _Pragma("unroll") for (int k = 0; k < 2; ++k) dst[n][k] = *(const PG8_LAS bf16x8*)(lds + PG8_SB(b, h) + boff + n * 2048 + k * 1024); } while (0)
#define PG8_MMA(ai, bj, At, Bt) do { __builtin_amdgcn_s_setprio(1); _Pragma("unroll") for (int m = 0; m < 4; ++m) _Pragma("unroll") for (int n = 0; n < 2; ++n) _Pragma("unroll") for (int k = 0; k < 2; ++k) \
        acc[ai][bj][m][n] = __builtin_amdgcn_mfma_f32_16x16x32_bf16(Bt[n][k], At[m][k], acc[ai][bj][m][n], 0, 0, 0); __builtin_amdgcn_s_setprio(0); } while (0)
#define PG8_WAIT_V(n) asm volatile("s_waitcnt vmcnt(" #n ")" ::: "memory")
#define PG8_WAIT_L(n) asm volatile("s_waitcnt lgkmcnt(" #n ")" ::: "memory")
#define PG8_BAR __builtin_amdgcn_s_barrier()
#define PG8_SCHED __builtin_amdgcn_sched_barrier(0)
    Unit cur, nxt; int ui = 0;
    if (!S.next(0, cur)) return;
    f32x4 acc[2][2][4][2];
#pragma unroll
    for (int a = 0; a < 2; ++a)
#pragma unroll
        for (int b = 0; b < 2; ++b)
#pragma unroll
            for (int m = 0; m < 4; ++m)
#pragma unroll
                for (int n = 0; n < 2; ++n) acc[a][b][m][n] = (f32x4){0.f, 0.f, 0.f, 0.f};
    bf16x8 At[4][2], B0[2][2], B1[2][2];
    const char* cA = (const char*)g.A + (size_t)cur.pm * tstep; const char* cB = (const char*)g.Bt + (size_t)cur.pn * tstep;
    S.a_ready(cur);
    if constexpr (SP2) {
        PG8_STAGE(PG8_SB(0, 0), cB, voffB); PG8_STAGE(PG8_SB(0, 1), cB + hstep, voffB); PG8_STAGE(PG8_SA(0, 0), cA, voffA); PG8_STAGE(PG8_SA(0, 1), cA + hstep, voffA);
        if (wr == 1) PG8_BAR;
        PG8_WAIT_V(2); PG8_BAR;
        PG8_STAGE(PG8_SB(1, 0), cB + kstep, voffB); PG8_STAGE(PG8_SA(1, 0), cA + kstep, voffA); PG8_STAGE(PG8_SB(1, 1), cB + hstep + kstep, voffB);
        PG8_WAIT_V(6); PG8_BAR;
    } else {
        PG8_STAGE(PG8_SB(0, 0), cB, voffB); PG8_STAGE(PG8_SA(0, 0), cA, voffA); PG8_STAGE(PG8_SB(0, 1), cB + hstep, voffB); PG8_STAGE(PG8_SA(0, 1), cA + hstep, voffA);
        if (wr == 1) PG8_BAR;
        PG8_WAIT_V(4); PG8_BAR;
        PG8_STAGE(PG8_SB(1, 0), cB + kstep, voffB); PG8_STAGE(PG8_SA(1, 0), cA + kstep, voffA); PG8_STAGE(PG8_SB(1, 1), cB + hstep + kstep, voffB);
        PG8_WAIT_V(6); PG8_BAR;
    }
    for (;;) {
        const bool has_next = S.next(ui + 1, nxt);
        const char* nA = has_next ? (const char*)g.A + (size_t)nxt.pm * tstep : cA; const char* nB = has_next ? (const char*)g.Bt + (size_t)nxt.pn * tstep : cB;
        for (int t = 0; t < nt; t += 2) {
            const bool last = (t == nt - 2);
            const char* a1 = cA + (size_t)(t + 1) * kstep;
            const char* a2 = last ? nA : cA + (size_t)(t + 2) * kstep; const char* b2 = last ? nB : cB + (size_t)(t + 2) * kstep;
            const char* a3 = a2 + kstep; const char* b3 = b2 + kstep;
            if (last && has_next) S.a_ready(nxt);
            if constexpr (SP2) {
            PG8_LDB(B0, 0, 0); PG8_LDB(B1, 0, 1); PG8_SCHED; PG8_LDA(At, 0, 0); PG8_STAGE(PG8_SA(1, 1), a1 + hstep, voffA);
            PG8_WAIT_V(8); PG8_WAIT_L(0); PG8_BAR; PG8_MMA(0, 0, At, B0); PG8_MMA(0, 1, At, B1); PG8_BAR; PG8_SCHED;
            PG8_LDA(At, 0, 1); PG8_STAGE(PG8_SB(0, 0), b2, voffB); PG8_STAGE(PG8_SB(0, 1), b2 + hstep, voffB); PG8_STAGE(PG8_SA(0, 0), a2, voffA);
            PG8_WAIT_V(8); PG8_WAIT_L(0); PG8_BAR; PG8_MMA(1, 0, At, B0); PG8_MMA(1, 1, At, B1); PG8_BAR; PG8_SCHED;
            PG8_LDB(B0, 1, 0); PG8_LDB(B1, 1, 1); PG8_SCHED; PG8_LDA(At, 1, 0); PG8_STAGE(PG8_SA(0, 1), a2 + hstep, voffA);
            PG8_WAIT_V(8); PG8_WAIT_L(0); PG8_BAR; PG8_MMA(0, 0, At, B0); PG8_MMA(0, 1, At, B1); PG8_BAR; PG8_SCHED;
            PG8_LDA(At, 1, 1); PG8_STAGE(PG8_SB(1, 0), b3, voffB); PG8_STAGE(PG8_SB(1, 1), b3 + hstep, voffB); PG8_STAGE(PG8_SA(1, 0), a3, voffA);
            PG8_WAIT_V(8); PG8_WAIT_L(0); PG8_BAR; PG8_MMA(1, 0, At, B0); PG8_MMA(1, 1, At, B1); PG8_BAR; PG8_SCHED;
            } else {
            PG8_LDB(B0, 0, 0); PG8_SCHED; PG8_LDA(At, 0, 0); PG8_STAGE(PG8_SA(1, 1), a1 + hstep, voffA);
            PG8_WAIT_L(8); PG8_BAR; PG8_WAIT_L(0); PG8_MMA(0, 0, At, B0); PG8_BAR; PG8_SCHED;
            PG8_LDB(B1, 0, 1); PG8_STAGE(PG8_SB(0, 0), b2, voffB);
            PG8_BAR; PG8_WAIT_L(0); PG8_MMA(0, 1, At, B1); PG8_BAR;
            PG8_LDA(At, 0, 1); PG8_STAGE(PG8_SA(0, 0), a2, voffA);
            PG8_BAR; PG8_WAIT_L(0); PG8_MMA(1, 0, At, B0); PG8_BAR; PG8_SCHED;
            PG8_STAGE(PG8_SB(0, 1), b2 + hstep, voffB);
            PG8_WAIT_V(6); PG8_BAR; PG8_MMA(1, 1, At, B1); PG8_BAR;
            PG8_LDB(B0, 1, 0); PG8_SCHED; PG8_LDA(At, 1, 0); PG8_STAGE(PG8_SA(0, 1), a2 + hstep, voffA);
            PG8_WAIT_L(8); PG8_BAR; PG8_WAIT_L(0); PG8_MMA(0, 0, At, B0); PG8_BAR; PG8_SCHED;
            PG8_LDB(B1, 1, 1); PG8_STAGE(PG8_SB(1, 0), b3, voffB);
            PG8_BAR; PG8_WAIT_L(0); PG8_MMA(0, 1, At, B1); PG8_BAR;
            PG8_LDA(At, 1, 1); PG8_STAGE(PG8_SA(1, 0), a3, voffA);
            PG8_BAR; PG8_WAIT_L(0); PG8_MMA(1, 0, At, B0); PG8_BAR; PG8_SCHED;
            PG8_STAGE(PG8_SB(1, 1), b3 + hstep, voffB);
            PG8_WAIT_V(6); PG8_BAR; PG8_MMA(1, 1, At, B1); PG8_BAR;
            }
        }
        if constexpr (ALIGN_EPI) { if (wr == 0) PG8_BAR; }
        if constexpr (!Epi::AFTER_DRAIN) { E(acc, cur, wr, wc, fr, fq); S.done(cur); }
        if (!has_next) break;
#pragma unroll
        for (int a = 0; a < 2; ++a)
#pragma unroll
            for (int b = 0; b < 2; ++b)
#pragma unroll
                for (int m = 0; m < 4; ++m)
#pragma unroll
                    for (int n = 0; n < 2; ++n) acc[a][b][m][n] = (f32x4){0.f, 0.f, 0.f, 0.f};
        cur = nxt; cA = nA; cB = nB; ++ui;
        if constexpr (ALIGN_EPI) { if (wr == 1) PG8_BAR; }
    }
    PG8_WAIT_V(0);
    if constexpr (!ALIGN_EPI) { if (wr == 0) PG8_BAR; }
    PG8_BAR;
    if constexpr (Epi::AFTER_DRAIN) { E.fused(acc, cur, wr, wc, fr, fq, lds, wid, lane); S.done(cur); }
#undef PG8_SA
#undef PG8_SB
#undef PG8_STAGE
#undef PG8_LDA
#undef PG8_LDB
#undef PG8_MMA
#undef PG8_WAIT_V
#undef PG8_WAIT_L
#undef PG8_BAR
#undef PG8_SCHED
}
}
#define GAS __attribute__((address_space(1)))
#define LAS __attribute__((address_space(3)))
typedef unsigned short bf16;
typedef unsigned v4u __attribute__((ext_vector_type(4)));
typedef float f32x4 __attribute__((ext_vector_type(4)));
typedef short bf16x8 __attribute__((ext_vector_type(8)));
typedef GAS unsigned gu32;
typedef GAS unsigned long long gu64;
#define RLX_AGENT __ATOMIC_RELAXED, __HIP_MEMORY_SCOPE_AGENT
#define LDS_WAIT() asm volatile("s_waitcnt lgkmcnt(0)" ::: "memory")
#define VM_WAIT() asm volatile("s_waitcnt vmcnt(0)" ::: "memory")
__device__ __forceinline__ unsigned long long rt() { return __builtin_amdgcn_s_memrealtime(); }
__device__ __forceinline__ unsigned f2bf(float f) { unsigned u = __builtin_bit_cast(unsigned, f); return (u + 0x7fffu + ((u >> 16) & 1u)) >> 16; }
__device__ __forceinline__ unsigned pk2(float lo, float hi) { return f2bf(lo) | (f2bf(hi) << 16); }

#define XB_TMO      128
#define XB_XCNT(j)  (256  + 64 * (j))
#define XB_XSUB(j)  (1280 + 64 * (j))
#define XB_XGEN(j)  (2304 + 64 * (j))
#define XB_TOP      3328
#define XB_TOPGEN   3392
#define XCD_BAR_WORDS 3456
#define XB_SPIN_CAP (1u << 18)

__device__ __forceinline__ unsigned xb_ld(unsigned* p)              { return __hip_atomic_load(p, __ATOMIC_RELAXED, __HIP_MEMORY_SCOPE_AGENT); }
__device__ __forceinline__ unsigned xb_add(unsigned* p, unsigned v) { return __hip_atomic_fetch_add(p, v, __ATOMIC_RELAXED, __HIP_MEMORY_SCOPE_AGENT); }
__device__ __forceinline__ unsigned xb_xcc_id() { return (unsigned)__builtin_amdgcn_s_getreg((3 << 11) | 20) & 0xFu; }
#define XB_SPIN(cond, bar) do { unsigned _sp = 0; while (cond) { __builtin_amdgcn_s_sleep(1); \
    if ((++_sp & 255u) == 0u) { if (xb_ld(&(bar)[XB_TMO])) break; if (_sp > XB_SPIN_CAP) { atomicAdd(&(bar)[XB_TMO], 1u); break; } } } } while (0)

struct XcdBarrier {
    unsigned* bar; unsigned x;
    volatile LAS unsigned* st;
};

__device__ __forceinline__ XcdBarrier xcd_barrier_post(unsigned* bar, volatile LAS unsigned* st, const int tid) {
    XcdBarrier b; b.bar = bar; b.x = xb_xcc_id(); b.st = st;
    if (tid == 0) (void)xb_add(&bar[XB_XCNT(b.x)], 1u);
    return b;
}
__device__ __forceinline__ void xcd_barrier_complete(unsigned* bar, unsigned x, unsigned& nloc, unsigned& nx) {
    const unsigned G = gridDim.x * gridDim.y * gridDim.z;
    unsigned sum, cnt, mine, sp = 0u;
    for (;;) {
        sum = 0u; cnt = 0u; mine = 0u;
#pragma unroll
        for (unsigned j = 0; j < 16; ++j) { const unsigned c = xb_ld(&bar[XB_XCNT(j)]); sum += c; cnt += (c > 0u) ? 1u : 0u; mine = (j == x) ? c : mine; }
        if (sum == G) break;
        __builtin_amdgcn_s_sleep(1);
        if ((++sp & 255u) == 0u) { if (xb_ld(&bar[XB_TMO])) break; if (sp > XB_SPIN_CAP) { atomicAdd(&bar[XB_TMO], 1u); break; } }
    }
    nloc = mine > 0u ? mine : 1u; nx = cnt > 0u ? cnt : 1u;
}

__device__ __forceinline__ void xcd_barrier(const XcdBarrier& b, const int tid) {
    asm volatile("s_waitcnt vmcnt(0)" ::: "memory");
    __syncthreads();
    if (tid == 0) {
        unsigned* bar = b.bar;
        __builtin_amdgcn_s_waitcnt(0);
        unsigned nloc = b.st[0], nx = b.st[1];
        if (nloc == 0u) { xcd_barrier_complete(bar, b.x, nloc, nx); b.st[0] = nloc; b.st[1] = nx; }
        const unsigned old = xb_add(&bar[XB_XSUB(b.x)], 1u);
        const unsigned gen = old / nloc;
        if (old + 1u == (gen + 1u) * nloc) {
            __builtin_amdgcn_fence(__ATOMIC_RELEASE, "agent");
            asm volatile("s_waitcnt vmcnt(0)" ::: "memory");
            const unsigned og = xb_add(&bar[XB_TOP], 1u);
            const unsigned tg = og / nx;
            if (og + 1u == (tg + 1u) * nx) xb_add(&bar[XB_TOPGEN], 1u);
            else XB_SPIN(xb_ld(&bar[XB_TOPGEN]) == tg, bar);
            __builtin_amdgcn_fence(__ATOMIC_ACQUIRE, "agent");
            xb_add(&bar[XB_XGEN(b.x)], 1u);
            asm volatile("s_waitcnt vmcnt(0)" ::: "memory");
        } else {
            XB_SPIN(xb_ld(&bar[XB_XGEN(b.x)]) == gen, bar);
            __builtin_amdgcn_fence(__ATOMIC_ACQUIRE, "agent");
            asm volatile("s_waitcnt vmcnt(0)" ::: "memory");
        }
    }
    __syncthreads();
}
namespace att {
typedef __attribute__((ext_vector_type(8))) short bf16x8;
typedef __attribute__((ext_vector_type(4))) short s16x4;
typedef __attribute__((ext_vector_type(16))) float f32x16;
typedef __attribute__((ext_vector_type(4))) unsigned u32x4;
typedef unsigned short bf16;
constexpr int D = 128, NW = 8, QBLK = 32, KVBLK = 64, LDQ = 1024;
constexpr float SCALE = 0.088388347648318440f, THR = 8.f;
constexpr int SHM_V = KVBLK * D * 2, SHM_K = KVBLK * D * 2;
constexpr int WS_OFF = 2 * SHM_V + 2 * SHM_K, TAB_OFF = WS_OFF + NW * 64 * 4, ATT_LDS_BYTES = TAB_OFF + 2048;
#define KSWZ(row, colB) ((row) * 256 + ((colB) ^ (((row) & 7) << 4)))
#define SBAR() __builtin_amdgcn_sched_barrier(0)
__device__ __forceinline__ int crow(int r, int hi) { return (r & 3) + 8 * (r >> 2) + 4 * hi; }
__device__ __forceinline__ unsigned cvtpk(float lo, float hi) { unsigned r; asm volatile("v_cvt_pk_bf16_f32 %0, %1, %2" : "=v"(r) : "v"(lo), "v"(hi)); return r; }
__device__ __forceinline__ bf16x8 ld8(const bf16* p) { return *reinterpret_cast<const bf16x8*>(p); }

__device__ __forceinline__ void partialSM(f32x16& p0, f32x16& p1, float& m_reg, float& mn, float& alpha) {
  constexpr float C = SCALE * 1.4426950408889634f;
  float pmax = p0[0]; for (int r = 1; r < 16; ++r) pmax = fmaxf(pmax, p0[r]); for (int r = 0; r < 16; ++r) pmax = fmaxf(pmax, p1[r]);
  { auto rr = __builtin_amdgcn_permlane32_swap(__float_as_uint(pmax), __float_as_uint(pmax), false, false);
    pmax = fmaxf(__uint_as_float(rr[0]), __uint_as_float(rr[1])); }
  if (__builtin_expect(__all(pmax - m_reg <= THR / SCALE), 1)) { mn = m_reg; alpha = 1.f; }
  else { mn = fmaxf(m_reg, pmax); alpha = __builtin_amdgcn_exp2f((m_reg - mn) * C); m_reg = mn; }
  float mnC = -mn * C;
  for (int r = 0; r < 16; ++r) p0[r] = fmaf(p0[r], C, mnC); for (int r = 0; r < 16; ++r) p1[r] = fmaf(p1[r], C, mnC);
  for (int r = 0; r < 16; ++r) p0[r] = __builtin_amdgcn_exp2f(p0[r]);
}
__device__ __forceinline__ void finishSM(f32x16& p0, f32x16& p1, float alpha, float& l_reg, bf16x8& pa0, bf16x8& pa1, bf16x8& pa2, bf16x8& pa3) {
  for (int r = 0; r < 16; ++r) p1[r] = __builtin_amdgcn_exp2f(p1[r]);
  float ps = 0; for (int r = 0; r < 16; ++r) ps += p0[r]; for (int r = 0; r < 16; ++r) ps += p1[r];
  { auto rr = __builtin_amdgcn_permlane32_swap(__float_as_uint(ps), __float_as_uint(ps), false, false);
    ps = __uint_as_float(rr[0]) + __uint_as_float(rr[1]); }
  l_reg = l_reg * alpha + ps;
#define PK4(P, BASE, OUT) do { unsigned a0 = cvtpk(P[BASE + 0], P[BASE + 1]), a1 = cvtpk(P[BASE + 2], P[BASE + 3]);   \
    unsigned b0 = cvtpk(P[BASE + 4], P[BASE + 5]), b1 = cvtpk(P[BASE + 6], P[BASE + 7]);                              \
    auto r0 = __builtin_amdgcn_permlane32_swap(a0, b0, false, false); auto r1 = __builtin_amdgcn_permlane32_swap(a1, b1, false, false); \
    u32x4 w = {r0[0], r1[0], r0[1], r1[1]}; OUT = *reinterpret_cast<bf16x8*>(&w); } while (0)
  PK4(p0, 0, pa0); PK4(p0, 8, pa1); PK4(p1, 0, pa2); PK4(p1, 8, pa3);
#undef PK4
}
__device__ __forceinline__ void qkt(f32x16& p0, f32x16& p1, const bf16* Ks, const bf16x8* qr, int r32, int hi) {
  p0 = f32x16{}; p1 = f32x16{};
  const char* kb[4];
#pragma unroll
  for (int dd = 0; dd < 4; ++dd) kb[dd] = (const char*)Ks + KSWZ(r32, (dd * 16 + hi * 8) * 2);
#pragma unroll
  for (int d0 = 0; d0 < 8; ++d0) { const char* a = kb[d0 & 3] + (d0 >> 2) * 128;
    bf16x8 b0 = *reinterpret_cast<const bf16x8*>(a);
    bf16x8 b1 = *reinterpret_cast<const bf16x8*>(a + 32 * 256);
    p0 = __builtin_amdgcn_mfma_f32_32x32x16_bf16(b0, qr[d0], p0, 0, 0, 0);
    p1 = __builtin_amdgcn_mfma_f32_32x32x16_bf16(b1, qr[d0], p1, 0, 0, 0); }
}
__device__ __forceinline__ int v_st(int k, int c) { const int kk = (k & ~0xC) | ((k & 4) << 1) | ((k & 8) >> 1); return ((kk >> 3) * 4 + (c >> 5)) * 512 + ((kk & 7) * 32 + (c & 31)) * 2; }
__device__ __forceinline__ int v_rd_base(int lane) { return ((lane & 3) << 3) | (((lane >> 2) & 3) << 6) | (((lane >> 4) & 1) << 5) | (((lane >> 5) & 1) << 8); }
constexpr int v_rd_off(int d0, int ks, int half) { return d0 * 512 + ks * 4096 + half * 2048; }
template <int OFF> __device__ __forceinline__ s16x4 tr_read(int vb) {
  s16x4 r; asm volatile("ds_read_b64_tr_b16 %0, %1 offset:%2" : "=&v"(r) : "v"(vb), "i"(OFF) : "memory"); return r;
}
template <int D0> __device__ __forceinline__ void pv_one(f32x16& od, int vb, bf16x8 pa0, bf16x8 pa1, bf16x8 pa2, bf16x8 pa3) {
  const s16x4 l0 = tr_read<v_rd_off(D0, 0, 0)>(vb), h0 = tr_read<v_rd_off(D0, 0, 1)>(vb), l1 = tr_read<v_rd_off(D0, 1, 0)>(vb), h1 = tr_read<v_rd_off(D0, 1, 1)>(vb);
  const s16x4 l2 = tr_read<v_rd_off(D0, 2, 0)>(vb), h2 = tr_read<v_rd_off(D0, 2, 1)>(vb), l3 = tr_read<v_rd_off(D0, 3, 0)>(vb), h3 = tr_read<v_rd_off(D0, 3, 1)>(vb);
  asm volatile("s_waitcnt lgkmcnt(0)" ::: "memory"); SBAR();
#define PK(L, H) (bf16x8){L[0], L[1], L[2], L[3], H[0], H[1], H[2], H[3]}
  od = __builtin_amdgcn_mfma_f32_32x32x16_bf16(pa0, PK(l0, h0), od, 0, 0, 0);
  od = __builtin_amdgcn_mfma_f32_32x32x16_bf16(pa1, PK(l1, h1), od, 0, 0, 0);
  od = __builtin_amdgcn_mfma_f32_32x32x16_bf16(pa2, PK(l2, h2), od, 0, 0, 0);
  od = __builtin_amdgcn_mfma_f32_32x32x16_bf16(pa3, PK(l3, h3), od, 0, 0, 0);
#undef PK
}
__device__ __forceinline__ void pv_d0(f32x16* o, int vb, bf16x8 pa0, bf16x8 pa1, bf16x8 pa2, bf16x8 pa3) {
  pv_one<0>(o[0], vb, pa0, pa1, pa2, pa3); pv_one<1>(o[1], vb, pa0, pa1, pa2, pa3); pv_one<2>(o[2], vb, pa0, pa1, pa2, pa3); pv_one<3>(o[3], vb, pa0, pa1, pa2, pa3);
}

struct Unit {
  const bf16* Q; bf16* O;
  const bf16* K0; const bf16* V0;
  const bf16* K1; const bf16* V1;
  int n0, n1, ldk;
  int mode;
  int a, b;
  float sink2;
  const float* tab;
};
__device__ __forceinline__ void mask_nat(f32x16& p0, f32x16& p1, bool rowvis, int cs4, int cqb, const float* trow) {
  const float NEG = -__builtin_inff();
  if (!rowvis) {
#pragma unroll
    for (int r = 0; r < 16; ++r) { p0[r] = NEG; p1[r] = NEG; }
    return; }
#pragma unroll
  for (int r = 0; r < 16; ++r) { const int cc = (r & 3) + 8 * (r >> 2);
    { const int i0 = min(max(cc - cqb, 0), 30); const float bv = trow[i0]; p0[r] = ((unsigned)(cc - cs4) < 16u) ? p0[r] + bv : NEG; }
    { const int i1 = min(max(cc + 32 - cqb, 0), 30); const float bv = trow[i1]; p1[r] = ((unsigned)(cc + 32 - cs4) < 16u) ? p1[r] + bv : NEG; } }
}
__device__ __forceinline__ void mask_win(f32x16& p0, f32x16& p1, int dq) {
  const float NEG = -__builtin_inff();
#pragma unroll
  for (int r = 0; r < 16; ++r) { const int cc = (r & 3) + 8 * (r >> 2);
    if ((unsigned)(dq + cc) > 256u) p0[r] = NEG;
    if ((unsigned)(dq + cc + 32) > 256u) p1[r] = NEG; }
}

__device__ __forceinline__ void attn_unit(const Unit& U, char* lds, const int tid_in) {
  int tid_l = tid_in; asm volatile("" : "+v"(tid_l));
  const int tid = tid_l, wid = __builtin_amdgcn_readfirstlane(tid >> 6), lane = tid & 63, r32 = lane & 31, hi = lane >> 5;
  bf16* V_lds = (bf16*)lds; bf16* K_lds = (bf16*)(lds + 2 * SHM_V);
  float* ws = (float*)(lds + WS_OFF) + wid * 64; float* li_l = ws; float* al_l = ws + 32;
  float* tabL = (float*)(lds + TAB_OFF);
  if (U.mode == 1) { for (int i = tid; i < 465; i += 512) tabL[i] = U.tab[i] * (1.0f / SCALE); }
  float m_reg = -1e30f, l_reg = 0; f32x16 o[4] = {}; bf16x8 qr[8];
  const bf16* Qw = U.Q + (long)(wid * QBLK + r32) * LDQ + hi * 8;
#pragma unroll
  for (int d0 = 0; d0 < 8; ++d0) qr[d0] = ld8(Qw + d0 * 16);
  const int ldk = U.ldk, n0 = U.n0, NT = U.n0 + U.n1;
  const int sr = tid >> 4, sc = (tid & 15) * 8, vst0 = v_st(sr, sc), vst1 = v_st(32 + sr, sc);
  const int vb0 = (int)(uintptr_t)V_lds + v_rd_base(lane);
  struct { bf16x8 vs0, vs1, ks0, ks1; } sr_[1];
  const int maskA = U.a, maskB = U.b;
#define SLOAD(i, t) do { const int t_ = (t); const bf16* Kp_ = t_ < n0 ? U.K0 + (long)t_ * KVBLK * ldk : U.K1 + (long)(t_ - n0) * KVBLK * ldk;  \
    const bf16* Vp_ = t_ < n0 ? U.V0 + (long)t_ * KVBLK * ldk : U.V1 + (long)(t_ - n0) * KVBLK * ldk;                                         \
    sr_[i].vs0 = ld8(&Vp_[(long)sr * ldk + sc]); sr_[i].vs1 = ld8(&Vp_[(long)(32 + sr) * ldk + sc]);                                           \
    sr_[i].ks0 = ld8(&Kp_[(long)sr * ldk + sc]); sr_[i].ks1 = ld8(&Kp_[(long)(32 + sr) * ldk + sc]); } while (0)
#define SWRITE(b, i) do { *(bf16x8*)((char*)V_lds + (b) * SHM_V + vst0) = sr_[i].vs0;          \
    *(bf16x8*)((char*)V_lds + (b) * SHM_V + vst1) = sr_[i].vs1; int kc = sc * 2;               \
    *(bf16x8*)((char*)K_lds + (b) * SHM_K + KSWZ(sr, kc)) = sr_[i].ks0;                       \
    *(bf16x8*)((char*)K_lds + (b) * SHM_K + KSWZ(32 + sr, kc)) = sr_[i].ks1; } while (0)
#define SWAIT() asm volatile("s_waitcnt vmcnt(0)" ::: "memory")
#define RESC(a) do { if (__any((a) < 1.f)) { if (hi == 0) al_l[r32] = (a); asm volatile("s_waitcnt lgkmcnt(0)" ::: "memory"); \
    for (int d = 0; d < 4; ++d) for (int r = 0; r < 16; ++r) o[d][r] *= al_l[crow(r, hi)]; } } while (0)
#define MASK(P0, P1, t) do { if (U.mode != 0 && (t) >= n0) { const int tl_ = (t) - n0; int ln_ = lane; asm volatile("" : "+v"(ln_));     \
    const int r32_ = ln_ & 31, hi_ = ln_ >> 5;                                                                                                  \
    if (U.mode == 1) { const int rq_ = maskA + (wid >> 1), rsq_ = min(max(rq_ - 4, 0), 56), kr_ = maskB + tl_; const bool rv_ = (unsigned)(kr_ - rsq_) < 8u; const int dr_ = rv_ ? kr_ - rq_ + 7 : 0; \
        const int cq_ = 32 * (wid & 1) + r32_, cs_ = min(max(cq_ - 8, 0), 48);                                                                   \
        mask_nat(P0, P1, rv_, cs_ - 4 * hi_, cq_ - 15 - 4 * hi_, tabL + dr_ * 31); }                                                             \
    else { mask_win(P0, P1, maskB + tl_ * KVBLK - (maskA + 32 * wid + r32_) + 4 * hi_ + 128); } } } while (0)
  f32x16 pA0, pA1, pB0, pB1; float mnA, mnB, alA, alB; bf16x8 pa0, pa1, pa2, pa3;
  constexpr int SE = 0, SO = 0;
  SLOAD(SE, 0); asm volatile("s_waitcnt vmcnt(0)" ::: "memory"); SWRITE(0, SE); __syncthreads();
  qkt(pA0, pA1, K_lds, qr, r32, hi); MASK(pA0, pA1, 0); partialSM(pA0, pA1, m_reg, mnA, alA);
  SLOAD(SO, 1);
  SWAIT(); SWRITE(1, SO); __syncthreads();
  for (int j = 1; j + 1 < NT; j += 2) {
    SBAR(); qkt(pB0, pB1, (bf16*)((char*)K_lds + SHM_K), qr, r32, hi);
    finishSM(pA0, pA1, alA, l_reg, pa0, pa1, pa2, pa3); SBAR();
    SLOAD(SO, j + 1); SBAR();
    pv_d0(o, vb0, pa0, pa1, pa2, pa3); MASK(pB0, pB1, j); partialSM(pB0, pB1, m_reg, mnB, alB);
    __syncthreads(); SWAIT(); SWRITE(0, SE);
    RESC(alB); __syncthreads();
    SBAR(); qkt(pA0, pA1, K_lds, qr, r32, hi);
    finishSM(pB0, pB1, alB, l_reg, pa0, pa1, pa2, pa3); SBAR();
    SLOAD(SE, j + 2); SBAR();
    pv_d0(o, vb0 + (int)SHM_V, pa0, pa1, pa2, pa3); MASK(pA0, pA1, j + 1); partialSM(pA0, pA1, m_reg, mnA, alA);
    __syncthreads(); SWAIT(); SWRITE(1, SO);
    RESC(alA); __syncthreads();
  }
  SBAR(); qkt(pB0, pB1, (bf16*)((char*)K_lds + SHM_K), qr, r32, hi);
  finishSM(pA0, pA1, alA, l_reg, pa0, pa1, pa2, pa3); SBAR();
  pv_d0(o, vb0, pa0, pa1, pa2, pa3); MASK(pB0, pB1, NT - 1); partialSM(pB0, pB1, m_reg, mnB, alB);
  __syncthreads(); RESC(alB);
  finishSM(pB0, pB1, alB, l_reg, pa0, pa1, pa2, pa3); SBAR();
  pv_d0(o, vb0 + (int)SHM_V, pa0, pa1, pa2, pa3);
  l_reg += __builtin_amdgcn_exp2f(U.sink2 - m_reg * (SCALE * 1.4426950408889634f));
  if (hi == 0) li_l[r32] = l_reg; asm volatile("s_waitcnt lgkmcnt(0)" ::: "memory");
  float rli[16];
#pragma unroll
  for (int r = 0; r < 16; ++r) rli[r] = __builtin_amdgcn_rcpf(li_l[crow(r, hi)]);
  __syncthreads();
  { bf16* stg = (bf16*)(lds + wid * 8192);
#pragma unroll
    for (int r = 0; r < 16; ++r) { const int orow = crow(r, hi);
#pragma unroll
      for (int d0 = 0; d0 < 4; ++d0) stg[orow * 128 + d0 * 32 + r32] = (bf16)(cvtpk(o[d0][r] * rli[r], 0.f) & 0xffffu); }
    asm volatile("s_waitcnt lgkmcnt(0)" ::: "memory");
    bf16* Ow = U.O + (long)(wid * QBLK) * LDQ;
#pragma unroll
    for (int i = 0; i < 8; ++i) { const int row = 4 * i + (lane >> 4), ch = lane & 15; const u32x4 v = *(const u32x4*)(stg + row * 128 + ch * 8);
      *(u32x4*)(Ow + (long)row * LDQ + ch * 8) = v; } }
  __syncthreads();
#undef SLOAD
#undef SWRITE
#undef SWAIT
#undef RESC
#undef MASK
}
#undef KSWZ
#undef SBAR
}
constexpr int DM = 2048, R_CTX = 4096, R_LAT = 8192, RT = 12288, FF = 5632, NGU = 11264, DIN = 12288, HD = 128;
constexpr int NWAVES = 8, NTHR = 512;
constexpr float EPS_N = 1e-6f, SM_SCALE = 0.08838834764831845f;
constexpr size_t MiB = 1u << 20;
constexpr size_t WS_CTL = 0, CTL_ZERO_BYTES = 1 * MiB;
constexpr size_t WS_MODS = 1 * MiB;
constexpr size_t WS_ROPE = 2 * MiB;
constexpr size_t WS_CACHE = 4 * MiB;
constexpr size_t WS_W = 16 * MiB, W_LAYER = 200 * MiB;
constexpr size_t W_GU1 = 0, W_D1 = 44 * MiB, W_IN = 66 * MiB, W_B = 114 * MiB, W_O = 126 * MiB, W_GU2 = 134 * MiB, W_D2 = 178 * MiB;
constexpr size_t WS_H = 416 * MiB;
constexpr size_t WS_ACT = 464 * MiB;
constexpr size_t WS_Z = 596 * MiB;
constexpr size_t WS_QKVG = 884 * MiB;
constexpr size_t WS_END = 1172 * MiB;
constexpr int CW_BAR = 4096;
constexpr int EXCH_OFF = 131072, LDSCTL_OFF = 139264, MISC_OFF = LDSCTL_OFF + 320, LDS_BYTES = 147456;
constexpr size_t OUT_YP = 0, OUT_YS = 8388608, OUT_KGQA = 25165824, OUT_VGQA = 27262976, OUT_KNAT = 29360128, OUT_VNAT = 37748736, OUT_KWIN = 46137344, OUT_VWIN = 48234496, OUT_TOTAL = 50331648;

constexpr int MAP_GU = 1, MAP_IN = 2;
struct Args { const float* in[25]; float* out; unsigned char* ws; };

struct Frame {
    LAS unsigned char* lds;
    int tid, lane, wave, G, bid;
    float* out; unsigned char* ws;
};
#define CAS __attribute__((address_space(4)))
__device__ __forceinline__ const float* in_ptr(int k) { const CAS char* p = (const CAS char*)__builtin_amdgcn_kernarg_segment_ptr(); asm volatile("" : "+s"(p)); return *(const float* const CAS*)(p + 8 * k); }

__device__ __forceinline__ float shx(float v, int mask, int lane) { return __uint_as_float((unsigned)__builtin_amdgcn_ds_bpermute((lane ^ mask) << 2, (int)__float_as_uint(v))); }
__device__ __forceinline__ float wave_sum(float v, int lane) {
#pragma unroll
    for (int o = 1; o < 64; o <<= 1) v += shx(v, o, lane);
    return v;
}
__device__ __forceinline__ float bf2f(unsigned b) { return __uint_as_float(b << 16); }
__device__ __forceinline__ float bflo(unsigned w) { return __uint_as_float(w << 16); }
__device__ __forceinline__ float bfhi(unsigned w) { return __uint_as_float(w & 0xffff0000u); }
__device__ __forceinline__ float sigm(float x) { return 1.f / (1.f + __expf(-x)); }

__device__ __forceinline__ int rowmap(int MAP, int s) {
    if (MAP == 1) { const int n = s >= FF ? 1 : 0, j = s - FF * n, pn = j >> 7, jj = j & 127, wc = jj >> 5, fq = (jj & 31) >> 3, bj = (jj & 7) >> 2, e = jj & 3;
        return 256 * pn + 128 * bj + 32 * wc + 16 * n + 4 * fq + e; }
    if (MAP == 2) { const int pn = s >> 8, c = s & 255, bj = c >> 7, d = c & 127; const bool ropet = pn < 5 || (pn >= 18 && pn < 23);
        if (ropet) { const int h2 = d >> 6, n = (d & 63) >> 5, w1 = (d & 31) >> 4, fq = (d & 15) >> 2, e = d & 3; return 256 * pn + 128 * bj + 32 * (2 * h2 + w1) + 16 * n + 4 * fq + e; }
        const int wc = d >> 5, fq = (d & 31) >> 3, n = (d & 7) >> 2, e = d & 3; return 256 * pn + 128 * bj + 32 * wc + 16 * n + 4 * fq + e; }
    return s;
}
__device__ __forceinline__ void transpose_item(const float* W, int K, int N, bf16* WT, LAS float* scr, int k0, int n0, int lane, int MAP) {
    f32x4 tv[16];
#pragma unroll
    for (int i = 0; i < 16; ++i) tv[i] = *(const GAS f32x4*)(W + (size_t)(k0 + 4 * i + (lane >> 4)) * N + n0 + 4 * (lane & 15));
#pragma unroll
    for (int i = 0; i < 16; ++i) { LAS float* s = scr + (4 * i + (lane >> 4)) * 65 + 4 * (lane & 15); s[0] = tv[i].x; s[1] = tv[i].y; s[2] = tv[i].z; s[3] = tv[i].w; }
    LDS_WAIT(); asm volatile("" ::: "memory");
    const int c = lane & 7;
#pragma unroll
    for (int j = 0; j < 8; ++j) {
        const int n = 8 * j + (lane >> 3); const LAS float* s = scr + (8 * c) * 65 + n;
        v4u o; o.x = pk2(s[0], s[65]); o.y = pk2(s[130], s[195]); o.z = pk2(s[260], s[325]); o.w = pk2(s[390], s[455]);
        *(GAS v4u*)(WT + (size_t)rowmap(MAP, n0 + n) * K + k0 + 8 * c) = o;
    }
    LDS_WAIT(); asm volatile("" ::: "memory");
}
__device__ __forceinline__ void transpose_matrix(Frame& F, const float* W, int K, int N, bf16* WT, int MAP) {
    LAS float* scr = (LAS float*)(F.lds + F.wave * 16640);
    const int gw = F.bid * NWAVES + F.wave, NGW = F.G * NWAVES, nb = N / 64, items = (K / 64) * nb;
    for (int it = gw; it < items; it += NGW) transpose_item(W, K, N, WT, scr, 64 * (it / nb), 64 * (it % nb), F.lane, MAP);
}
__device__ __forceinline__ void cvt_array(Frame& F, const float* src, bf16* dst, int n8) {
    for (int i = F.bid * NTHR + F.tid; i < n8; i += F.G * NTHR) {
        const f32x4 a = *(const GAS f32x4*)(src + (size_t)i * 8), b = *(const GAS f32x4*)(src + (size_t)i * 8 + 4);
        v4u o; o.x = pk2(a.x, a.y); o.y = pk2(a.z, a.w); o.z = pk2(b.x, b.y); o.w = pk2(b.z, b.w);
        *(GAS v4u*)(dst + (size_t)i * 8) = o;
    }
}
__device__ __forceinline__ void mods_phase(Frame& F) {
    LAS float* sv = (LAS float*)F.lds;
    LAS f32x4* red = (LAS f32x4*)(F.lds + 24576);
    const float* c_lat = in_ptr(8); const float* c_ctx = in_ptr(9); const float* w_mod = in_ptr(10); const float* b_mod = in_ptr(11);
    float* mods = (float*)(F.ws + WS_MODS);
    for (int i = F.tid; i < 3 * 2048; i += NTHR) { const int g = i >> 11, k = i & 2047; const float c = (g == 0) ? c_ctx[k] : c_lat[(g - 1) * 2048 + k]; sv[i] = c / (1.f + __expf(-c)); }
    __syncthreads();
    for (int cb = F.bid; cb < 256; cb += F.G) {
        const int l = cb >> 7, col0 = (cb & 127) * 144;
        if (F.tid < 504) {
            const int c4 = F.tid % 36, kg = F.tid / 36;
            const GAS f32x4* wp = (const GAS f32x4*)(w_mod + (size_t)l * 2048 * 18432 + col0 + 4 * c4);
            f32x4 a0 = {0.f, 0.f, 0.f, 0.f}, a1 = a0, a2 = a0;
#pragma unroll 4
            for (int k = kg; k < 2048; k += 14) { const f32x4 w = wp[(size_t)k * 4608]; a0 += sv[k] * w; a1 += sv[2048 + k] * w; a2 += sv[4096 + k] * w; }
            red[(kg * 3 + 0) * 36 + c4] = a0; red[(kg * 3 + 1) * 36 + c4] = a1; red[(kg * 3 + 2) * 36 + c4] = a2;
        }
        __syncthreads();
        if (F.tid < 108) {
            const int g = F.tid / 36, c4 = F.tid % 36; f32x4 s = *(const GAS f32x4*)(b_mod + (size_t)l * 18432 + col0 + 4 * c4);
            for (int kg = 0; kg < 14; ++kg) s += red[(kg * 3 + g) * 36 + c4];
            *(GAS f32x4*)(mods + (size_t)(l * 3 + g) * 18432 + col0 + 4 * c4) = s;
        }
        __syncthreads();
    }
}
__device__ __forceinline__ void prologue(Frame& F) {
    unsigned char* ws = F.ws;
    for (int l = 0; l < 2; ++l) {
        unsigned char* wl = ws + WS_W + (size_t)l * W_LAYER;
        transpose_matrix(F, in_ptr(13) + (size_t)l * DM * NGU, DM, NGU, (bf16*)(wl + W_GU1), MAP_GU);
        transpose_matrix(F, in_ptr(14) + (size_t)l * FF * DM, FF, DM, (bf16*)(wl + W_D1), 0);
        transpose_matrix(F, in_ptr(15) + (size_t)l * DM * DIN, DM, DIN, (bf16*)(wl + W_IN), MAP_IN);
        for (int i = 0; i < 3; ++i) transpose_matrix(F, in_ptr(20) + (size_t)(l * 3 + i) * 1024 * DM, 1024, DM, (bf16*)(wl + W_B) + (size_t)i * DM * 1024, 0);
        transpose_matrix(F, in_ptr(21) + (size_t)l * DM * DM, DM, DM, (bf16*)(wl + W_O), 0);
        transpose_matrix(F, in_ptr(22) + (size_t)l * DM * NGU, DM, NGU, (bf16*)(wl + W_GU2), MAP_GU);
        transpose_matrix(F, in_ptr(23) + (size_t)l * FF * DM, FF, DM, (bf16*)(wl + W_D2), 0);
    }
    cvt_array(F, in_ptr(2), (bf16*)(ws + WS_CACHE), 524288 / 8);
    cvt_array(F, in_ptr(3), (bf16*)(ws + WS_CACHE + 1 * MiB), 524288 / 8);
    cvt_array(F, in_ptr(6), (bf16*)(ws + WS_CACHE + 2 * MiB), 524288 / 8);
    cvt_array(F, in_ptr(7), (bf16*)(ws + WS_CACHE + 3 * MiB), 524288 / 8);
    cvt_array(F, in_ptr(4), (bf16*)(ws + WS_CACHE + 4 * MiB), 2097152 / 8);
    cvt_array(F, in_ptr(5), (bf16*)(ws + WS_CACHE + 8 * MiB), 2097152 / 8);
    { float* ct = (float*)(ws + WS_ROPE); float* st = ct + 2048;
      for (int i = F.bid * NTHR + F.tid; i < 2048; i += F.G * NTHR) { const int pos = i >> 5, f = i & 31;
          const float inv = exp2f(-(float)f * (13.287712379549449f / 32.0f)); const float ang = (float)pos * inv;
          const float kf = rintf(ang * 0.6366197723675814f); float r = fmaf(-kf, 1.5707962512969971f, ang); r = fmaf(-kf, 7.5497894158615964e-08f, r); r = fmaf(-kf, 5.3903029534742384e-15f, r);
          const float r2 = r * r;
          const float sn = r + r * r2 * (-1.6666667e-1f + r2 * (8.3333338e-3f + r2 * (-1.9841270e-4f + r2 * 2.7557319e-6f)));
          const float cs = 1.0f + r2 * (-0.5f + r2 * (4.1666668e-2f + r2 * (-1.3888889e-3f + r2 * (2.4801587e-5f + r2 * -2.7557319e-7f))));
          const int q = ((int)kf) & 3; const float sv_ = (q == 0) ? sn : (q == 1) ? cs : (q == 2) ? -sn : -cs, cv_ = (q == 0) ? cs : (q == 1) ? -sn : (q == 2) ? -cs : sn;
          ct[i] = cv_; st[i] = sv_; } }
    __syncthreads();
    mods_phase(F);
}

__device__ __forceinline__ void adaln_phase(Frame& F, int l, int which, bool from_inputs) {
    const float* X = F.out; bf16* H = (bf16*)(F.ws + WS_H); const float* mods = (const float*)(F.ws + WS_MODS);
    const float* gn = in_ptr(12) + (size_t)(l * 3 + which) * DM; const float* xin0 = in_ptr(0); const float* xin1 = in_ptr(1);
    const int gw = F.bid * NWAVES + F.wave, NGW = F.G * NWAVES, lane = F.lane;
#define ADALN_SRC(row) (from_inputs ? ((row) < R_CTX ? xin0 + (size_t)(row) * DM : xin1 + (size_t)((row) - R_CTX) * DM) : X + (size_t)(row) * DM)
    f32x4 v[8], vn[8];
    if (gw < RT) { const float* src = ADALN_SRC(gw);
#pragma unroll
        for (int j = 0; j < 8; ++j) v[j] = ((const GAS f32x4*)src)[64 * j + lane]; }
    for (int row = gw; row < RT; row += NGW) {
        const int g = row < R_CTX ? 0 : 1 + ((row - R_CTX) >> 12);
        const int nrow = row + NGW;
        if (nrow < RT) { const float* src = ADALN_SRC(nrow);
#pragma unroll
            for (int j = 0; j < 8; ++j) vn[j] = ((const GAS f32x4*)src)[64 * j + lane]; }
        float ss = 0.f;
#pragma unroll
        for (int j = 0; j < 8; ++j) ss += (v[j].x * v[j].x + v[j].y * v[j].y) + (v[j].z * v[j].z + v[j].w * v[j].w);
        const float rstd = 1.0f / sqrtf(wave_sum(ss, lane) * (1.0f / DM) + EPS_N);
        const GAS f32x4* gnp = (const GAS f32x4*)gn; const float* mg = mods + (size_t)(l * 3 + g) * 18432 + (size_t)which * 3 * DM;
        const GAS f32x4* shp = (const GAS f32x4*)mg; const GAS f32x4* scp = (const GAS f32x4*)(mg + DM);
        GAS unsigned long long* o8 = (GAS unsigned long long*)(H + (size_t)row * DM);
#pragma unroll
        for (int j = 0; j < 8; ++j) {
            const f32x4 a = gnp[64 * j + lane] * (1.0f + scp[64 * j + lane]) * rstd, b = shp[64 * j + lane]; const f32x4 h = v[j] * a + b;
            o8[64 * j + lane] = (unsigned long long)pk2(h.x, h.y) | ((unsigned long long)pk2(h.z, h.w) << 32);
        }
#pragma unroll
        for (int j = 0; j < 8; ++j) v[j] = vn[j];
    }
#undef ADALN_SRC
}
__device__ __forceinline__ void final_phase(Frame& F) {
    float* X = F.out; const GAS f32x4* gf = (const GAS f32x4*)in_ptr(24);
    const int gw = F.bid * NWAVES + F.wave, NGW = F.G * NWAVES, lane = F.lane;
    for (int row = gw; row < RT; row += NGW) {
        GAS f32x4* xr = (GAS f32x4*)(X + (size_t)row * DM);
        f32x4 v[8];
#pragma unroll
        for (int j = 0; j < 8; ++j) v[j] = xr[64 * j + lane];
        float ss = 0.f;
#pragma unroll
        for (int j = 0; j < 8; ++j) ss += (v[j].x * v[j].x + v[j].y * v[j].y) + (v[j].z * v[j].z + v[j].w * v[j].w);
        const float rstd = 1.0f / sqrtf(wave_sum(ss, lane) * (1.0f / DM) + EPS_N);
#pragma unroll
        for (int j = 0; j < 8; ++j) xr[64 * j + lane] = v[j] * rstd * gf[64 * j + lane];
    }
}
__device__ __forceinline__ bool make_unit(Frame& F, int l, int id, att::Unit& U) {
    if (id >= 1152) return false;
    unsigned char* qb = F.ws + WS_QKVG;
    const bf16* QA = (const bf16*)qb; const bf16* QB = (const bf16*)(qb + 24 * MiB); const bf16* QC = (const bf16*)(qb + 48 * MiB); const bf16* KB = (const bf16*)(qb + 72 * MiB); const bf16* VB = (const bf16*)(qb + 96 * MiB);
    const bf16* KA = (const bf16*)(qb + 120 * MiB); const bf16* VA = (const bf16*)(qb + 126 * MiB); const bf16* KC = (const bf16*)(qb + 132 * MiB); const bf16* VC = (const bf16*)(qb + 138 * MiB);
    const bf16* CKA = (const bf16*)(F.ws + WS_CACHE); const bf16* CVA = (const bf16*)(F.ws + WS_CACHE + 1 * MiB); const bf16* CKC = (const bf16*)(F.ws + WS_CACHE + 2 * MiB); const bf16* CVC = (const bf16*)(F.ws + WS_CACHE + 3 * MiB);
    const bf16* CKB = (const bf16*)(F.ws + WS_CACHE + 4 * MiB); const bf16* CVB = (const bf16*)(F.ws + WS_CACHE + 8 * MiB);
    bf16* O = (bf16*)(F.ws + WS_ACT);
    const float LOG2E = 1.4426950408889634f;
    U.mode = 0; U.a = 0; U.b = 0; U.sink2 = -__builtin_inff(); U.tab = in_ptr(18); U.n0 = 0;
    if (id < 768) {
        const int type = id >> 8, v = id & 255, xcd = v & 7, j = v >> 3; int b, h, q;
        if (type != 1) { const int combo = xcd >> 1, idx = (xcd & 1) * 32 + j; b = combo >> 1; h = (combo & 1) * 4 + (idx >> 4); q = idx & 15; }
        else { const int combo = xcd * 2 + (j >> 4); b = combo >> 3; h = combo & 7; q = j & 15; }
        const size_t lat0 = R_CTX + (size_t)b * 4096, row0 = lat0 + (size_t)q * 256, cb = (size_t)(b * 2 + l) * 512;
        U.n0 = 8;
        if (type == 0) { const int kvh = h >> 2; U.ldk = 256;
            U.Q = QA + row0 * 1024 + h * 128; U.O = O + row0 * 1024 + h * 128;
            U.K0 = CKA + cb * 256 + kvh * 128; U.V0 = CVA + cb * 256 + kvh * 128; U.K1 = KA + lat0 * 256 + kvh * 128; U.V1 = VA + lat0 * 256 + kvh * 128; U.n1 = 64; }
        else if (type == 1) { U.ldk = 1024; const int R0 = q * 4, kr0 = min(max(R0 - 4, 0), 52);
            U.Q = QB + row0 * 1024 + h * 128; U.O = O + (size_t)RT * 1024 + row0 * 1024 + h * 128;
            U.K0 = CKB + cb * 1024 + h * 128; U.V0 = CVB + cb * 1024 + h * 128; U.K1 = KB + (lat0 + (size_t)kr0 * 64) * 1024 + h * 128; U.V1 = VB + (lat0 + (size_t)kr0 * 64) * 1024 + h * 128; U.n1 = 12;
            U.mode = 1; U.a = R0; U.b = kr0; U.tab = in_ptr(18) + (size_t)(l * 8 + h) * 465; }
        else { const int kvh = h >> 2; U.ldk = 256; const int kp0 = max(q * 256 - 128, 0), kp1 = min(q * 256 + 384, 4096);
            U.Q = QC + row0 * 1024 + h * 128; U.O = O + (size_t)2 * RT * 1024 + row0 * 1024 + h * 128;
            U.K0 = CKC + cb * 256 + kvh * 128; U.V0 = CVC + cb * 256 + kvh * 128; U.K1 = KC + (lat0 + kp0) * 256 + kvh * 128; U.V1 = VC + (lat0 + kp0) * 256 + kvh * 128; U.n1 = (kp1 - kp0) >> 6;
            U.mode = 2; U.a = q * 256; U.b = kp0; U.sink2 = in_ptr(19)[l * 8 + h] * LOG2E; }
    } else {
        const int v = id - 768, b = v / 24, rem = v - 24 * b, br = rem >> 3, h = rem & 7; const size_t row0 = (size_t)b * 256;
        const int kvh = br == 1 ? h : (h >> 2); U.ldk = br == 1 ? 1024 : 256;
        const bf16* Qx = br == 0 ? QA : br == 1 ? QB : QC; const bf16* Kx = br == 0 ? KA : br == 1 ? KB : KC; const bf16* Vx = br == 0 ? VA : br == 1 ? VB : VC;
        U.Q = Qx + row0 * 1024 + h * 128; U.O = O + (size_t)br * RT * 1024 + row0 * 1024 + h * 128;
        U.K1 = Kx + row0 * U.ldk + kvh * 128; U.V1 = Vx + row0 * U.ldk + kvh * 128; U.K0 = U.K1; U.V0 = U.V1; U.n1 = 4;
        if (br == 2) U.sink2 = in_ptr(19)[l * 8 + h] * LOG2E;
    }
    return true;
}
__device__ __forceinline__ void attn_phase(Frame& F, int l, char* lds) {
    for (int id = F.bid; ; id += F.G) { att::Unit U; if (!make_unit(F, l, id, U)) break; att::attn_unit(U, lds, F.tid); }
}

namespace pg8 {
struct EpiSwiglu {
    static constexpr bool PERM = false, AFTER_DRAIN = false;
    bf16_t* ACT;
    __device__ __forceinline__ void operator()(const f32x4 (&acc)[2][2][4][2], const Unit& u, int wr, int wc, int fr, int fq) const {
        { int ln_; asm volatile("v_mbcnt_lo_u32_b32 %0, -1, 0\n\tv_mbcnt_hi_u32_b32 %0, -1, %0" : "=v"(ln_)); fr = ln_ & 15; fq = ln_ >> 4; }
        const int row0 = u.pm * BM + wr * 64 + fr, col0 = u.pn * 128 + wc * 32 + 8 * fq;
#pragma unroll
        for (int ai = 0; ai < 2; ++ai)
#pragma unroll
            for (int m = 0; m < 4; ++m) { u32x4 w;
#pragma unroll
                for (int bj = 0; bj < 2; ++bj) { const f32x4 a = acc[ai][bj][m][0], b = acc[ai][bj][m][1]; f32x4 r;
#pragma unroll
                    for (int e = 0; e < 4; ++e) r[e] = a[e] * __builtin_amdgcn_rcpf(1.0f + __expf(-a[e])) * b[e];
                    w[2 * bj] = cvt_pk_bf16(r[0], r[1]); w[2 * bj + 1] = cvt_pk_bf16(r[2], r[3]); }
                *(u32x4*)(ACT + (size_t)(row0 + ai * HALF + m * 16) * 5632 + col0) = w; }
    }
};
struct EpiResid {
    static constexpr bool PERM = false, AFTER_DRAIN = false;
    float* X; const float* base_ctx; const float* base_lat; const float* gate; float coef;
    __device__ __forceinline__ void operator()(const f32x4 (&acc)[2][2][4][2], const Unit& u, int wr, int wc, int fr, int fq) const {
        { int ln_; asm volatile("v_mbcnt_lo_u32_b32 %0, -1, 0\n\tv_mbcnt_hi_u32_b32 %0, -1, %0" : "=v"(ln_)); fr = ln_ & 15; fq = ln_ >> 4; }
        const int col0 = u.pn * BM + wc * 32 + 4 * fq;
        const int grp = u.pm < 16 ? 0 : (u.pm < 32 ? 1 : 2);
        const float* bs = u.pm < 16 ? base_ctx + (size_t)u.pm * BM * 2048 : base_lat + (size_t)(u.pm - 16) * BM * 2048;
        f32x4 gv[2][2];
#pragma unroll
        for (int bj = 0; bj < 2; ++bj)
#pragma unroll
            for (int n = 0; n < 2; ++n) gv[bj][n] = *(const f32x4*)(gate + (size_t)grp * 18432 + col0 + bj * HALF + n * 16) * coef;
#pragma unroll
        for (int ai = 0; ai < 2; ++ai) {
            f32x4 bv[4][2][2];
#pragma unroll
            for (int m = 0; m < 4; ++m) { const size_t off = (size_t)(wr * 64 + fr + ai * HALF + m * 16) * 2048 + col0;
#pragma unroll
                for (int bj = 0; bj < 2; ++bj)
#pragma unroll
                    for (int n = 0; n < 2; ++n) bv[m][bj][n] = *(const f32x4*)(bs + off + bj * HALF + n * 16); }
#pragma unroll
            for (int m = 0; m < 4; ++m) { const size_t off = (size_t)(wr * 64 + fr + ai * HALF + m * 16) * 2048 + col0;
#pragma unroll
                for (int bj = 0; bj < 2; ++bj)
#pragma unroll
                    for (int n = 0; n < 2; ++n) *(f32x4*)(X + (size_t)u.pm * BM * 2048 + off + bj * HALF + n * 16) = bv[m][bj][n] + gv[bj][n] * acc[ai][bj][m][n]; } }
    }
};
struct EpiBranch {
    static constexpr bool PERM = false, AFTER_DRAIN = false;
    float* M32; bf16_t* Mb; const bf16_t* GT;
    __device__ __forceinline__ void operator()(const f32x4 (&acc)[2][2][4][2], const Unit& u, int wr, int wc, int fr, int fq) const {
        { int ln_; asm volatile("v_mbcnt_lo_u32_b32 %0, -1, 0\n\tv_mbcnt_hi_u32_b32 %0, -1, %0" : "=v"(ln_)); fr = ln_ & 15; fq = ln_ >> 4; }
        const int br = u.pm / 48, pm = u.pm - 48 * br, pn = u.pn & 7;
        const int row0 = pm * BM + wr * 64 + fr, col0 = pn * BM + wc * 32 + 4 * fq;
#pragma unroll
        for (int aq = 0; aq < 4; ++aq) { const int ai = aq >> 1, m0 = (aq & 1) * 2;
            unsigned long long gg[2][2][2]; f32x4 mv[2][2][2];
#pragma unroll
            for (int mm = 0; mm < 2; ++mm) { const size_t row = (size_t)(row0 + ai * HALF + (m0 + mm) * 16);
#pragma unroll
                for (int bj = 0; bj < 2; ++bj)
#pragma unroll
                    for (int n = 0; n < 2; ++n) { const int col = col0 + bj * HALF + n * 16; gg[mm][bj][n] = *(const unsigned long long*)(GT + row * 6144 + br * 2048 + col);
                        mv[mm][bj][n] = br ? *(const f32x4*)(M32 + row * 2048 + col) : (f32x4){0.f, 0.f, 0.f, 0.f}; } }
#pragma unroll
            for (int mm = 0; mm < 2; ++mm) { const size_t row = (size_t)(row0 + ai * HALF + (m0 + mm) * 16);
#pragma unroll
                for (int bj = 0; bj < 2; ++bj)
#pragma unroll
                    for (int n = 0; n < 2; ++n) { const int col = col0 + bj * HALF + n * 16; const unsigned g0 = (unsigned)gg[mm][bj][n], g1 = (unsigned)(gg[mm][bj][n] >> 32);
                        f32x4 v = acc[ai][bj][m0 + mm][n]; v[0] *= __uint_as_float(g0 << 16); v[1] *= __uint_as_float(g0 & 0xffff0000u); v[2] *= __uint_as_float(g1 << 16); v[3] *= __uint_as_float(g1 & 0xffff0000u);
                        const f32x4 t = mv[mm][bj][n] + v;
                        if (br < 2) *(f32x4*)(M32 + row * 2048 + col) = t;
                        else *(unsigned long long*)(Mb + row * 2048 + col) = (unsigned long long)cvt_pk_bf16(t[0], t[1]) | ((unsigned long long)cvt_pk_bf16(t[2], t[3]) << 32); } } }
    }
};
struct EpiInproj {
    static constexpr bool PERM = false, AFTER_DRAIN = false;
    unsigned char* qkvg; float* out; const float* gq; const float* gk; const float* ropec; int l; PG8_LAS float* P;
    __device__ __forceinline__ void operator()(const f32x4 (&acc)[2][2][4][2], const Unit& u, int wr, int wc, int fr, int fq) const {
        { int ln_; asm volatile("v_mbcnt_lo_u32_b32 %0, -1, 0\n\tv_mbcnt_hi_u32_b32 %0, -1, %0" : "=v"(ln_)); fr = ln_ & 15; fq = ln_ >> 4; }
        constexpr size_t MiB_ = 1u << 20;
        const int pn = u.pn; const bool isctx = u.pm < 16;
        bf16_t* dst; int dld; float* fo = nullptr; int fld = 0; int kind = 0, norm = 0;
        if (pn < 4)        { dst = (bf16_t*)qkvg + pn * 256; dld = 1024; kind = 1; norm = 1; }
        else if (pn == 4)  { dst = (bf16_t*)(qkvg + 120 * MiB_); dld = 256; kind = 1; norm = 2; fo = out + 25165824; fld = 256; }
        else if (pn == 5)  { dst = (bf16_t*)(qkvg + 126 * MiB_); dld = 256; fo = out + 27262976; fld = 256; }
        else if (pn < 10)  { dst = (bf16_t*)(qkvg + 24 * MiB_) + (pn - 6) * 256; dld = 1024; }
        else if (pn < 14)  { dst = (bf16_t*)(qkvg + 72 * MiB_) + (pn - 10) * 256; dld = 1024; fo = out + 29360128 + (pn - 10) * 256; fld = 1024; }
        else if (pn < 18)  { dst = (bf16_t*)(qkvg + 96 * MiB_) + (pn - 14) * 256; dld = 1024; fo = out + 37748736 + (pn - 14) * 256; fld = 1024; }
        else if (pn < 22)  { dst = (bf16_t*)(qkvg + 48 * MiB_) + (pn - 18) * 256; dld = 1024; kind = 1; }
        else if (pn == 22) { dst = (bf16_t*)(qkvg + 132 * MiB_); dld = 256; kind = 1; fo = out + 46137344; fld = 256; }
        else if (pn == 23) { dst = (bf16_t*)(qkvg + 138 * MiB_); dld = 256; fo = out + 48234496; fld = 256; }
        else               { dst = (bf16_t*)(qkvg + 144 * MiB_) + (pn - 24) * 256; dld = 6144; kind = 2; }
        if (!isctx) fo = nullptr;
        const int rl0 = wr * 64 + fr;
        const size_t grow0 = (size_t)u.pm * BM;
        const size_t frow0 = ((size_t)(u.pm * 2 + l)) * 256;
        if (kind != 1) {
            const int c0 = 32 * wc + 8 * fq;
#pragma unroll
            for (int ai = 0; ai < 2; ++ai)
#pragma unroll
                for (int m = 0; m < 4; ++m) { const int rl = rl0 + ai * HALF + m * 16;
#pragma unroll
                    for (int bj = 0; bj < 2; ++bj) { f32x4 a = acc[ai][bj][m][0], b = acc[ai][bj][m][1];
                        if (kind == 2) {
#pragma unroll
                            for (int e = 0; e < 4; ++e) { a[e] = __builtin_amdgcn_rcpf(1.0f + __expf(-a[e])); b[e] = __builtin_amdgcn_rcpf(1.0f + __expf(-b[e])); } }
                        u32x4 w; w.x = cvt_pk_bf16(a[0], a[1]); w.y = cvt_pk_bf16(a[2], a[3]); w.z = cvt_pk_bf16(b[0], b[1]); w.w = cvt_pk_bf16(b[2], b[3]);
                        *(u32x4*)(dst + (grow0 + rl) * dld + bj * HALF + c0) = w;
                        if (fo) { float* fp = fo + (frow0 + rl) * fld + bj * HALF + c0; *(f32x4*)fp = a; *(f32x4*)(fp + 4) = b; } } }
            return;
        }
        const int db = 64 * (wc >> 1) + 16 * (wc & 1) + 4 * fq;
        if (norm) {
#pragma unroll
            for (int ai = 0; ai < 2; ++ai)
#pragma unroll
                for (int m = 0; m < 4; ++m)
#pragma unroll
                    for (int bj = 0; bj < 2; ++bj) { const f32x4 a = acc[ai][bj][m][0], b = acc[ai][bj][m][1];
                        float ss = (a[0] * a[0] + a[1] * a[1]) + (a[2] * a[2] + a[3] * a[3]) + (b[0] * b[0] + b[1] * b[1]) + (b[2] * b[2] + b[3] * b[3]);
                        ss += shx(ss, 16, 16 * fq + fr); ss += shx(ss, 32, 16 * fq + fr);
                        if (fq == 0) P[((rl0 + ai * HALF + m * 16) * 2 + bj) * 4 + wc] = ss; }
            asm volatile("s_waitcnt lgkmcnt(0)" ::: "memory"); __builtin_amdgcn_s_barrier(); asm volatile("" ::: "memory");
        }
        f32x4 g0 = {1.f, 1.f, 1.f, 1.f}, g1 = g0;
        if (norm) { const float* gg = norm == 1 ? gq : gk; g0 = *(const f32x4*)(gg + db); g1 = *(const f32x4*)(gg + db + 32); }
        const int fi = 16 * (wc & 1) + 4 * fq;
#pragma unroll
        for (int ai = 0; ai < 2; ++ai) { f32x4 csv[4], snv[4];
#pragma unroll
            for (int m = 0; m < 4; ++m) { csv[m] = (f32x4){1.f, 1.f, 1.f, 1.f}; snv[m] = (f32x4){0.f, 0.f, 0.f, 0.f};
                if (!isctx) { const int nl = (int)((grow0 + rl0 + ai * HALF + m * 16 - 4096) & 4095); const int pos = (wc >> 1) ? (nl & 63) : (nl >> 6);
                    csv[m] = *(const f32x4*)(ropec + pos * 32 + fi); snv[m] = *(const f32x4*)(ropec + 2048 + pos * 32 + fi); } }
#pragma unroll
            for (int m = 0; m < 4; ++m) { const int rl = rl0 + ai * HALF + m * 16;
                const f32x4 cs = csv[m], sn = snv[m];
#pragma unroll
                for (int bj = 0; bj < 2; ++bj) { f32x4 a = acc[ai][bj][m][0], b = acc[ai][bj][m][1];
                    if (norm) { const f32x4 pp = *(const PG8_LAS f32x4*)(P + (rl * 2 + bj) * 4); const float rstd = 1.0f / sqrtf(((pp[0] + pp[1]) + (pp[2] + pp[3])) * (1.0f / 128.0f) + 1e-6f);
                        a = a * rstd * g0; b = b * rstd * g1; }
                    const f32x4 y1 = a * cs - b * sn, y2 = b * cs + a * sn;
                    bf16_t* dp = dst + (grow0 + rl) * dld + bj * HALF + db;
                    *(unsigned long long*)dp = (unsigned long long)cvt_pk_bf16(y1[0], y1[1]) | ((unsigned long long)cvt_pk_bf16(y1[2], y1[3]) << 32);
                    *(unsigned long long*)(dp + 32) = (unsigned long long)cvt_pk_bf16(y2[0], y2[1]) | ((unsigned long long)cvt_pk_bf16(y2[2], y2[3]) << 32);
                    if (fo) { float* fp = fo + (frow0 + rl) * fld + bj * HALF + db; *(f32x4*)fp = y1; *(f32x4*)(fp + 32) = y2; } } } }
    }
};
struct EpiF32 {
    static constexpr bool PERM = false, AFTER_DRAIN = false;
    float* C; int ldc;
    __device__ __forceinline__ void operator()(const f32x4 (&acc)[2][2][4][2], const Unit& u, int wr, int wc, int fr, int fq) const {
        { int ln_; asm volatile("v_mbcnt_lo_u32_b32 %0, -1, 0\n\tv_mbcnt_hi_u32_b32 %0, -1, %0" : "=v"(ln_)); fr = ln_ & 15; fq = ln_ >> 4; }
        const int row0 = u.pm * BM + wr * 64 + fr, col0 = u.pn * BM + wc * 32 + 4 * fq;
#pragma unroll
        for (int ai = 0; ai < 2; ++ai)
#pragma unroll
            for (int m = 0; m < 4; ++m) { float* rowp = C + (size_t)(row0 + ai * HALF + m * 16) * ldc + col0;
#pragma unroll
                for (int bj = 0; bj < 2; ++bj)
#pragma unroll
                    for (int n = 0; n < 2; ++n) *(f32x4*)(rowp + bj * HALF + n * 16) = acc[ai][bj][m][n]; }
    }
};
struct BranchOrder {
    int G, c;
    __device__ __forceinline__ bool next(int i, Unit& u) const { const int j = i / 3, br = i - 3 * j; const int tile = j * G + c; if (tile >= 384) return false;
        u.pm = br * 48 + (tile >> 3); u.pn = br * 8 + (tile & 7); return true; }
    __device__ __forceinline__ void a_ready(const Unit&) const {}
    __device__ __forceinline__ void done(const Unit&) const {}
};
struct EpiBranchF32 {
    static constexpr bool PERM = false, AFTER_DRAIN = false;
    float* Y3;
    __device__ __forceinline__ void operator()(const f32x4 (&acc)[2][2][4][2], const Unit& u, int wr, int wc, int fr, int fq) const {
        { int ln_; asm volatile("v_mbcnt_lo_u32_b32 %0, -1, 0\n\tv_mbcnt_hi_u32_b32 %0, -1, %0" : "=v"(ln_)); fr = ln_ & 15; fq = ln_ >> 4; }
        const int br = u.pm / 48, pm = u.pm - 48 * br, pn = u.pn & 7;
        const int row0 = pm * BM + wr * 64 + fr, col0 = pn * BM + wc * 32 + 4 * fq; float* base = Y3 + (size_t)br * 12288 * 2048;
#pragma unroll
        for (int ai = 0; ai < 2; ++ai)
#pragma unroll
            for (int m = 0; m < 4; ++m) { float* rowp = base + (size_t)(row0 + ai * HALF + m * 16) * 2048 + col0;
#pragma unroll
                for (int bj = 0; bj < 2; ++bj)
#pragma unroll
                    for (int n = 0; n < 2; ++n) *(f32x4*)(rowp + bj * HALF + n * 16) = acc[ai][bj][m][n]; }
    }
};
}

__global__ void __launch_bounds__(NTHR, 2) mega_fwd(Args args) {
    extern __shared__ __attribute__((aligned(16))) unsigned char lds[];
    Frame F;
    F.lds = (LAS unsigned char*)lds; F.tid = threadIdx.x; F.lane = F.tid & 63; F.wave = __builtin_amdgcn_readfirstlane(F.tid >> 6); F.G = gridDim.x; F.bid = blockIdx.x;
    F.out = (float*)in_ptr(25); F.ws = (unsigned char*)in_ptr(26);
    for (int u = F.tid; u < (LDS_BYTES - LDSCTL_OFF) / 4; u += NTHR) ((LAS unsigned*)(F.lds + LDSCTL_OFF))[u] = 0u;
    __syncthreads();
    volatile LAS unsigned* MISC = (volatile LAS unsigned*)(F.lds + MISC_OFF);
    XcdBarrier bar = xcd_barrier_post((unsigned*)(F.ws + WS_CTL) + CW_BAR, MISC + 8, F.tid);
#define RELAUNDER() do { asm volatile("v_mbcnt_lo_u32_b32 %0, -1, 0\n\tv_mbcnt_hi_u32_b32 %0, -1, %0" : "=v"(F.lane)); \
    asm volatile("" : "+s"(F.wave), "+s"(F.bid), "+s"(F.G), "+s"(F.ws), "+s"(F.out), "+s"(bar.bar), "+s"(bar.x)); F.tid = F.wave * 64 + F.lane; } while (0)
#define GRID_BAR() do { RELAUNDER(); xcd_barrier(bar, F.tid); RELAUNDER(); } while (0)

    prologue(F); GRID_BAR();

    for (int l = 0; l < 2; ++l) {
        unsigned char* wl = F.ws + WS_W + (size_t)l * W_LAYER;
        const float* modl = (const float*)(F.ws + WS_MODS) + (size_t)l * 3 * 18432;
        adaln_phase(F, l, 0, l == 0); GRID_BAR();
        { pg8::Gemm g{(const bf16*)(F.ws + WS_H), (const bf16*)(wl + W_GU1), RT, NGU, DM}; pg8::StaticOrder S; S.init(RT, NGU, F.G, F.bid);
          pg8::EpiSwiglu E{(bf16*)(F.ws + WS_ACT)};
          pg8::gemm_phase<pg8::EpiSwiglu, pg8::StaticOrder, true, true>(F.lds, g, S, E, F.tid); }
        GRID_BAR();
        { pg8::Gemm g{(const bf16*)(F.ws + WS_ACT), (const bf16*)(wl + W_D1), RT, DM, FF}; pg8::StaticOrder S; S.init(RT, DM, F.G, F.bid);
          pg8::EpiResid E{F.out, l == 0 ? in_ptr(0) : F.out, l == 0 ? in_ptr(1) : F.out + (size_t)R_CTX * DM, modl + 2 * DM, 0.5f};
          pg8::gemm_phase<pg8::EpiResid, pg8::StaticOrder, true, true>(F.lds, g, S, E, F.tid); }
        GRID_BAR();
        adaln_phase(F, l, 1, false); GRID_BAR();
        { pg8::Gemm g{(const bf16*)(F.ws + WS_H), (const bf16*)(wl + W_IN), RT, DIN, DM}; pg8::StaticOrder S; S.init(RT, DIN, F.G, F.bid);
          pg8::EpiInproj E{F.ws + WS_QKVG, F.out, in_ptr(16) + l * HD, in_ptr(17) + l * HD, (const float*)(F.ws + WS_ROPE), l, (LAS float*)(F.lds + EXCH_OFF)};
          pg8::gemm_phase<pg8::EpiInproj, pg8::StaticOrder, true, true>(F.lds, g, S, E, F.tid); }
        GRID_BAR();
        attn_phase(F, l, (char*)lds); GRID_BAR();
        { pg8::Gemm g{(const bf16*)(F.ws + WS_ACT)  , (const bf16*)(wl + W_B), 3 * RT, 3 * DM, 1024}; pg8::BranchOrder S{F.G, F.bid};
          pg8::EpiBranch E{(float*)(F.ws + WS_Z), (bf16*)(F.ws + WS_H), (const bf16*)(F.ws + WS_QKVG + 144 * MiB)};
          pg8::gemm_phase<pg8::EpiBranch, pg8::BranchOrder, true, true>(F.lds, g, S, E, F.tid); }
        GRID_BAR();
        { pg8::Gemm g{(const bf16*)(F.ws + WS_H)  , (const bf16*)(wl + W_O), RT, DM, DM}; pg8::StaticOrder S; S.init(RT, DM, F.G, F.bid);
          pg8::EpiResid E{F.out, F.out, F.out + (size_t)R_CTX * DM, modl + 5 * DM, 1.0f};
          pg8::gemm_phase<pg8::EpiResid, pg8::StaticOrder, true, true>(F.lds, g, S, E, F.tid); }
        GRID_BAR();
        adaln_phase(F, l, 2, false); GRID_BAR();
        { pg8::Gemm g{(const bf16*)(F.ws + WS_H), (const bf16*)(wl + W_GU2), RT, NGU, DM}; pg8::StaticOrder S; S.init(RT, NGU, F.G, F.bid);
          pg8::EpiSwiglu E{(bf16*)(F.ws + WS_ACT)};
          pg8::gemm_phase<pg8::EpiSwiglu, pg8::StaticOrder, true, true>(F.lds, g, S, E, F.tid); }
        GRID_BAR();
        { pg8::Gemm g{(const bf16*)(F.ws + WS_ACT), (const bf16*)(wl + W_D2), RT, DM, FF}; pg8::StaticOrder S; S.init(RT, DM, F.G, F.bid);
          pg8::EpiResid E{F.out, F.out, F.out + (size_t)R_CTX * DM, modl + 8 * DM, 0.5f};
          pg8::gemm_phase<pg8::EpiResid, pg8::StaticOrder, true, true>(F.lds, g, S, E, F.tid); }
        GRID_BAR();
    }
    final_phase(F);
#undef GRID_BAR
}

extern "C" void kernel_launch(void* const* d_in, const int* in_sizes, int n_in, void* d_out, int out_size, void* d_ws, size_t ws_size, hipStream_t stream) {
    static int grid = 0;
    if (grid == 0) {
        if (n_in != 25 || out_size != (int)OUT_TOTAL || ws_size < WS_END) { fprintf(stderr, "kernel_launch: unexpected shapes: n_in %d out %d ws %zu (need %zu)\n", n_in, out_size, ws_size, (size_t)WS_END); grid = -1; return; }
        int dev = 0, cus = 0, per_cu = 0;
        if (hipGetDevice(&dev) != hipSuccess || hipDeviceGetAttribute(&cus, hipDeviceAttributeMultiprocessorCount, dev) != hipSuccess) { grid = -1; return; }
        if (hipFuncSetAttribute((const void*)mega_fwd, hipFuncAttributeMaxDynamicSharedMemorySize, LDS_BYTES) != hipSuccess) { fprintf(stderr, "kernel_launch: hipFuncSetAttribute failed\n"); grid = -1; return; }
        if (hipOccupancyMaxActiveBlocksPerMultiprocessor(&per_cu, (const void*)mega_fwd, NTHR, LDS_BYTES) != hipSuccess || per_cu < 1) { fprintf(stderr, "kernel_launch: occupancy query says %d\n", per_cu); (void)hipGetLastError(); grid = -1; return; }
        grid = cus;
    }
    if (grid < 0) return;
    if (hipMemsetAsync((char*)d_ws + WS_CTL, 0, CTL_ZERO_BYTES, stream) != hipSuccess) return;
    Args a{};
    for (int i = 0; i < 25; ++i) a.in[i] = (const float*)d_in[i];
    a.out = (float*)d_out; a.ws = (unsigned char*)d_ws;
    hipLaunchKernelGGL(mega_fwd, dim3(grid), dim3(NTHR), LDS_BYTES, stream, a);
}
```

```cpp
#include <hip/hip_runtime.h>
#include <cstdio>
#include <cstdint>
namespace pg8 {
#define PG8_LAS __attribute__((address_space(3)))
typedef unsigned short bf16_t;
typedef short bf16x8 __attribute__((ext_vector_type(8)));
typedef float f32x4 __attribute__((ext_vector_type(4)));
typedef unsigned u32x4 __attribute__((ext_vector_type(4)));
constexpr int BM = 256, BK = 64, HALF = 128, HTB = HALF * BK * 2  , STAGE_BYTES = 8 * HTB, NXCD = 8, WGM = 8;

__host__ __device__ __forceinline__ int lds_byte(int r, int c) { const int st = (r >> 4) * 2 + (c >> 5), rr = r & 15, cc = c & 31, ob = rr * 64 + cc * 2; return st * 1024 + (ob ^ (((ob >> 9) & 1) << 5)); }
__host__ __device__ __forceinline__ void stage_rc(int b, int& R, int& C) { const int st = b / 1024, sb = b % 1024, swz = sb ^ (((sb >> 9) & 1) << 5); R = (st >> 1) * 16 + swz / 64; C = (st & 1) * 32 + (swz % 64) / 2; }
__host__ __device__ __forceinline__ int perm32(int rho) { const int n = rho >> 4, i = rho & 15; return 8 * (i >> 2) + 4 * n + (i & 3); }

struct Unit { int pm, pn; };
struct Gemm { const bf16_t* A; const bf16_t* Bt; int M, N, K; };

struct StaticOrder {
    int nM, nN, nwg, G, c;
    __host__ __device__ void init(int M, int N, int G_, int c_) { nM = M / BM; nN = N / BM; nwg = nM * nN; G = G_; c = c_; }
    __host__ __device__ bool next(int i, Unit& u) const {
        const long L = (long)i * G + c; if (L >= nwg) return false;
        int wgid = (int)L; { const int q = nwg / NXCD, r = nwg % NXCD, xcd = wgid % NXCD, off = wgid / NXCD; wgid = (xcd < r ? xcd * (q + 1) : r * (q + 1) + (xcd - r) * q) + off; }
        const int nig = WGM * nN, gid = wgid / nig, fm = gid * WGM, gsz = (nM - fm) < WGM ? (nM - fm) : WGM;
        u.pm = fm + ((wgid % nig) % gsz); u.pn = (wgid % nig) / gsz; return true;
    }
    __device__ __forceinline__ void a_ready(const Unit&) const {}
    __device__ __forceinline__ void done(const Unit&) const {}
};

__device__ __forceinline__ unsigned cvt_pk_bf16(float lo, float hi) { unsigned r; asm volatile("v_cvt_pk_bf16_f32 %0, %1, %2" : "=v"(r) : "v"(lo), "v"(hi)); return r; }
typedef float f32x2 __attribute__((ext_vector_type(2)));
__device__ __forceinline__ f32x2 gelu_pk(f32x2 v) {
    const f32x2 av = __builtin_elementwise_abs(v), d = av * 0.2316418882f + 1.0f;
    f32x2 t; t.x = __builtin_amdgcn_rcpf(d.x); t.y = __builtin_amdgcn_rcpf(d.y);
    f32x2 q = t * 0.5307027145f + (-0.7265760135f); q = q * t + 0.7107068705f; q = q * t + (-0.142248368f); q = q * t + 0.127414796f; q = q * t;
    const f32x2 s = (v * v) * (-0.72134752044f);
    f32x2 e; e.x = __builtin_amdgcn_exp2f(s.x); e.y = __builtin_amdgcn_exp2f(s.y);
    const f32x2 m = v * (q * e), r = v - m;
    f32x2 o; o.x = v.x < 0.f ? m.x : r.x; o.y = v.y < 0.f ? m.y : r.y; return o;
}

template <int ACT  > struct EpiBf16 {
    static constexpr bool PERM = true, AFTER_DRAIN = false, CHAIN = false; static_assert(ACT == 0 || ACT == 1, "EpiBf16: ACT is 0 (none) or 1 (gelu_pk)");
    bf16_t* O; int ldc; const float* bias; int split_cols; size_t split_stride; float scale0;
    __device__ __forceinline__ void operator()(const f32x4 (&acc)[2][2][4][2], const Unit& u, int wr, int wc, int fr, int fq) const {
        const int row0 = u.pm * BM + wr * 64 + fr; int colt = u.pn * BM; bf16_t* base = O;
        float sc = 1.f; if (split_cols) { const int t = colt / split_cols; base += (size_t)t * split_stride; colt -= t * split_cols; if (t == 0) sc = scale0; }
        const int col0 = colt + wc * 32 + 8 * fq, bcol0 = u.pn * BM + wc * 32 + 8 * fq;
        f32x4 bv[2][2];
#pragma unroll
        for (int bj = 0; bj < 2; ++bj)
#pragma unroll
            for (int n = 0; n < 2; ++n) bv[bj][n] = bias ? *(const f32x4*)(bias + bcol0 + bj * HALF + 4 * n) : (f32x4){0.f, 0.f, 0.f, 0.f};
#pragma unroll
        for (int ai = 0; ai < 2; ++ai)
#pragma unroll
            for (int m = 0; m < 4; ++m) { bf16_t* rowp = base + (size_t)(row0 + ai * HALF + m * 16) * ldc + col0;
#pragma unroll
                for (int bj = 0; bj < 2; ++bj) { f32x4 v0 = acc[ai][bj][m][0] + bv[bj][0], v1 = acc[ai][bj][m][1] + bv[bj][1];
                    if (ACT == 1) { f32x2 a = gelu_pk((f32x2){v0[0], v0[1]}), b = gelu_pk((f32x2){v0[2], v0[3]}), c = gelu_pk((f32x2){v1[0], v1[1]}), d = gelu_pk((f32x2){v1[2], v1[3]});
                        v0 = (f32x4){a.x, a.y, b.x, b.y}; v1 = (f32x4){c.x, c.y, d.x, d.y}; }
                    v0 = v0 * sc; v1 = v1 * sc; u32x4 w; w.x = cvt_pk_bf16(v0[0], v0[1]); w.y = cvt_pk_bf16(v0[2], v0[3]); w.z = cvt_pk_bf16(v1[0], v1[1]); w.w = cvt_pk_bf16(v1[2], v1[3]);
                    *(u32x4*)(rowp + bj * HALF) = w; } }
    }
};

template <class Epi, class Sched, bool ALIGN_EPI = false, bool SP2 = false>
__device__ __forceinline__ void gemm_phase(PG8_LAS unsigned char* lds, const Gemm g, const Sched& S, const Epi& E, const int tid_in) {
    int tid_l = tid_in; asm volatile("" : "+v"(tid_l));
    const int tid = tid_l, wid = __builtin_amdgcn_readfirstlane(tid >> 6), lane = tid & 63, wr = wid >> 2, wc = wid & 3, fr = lane & 15, fq = lane >> 4;
    const int K = g.K, nt = K / BK;
    unsigned voffA[2], voffB[2];
#pragma unroll
    for (int i = 0; i < 2; ++i) { int R, C; stage_rc(tid * 16 + i * 8192, R, C); const int Rb = Epi::PERM ? ((R & ~31) + perm32(R & 31)) : R;
        voffA[i] = (unsigned)(R * K + C) * 2u; voffB[i] = (unsigned)(Rb * K + C) * 2u; }
    const size_t kstep = (size_t)(BK * 2);
    const size_t hstep = (size_t)HALF * K * 2;
    const size_t tstep = 2 * hstep;
    const unsigned ldsw = (unsigned)wid * 1024u;
    const int aoff = lds_byte(wr * 64 + fr, fq * 8), boff = lds_byte(wc * 32 + fr, fq * 8);
#define PG8_SA(b, h) (((b) * 2 + (h)) * HTB)
#define PG8_SB(b, h) ((4 + (b) * 2 + (h)) * HTB)
#define PG8_STAGE(bufoff, gbase, voff) do { _Pragma("unroll") for (int _i = 0; _i < 2; ++_i) \
        __builtin_amdgcn_global_load_lds((const unsigned*)((const char*)(gbase) + (voff)[_i]), (PG8_LAS unsigned*)(lds + (bufoff) + ldsw + _i * 8192), 16, 0, 0); } while (0)
#define PG8_LDA(dst, b, h) do { _Pragma("unroll") for (int m = 0; m < 4; ++m) _Pragma("unroll") for (int k = 0; k < 2; ++k) dst[m][k] = *(const PG8_LAS bf16x8*)(lds + PG8_SA(b, h) + aoff + m * 2048 + k * 1024); } while (0)
#define PG8_LDB(dst, b, h) do { _Pragma("unroll") for (int n = 0; n < 2; ++n) _Pragma("unroll") for (int k = 0; k < 2; ++k) dst[n][k] = *(const PG8_LAS bf16x8*)(lds + PG8_SB(b, h) + boff + n * 2048 + k * 1024); } while (0)
#define PG8_MMA(ai, bj, At, Bt) do { __builtin_amdgcn_s_setprio(1); _Pragma("unroll") for (int m = 0; m < 4; ++m) _Pragma("unroll") for (int n = 0; n < 2; ++n) _Pragma("unroll") for (int k = 0; k < 2; ++k) \
        acc[ai][bj][m][n] = __builtin_amdgcn_mfma_f32_16x16x32_bf16(Bt[n][k], At[m][k], acc[ai][bj][m][n], 0, 0, 0); __builtin_amdgcn_s_setprio(0); } while (0)
#define PG8_WAIT_V(n) asm volatile("s_waitcnt vmcnt(" #n ")" ::: "memory")
#define PG8_WAIT_L(n) asm volatile("s_waitcnt lgkmcnt(" #n ")" ::: "memory")
#define PG8_BAR __builtin_amdgcn_s_barrier()
#define PG8_SCHED __builtin_amdgcn_sched_barrier(0)
    Unit cur, nxt; int ui = 0;
    if (!S.next(0, cur)) return;
    f32x4 acc[2][2][4][2];
#pragma unroll
    for (int a = 0; a < 2; ++a)
#pragma unroll
        for (int b = 0; b < 2; ++b)
#pragma unroll
            for (int m = 0; m < 4; ++m)
#pragma unroll
                for (int n = 0; n < 2; ++n) acc[a][b][m][n] = (f32x4){0.f, 0.f, 0.f, 0.f};
    bf16x8 At[4][2], B0[2][2], B1[2][2];
    const char* cA = (const char*)g.A + (size_t)cur.pm * tstep; const char* cB = (const char*)g.Bt + (size_t)cur.pn * tstep;
    S.a_ready(cur);
    if constexpr (SP2) {
        PG8_STAGE(PG8_SB(0, 0), cB, voffB); PG8_STAGE(PG8_SB(0, 1), cB + hstep, voffB); PG8_STAGE(PG8_SA(0, 0), cA, voffA); PG8_STAGE(PG8_SA(0, 1), cA + hstep, voffA);
        if (wr == 1) PG8_BAR;
        PG8_WAIT_V(2); PG8_BAR;
        PG8_STAGE(PG8_SB(1, 0), cB + kstep, voffB); PG8_STAGE(PG8_SA(1, 0), cA + kstep, voffA); PG8_STAGE(PG8_SB(1, 1), cB + hstep + kstep, voffB);
        PG8_WAIT_V(6); PG8_BAR;
    } else {
        PG8_STAGE(PG8_SB(0, 0), cB, voffB); PG8_STAGE(PG8_SA(0, 0), cA, voffA); PG8_STAGE(PG8_SB(0, 1), cB + hstep, voffB); PG8_STAGE(PG8_SA(0, 1), cA + hstep, voffA);
        if (wr == 1) PG8_BAR;
        PG8_WAIT_V(4); PG8_BAR;
        PG8_STAGE(PG8_SB(1, 0), cB + kstep, voffB); PG8_STAGE(PG8_SA(1, 0), cA + kstep, voffA); PG8_STAGE(PG8_SB(1, 1), cB + hstep + kstep, voffB);
        PG8_WAIT_V(6); PG8_BAR;
    }
    for (;;) {
        const bool has_next = S.next(ui + 1, nxt);
        const char* nA = has_next ? (const char*)g.A + (size_t)nxt.pm * tstep : cA; const char* nB = has_next ? (const char*)g.Bt + (size_t)nxt.pn * tstep : cB;
        for (int t = 0; t < nt; t += 2) {
            const bool last = (t == nt - 2);
            const char* a1 = cA + (size_t)(t + 1) * kstep;
            const char* a2 = last ? nA : cA + (size_t)(t + 2) * kstep; const char* b2 = last ? nB : cB + (size_t)(t + 2) * kstep;
            const char* a3 = a2 + kstep; const char* b3 = b2 + kstep;
            if (last && has_next) S.a_ready(nxt);
            if constexpr (SP2) {
            PG8_LDB(B0, 0, 0); PG8_LDB(B1, 0, 1); PG8_SCHED; PG8_LDA(At, 0, 0); PG8_STAGE(PG8_SA(1, 1), a1 + hstep, voffA);
            PG8_WAIT_V(8); PG8_WAIT_L(0); PG8_BAR; PG8_MMA(0, 0, At, B0); PG8_MMA(0, 1, At, B1); PG8_BAR; PG8_SCHED;
            PG8_LDA(At, 0, 1); PG8_STAGE(PG8_SB(0, 0), b2, voffB); PG8_STAGE(PG8_SB(0, 1), b2 + hstep, voffB); PG8_STAGE(PG8_SA(0, 0), a2, voffA);
            PG8_WAIT_V(8); PG8_WAIT_L(0); PG8_BAR; PG8_MMA(1, 0, At, B0); PG8_MMA(1, 1, At, B1); PG8_BAR; PG8_SCHED;
            PG8_LDB(B0, 1, 0); PG8_LDB(B1, 1, 1); PG8_SCHED; PG8_LDA(At, 1, 0); PG8_STAGE(PG8_SA(0, 1), a2 + hstep, voffA);
            PG8_WAIT_V(8); PG8_WAIT_L(0); PG8_BAR; PG8_MMA(0, 0, At, B0); PG8_MMA(0, 1, At, B1); PG8_BAR; PG8_SCHED;
            PG8_LDA(At, 1, 1); PG8_STAGE(PG8_SB(1, 0), b3, voffB); PG8_STAGE(PG8_SB(1, 1), b3 + hstep, voffB); PG8_STAGE(PG8_SA(1, 0), a3, voffA);
            PG8_WAIT_V(8); PG8_WAIT_L(0); PG8_BAR; PG8_MMA(1, 0, At, B0); PG8_MMA(1, 1, At, B1); PG8_BAR; PG8_SCHED;
            } else {
            PG8_LDB(B0, 0, 0); PG8_SCHED; PG8_LDA(At, 0, 0); PG8_STAGE(PG8_SA(1, 1), a1 + hstep, voffA);
            PG8_WAIT_L(8); PG8_BAR; PG8_WAIT_L(0); PG8_MMA(0, 0, At, B0); PG8_BAR; PG8_SCHED;
            PG8_LDB(B1, 0, 1); PG8_STAGE(PG8_SB(0, 0), b2, voffB);
            PG8_BAR; PG8_WAIT_L(0); PG8_MMA(0, 1, At, B1); PG8_BAR;
            PG8_LDA(At, 0, 1); PG8_STAGE(PG8_SA(0, 0), a2, voffA);
            PG8_BAR; PG8_WAIT_L(0); PG8_MMA(1, 0, At, B0); PG8_BAR; PG8_SCHED;
            PG8_STAGE(PG8_SB(0, 1), b2 + hstep, voffB);
            PG8_WAIT_V(6); PG8_BAR; PG8_MMA(1, 1, At, B1); PG8_BAR;
            PG8_LDB(B0, 1, 0); PG8_SCHED; PG8_LDA(At, 1, 0); PG8_STAGE(PG8_SA(0, 1), a2 + hstep, voffA);
            PG8_WAIT_L(8); PG8_BAR; PG8_WAIT_L(0); PG8_MMA(0, 0, At, B0); PG8_BAR; PG8_SCHED;
            PG8_LDB(B1, 1, 1); PG8_STAGE(PG8_SB(1, 0), b3, voffB);
            PG8_BAR; PG8_WAIT_L(0); PG8_MMA(0, 1, At, B1); PG8_BAR;
            PG8_LDA(At, 1, 1); PG8_STAGE(PG8_SA(1, 0), a3, voffA);
            PG8_BAR; PG8_WAIT_L(0); PG8_MMA(1, 0, At, B0); PG8_BAR; PG8_SCHED;
            PG8_STAGE(PG8_SB(1, 1), b3 + hstep, voffB);
            PG8_WAIT_V(6); PG8_BAR; PG8_MMA(1, 1, At, B1); PG8_BAR;
            }
        }
        if constexpr (ALIGN_EPI) { if (wr == 0) PG8_BAR; }
        if constexpr (!Epi::AFTER_DRAIN) { E(acc, cur, wr, wc, fr, fq); S.done(cur); }
        if (!has_next) break;
        if constexpr (!Epi::CHAIN) {
#pragma unroll
        for (int a = 0; a < 2; ++a)
#pragma unroll
            for (int b = 0; b < 2; ++b)
#pragma unroll
                for (int m = 0; m < 4; ++m)
#pragma unroll
                    for (int n = 0; n < 2; ++n) acc[a][b][m][n] = (f32x4){0.f, 0.f, 0.f, 0.f};
        }
        cur = nxt; cA = nA; cB = nB; ++ui;
        if constexpr (ALIGN_EPI) { if (wr == 1) PG8_BAR; }
    }
    PG8_WAIT_V(0);
    if constexpr (!ALIGN_EPI) { if (wr == 0) PG8_BAR; }
    PG8_BAR;
    if constexpr (Epi::AFTER_DRAIN) { E.fused(acc, cur, wr, wc, fr, fq, lds, wid, lane); S.done(cur); }
#undef PG8_SA
#undef PG8_SB
#undef PG8_STAGE
#undef PG8_LDA
#undef PG8_LDB
#undef PG8_MMA
#undef PG8_WAIT_V
#undef PG8_WAIT_L
#undef PG8_BAR
#undef PG8_SCHED
}
}
#define GAS __attribute__((address_space(1)))
#define LAS __attribute__((address_space(3)))
typedef unsigned short bf16;
typedef unsigned v4u __attribute__((ext_vector_type(4)));
typedef float f32x4 __attribute__((ext_vector_type(4)));
typedef short bf16x8 __attribute__((ext_vector_type(8)));
typedef GAS unsigned gu32;
typedef GAS unsigned long long gu64;
#define RLX_AGENT __ATOMIC_RELAXED, __HIP_MEMORY_SCOPE_AGENT
#define LDS_WAIT() asm volatile("s_waitcnt lgkmcnt(0)" ::: "memory")
#define VM_WAIT() asm volatile("s_waitcnt vmcnt(0)" ::: "memory")
__device__ __forceinline__ unsigned long long rt() { return __builtin_amdgcn_s_memrealtime(); }
__device__ __forceinline__ unsigned f2bf(float f) { unsigned u = __builtin_bit_cast(unsigned, f); return (u + 0x7fffu + ((u >> 16) & 1u)) >> 16; }
__device__ __forceinline__ unsigned pk2(float lo, float hi) { return f2bf(lo) | (f2bf(hi) << 16); }

#define XB_TMO      128
#define XB_XCNT(j)  (256  + 64 * (j))
#define XB_XSUB(j)  (1280 + 64 * (j))
#define XB_XGEN(j)  (2304 + 64 * (j))
#define XB_TOP      3328
#define XB_TOPGEN   3392
#define XCD_BAR_WORDS 3456
#define XB_SPIN_CAP (1u << 18)

__device__ __forceinline__ unsigned xb_ld(unsigned* p)              { return __hip_atomic_load(p, __ATOMIC_RELAXED, __HIP_MEMORY_SCOPE_AGENT); }
__device__ __forceinline__ unsigned xb_add(unsigned* p, unsigned v) { return __hip_atomic_fetch_add(p, v, __ATOMIC_RELAXED, __HIP_MEMORY_SCOPE_AGENT); }
__device__ __forceinline__ unsigned xb_xcc_id() { return (unsigned)__builtin_amdgcn_s_getreg((3 << 11) | 20) & 0xFu; }
#define XB_SPIN(cond, bar) do { unsigned _sp = 0; while (cond) { __builtin_amdgcn_s_sleep(1); \
    if ((++_sp & 255u) == 0u) { if (xb_ld(&(bar)[XB_TMO])) break; if (_sp > XB_SPIN_CAP) { atomicAdd(&(bar)[XB_TMO], 1u); break; } } } } while (0)

struct XcdBarrier {
    unsigned* bar; unsigned x;
    volatile LAS unsigned* st;
};

__device__ __forceinline__ XcdBarrier xcd_barrier_post(unsigned* bar, volatile LAS unsigned* st, const int tid) {
    XcdBarrier b; b.bar = bar; b.x = xb_xcc_id(); b.st = st;
    if (tid == 0) (void)xb_add(&bar[XB_XCNT(b.x)], 1u);
    return b;
}
__device__ __forceinline__ void xcd_barrier_complete(unsigned* bar, unsigned x, unsigned& nloc, unsigned& nx) {
    const unsigned G = gridDim.x * gridDim.y * gridDim.z;
    unsigned sum, cnt, mine, sp = 0u;
    for (;;) {
        sum = 0u; cnt = 0u; mine = 0u;
#pragma unroll
        for (unsigned j = 0; j < 16; ++j) { const unsigned c = xb_ld(&bar[XB_XCNT(j)]); sum += c; cnt += (c > 0u) ? 1u : 0u; mine = (j == x) ? c : mine; }
        if (sum == G) break;
        __builtin_amdgcn_s_sleep(1);
        if ((++sp & 255u) == 0u) { if (xb_ld(&bar[XB_TMO])) break; if (sp > XB_SPIN_CAP) { atomicAdd(&bar[XB_TMO], 1u); break; } }
    }
    nloc = mine > 0u ? mine : 1u; nx = cnt > 0u ? cnt : 1u;
}

__device__ __forceinline__ void xcd_barrier(const XcdBarrier& b, const int tid) {
    asm volatile("s_waitcnt vmcnt(0)" ::: "memory");
    __syncthreads();
    if (tid == 0) {
        unsigned* bar = b.bar;
        __builtin_amdgcn_s_waitcnt(0);
        unsigned nloc = b.st[0], nx = b.st[1];
        if (nloc == 0u) { xcd_barrier_complete(bar, b.x, nloc, nx); b.st[0] = nloc; b.st[1] = nx; }
        const unsigned old = xb_add(&bar[XB_XSUB(b.x)], 1u);
        const unsigned gen = old / nloc;
        if (old + 1u == (gen + 1u) * nloc) {
            __builtin_amdgcn_fence(__ATOMIC_RELEASE, "agent");
            asm volatile("s_waitcnt vmcnt(0)" ::: "memory");
            const unsigned og = xb_add(&bar[XB_TOP], 1u);
            const unsigned tg = og / nx;
            if (og + 1u == (tg + 1u) * nx) xb_add(&bar[XB_TOPGEN], 1u);
            else XB_SPIN(xb_ld(&bar[XB_TOPGEN]) == tg, bar);
            __builtin_amdgcn_fence(__ATOMIC_ACQUIRE, "agent");
            xb_add(&bar[XB_XGEN(b.x)], 1u);
            asm volatile("s_waitcnt vmcnt(0)" ::: "memory");
        } else {
            XB_SPIN(xb_ld(&bar[XB_XGEN(b.x)]) == gen, bar);
            __builtin_amdgcn_fence(__ATOMIC_ACQUIRE, "agent");
            asm volatile("s_waitcnt vmcnt(0)" ::: "memory");
        }
    }
    __syncthreads();
}
namespace att {
typedef __attribute__((ext_vector_type(8))) short bf16x8;
typedef __attribute__((ext_vector_type(4))) short s16x4;
typedef __attribute__((ext_vector_type(16))) float f32x16;
typedef __attribute__((ext_vector_type(4))) unsigned u32x4;
typedef unsigned short bf16;
constexpr int D = 128, NW = 8, QBLK = 32, KVBLK = 64, LDQ = 1024;
constexpr float SCALE = 0.088388347648318440f, THR = 8.f;
constexpr int SHM_V = KVBLK * D * 2, SHM_K = KVBLK * D * 2;
constexpr int WS_OFF = 2 * SHM_V + 2 * SHM_K, TAB_OFF = WS_OFF + NW * 64 * 4, ATT_LDS_BYTES = TAB_OFF + 2048;
#define KSWZ(row, colB) ((row) * 256 + ((colB) ^ (((row) & 7) << 4)))
#define SBAR() __builtin_amdgcn_sched_barrier(0)
__device__ __forceinline__ int crow(int r, int hi) { return (r & 3) + 8 * (r >> 2) + 4 * hi; }
__device__ __forceinline__ unsigned cvtpk(float lo, float hi) { unsigned r; asm volatile("v_cvt_pk_bf16_f32 %0, %1, %2" : "=v"(r) : "v"(lo), "v"(hi)); return r; }
__device__ __forceinline__ bf16x8 ld8(const bf16* p) { return *reinterpret_cast<const bf16x8*>(p); }

__device__ __forceinline__ void partialSM(f32x16& p0, f32x16& p1, float& m_reg, float& mn, float& alpha) {
  constexpr float C = SCALE * 1.4426950408889634f;
  float pmax = p0[0]; for (int r = 1; r < 16; ++r) pmax = fmaxf(pmax, p0[r]); for (int r = 0; r < 16; ++r) pmax = fmaxf(pmax, p1[r]);
  { auto rr = __builtin_amdgcn_permlane32_swap(__float_as_uint(pmax), __float_as_uint(pmax), false, false);
    pmax = fmaxf(__uint_as_float(rr[0]), __uint_as_float(rr[1])); }
  if (__builtin_expect(__all(pmax - m_reg <= THR / SCALE), 1)) { mn = m_reg; alpha = 1.f; }
  else { mn = fmaxf(m_reg, pmax); alpha = __builtin_amdgcn_exp2f((m_reg - mn) * C); m_reg = mn; }
  float mnC = -mn * C;
  for (int r = 0; r < 16; ++r) p0[r] = fmaf(p0[r], C, mnC); for (int r = 0; r < 16; ++r) p1[r] = fmaf(p1[r], C, mnC);
  for (int r = 0; r < 16; ++r) p0[r] = __builtin_amdgcn_exp2f(p0[r]);
}
__device__ __forceinline__ void finishSM(f32x16& p0, f32x16& p1, float alpha, float& l_reg, bf16x8& pa0, bf16x8& pa1, bf16x8& pa2, bf16x8& pa3) {
  for (int r = 0; r < 16; ++r) p1[r] = __builtin_amdgcn_exp2f(p1[r]);
  float ps = 0; for (int r = 0; r < 16; ++r) ps += p0[r]; for (int r = 0; r < 16; ++r) ps += p1[r];
  { auto rr = __builtin_amdgcn_permlane32_swap(__float_as_uint(ps), __float_as_uint(ps), false, false);
    ps = __uint_as_float(rr[0]) + __uint_as_float(rr[1]); }
  l_reg = l_reg * alpha + ps;
#define PK4(P, BASE, OUT) do { unsigned a0 = cvtpk(P[BASE + 0], P[BASE + 1]), a1 = cvtpk(P[BASE + 2], P[BASE + 3]);   \
    unsigned b0 = cvtpk(P[BASE + 4], P[BASE + 5]), b1 = cvtpk(P[BASE + 6], P[BASE + 7]);                              \
    auto r0 = __builtin_amdgcn_permlane32_swap(a0, b0, false, false); auto r1 = __builtin_amdgcn_permlane32_swap(a1, b1, false, false); \
    u32x4 w = {r0[0], r1[0], r0[1], r1[1]}; OUT = *reinterpret_cast<bf16x8*>(&w); } while (0)
  PK4(p0, 0, pa0); PK4(p0, 8, pa1); PK4(p1, 0, pa2); PK4(p1, 8, pa3);
#undef PK4
}
__device__ __forceinline__ void qkt(f32x16& p0, f32x16& p1, const bf16* Ks, const bf16x8* qr, int r32, int hi) {
  p0 = f32x16{}; p1 = f32x16{};
  const char* kb[4];
#pragma unroll
  for (int dd = 0; dd < 4; ++dd) kb[dd] = (const char*)Ks + KSWZ(r32, (dd * 16 + hi * 8) * 2);
#pragma unroll
  for (int d0 = 0; d0 < 8; ++d0) { const char* a = kb[d0 & 3] + (d0 >> 2) * 128;
    bf16x8 b0 = *reinterpret_cast<const bf16x8*>(a);
    bf16x8 b1 = *reinterpret_cast<const bf16x8*>(a + 32 * 256);
    p0 = __builtin_amdgcn_mfma_f32_32x32x16_bf16(b0, qr[d0], p0, 0, 0, 0);
    p1 = __builtin_amdgcn_mfma_f32_32x32x16_bf16(b1, qr[d0], p1, 0, 0, 0); }
}
__device__ __forceinline__ int v_st(int k, int c) { const int kk = (k & ~0xC) | ((k & 4) << 1) | ((k & 8) >> 1); return ((kk >> 3) * 4 + (c >> 5)) * 512 + ((kk & 7) * 32 + (c & 31)) * 2; }
__device__ __forceinline__ int v_rd_base(int lane) { return ((lane & 3) << 3) | (((lane >> 2) & 3) << 6) | (((lane >> 4) & 1) << 5) | (((lane >> 5) & 1) << 8); }
constexpr int v_rd_off(int d0, int ks, int half) { return d0 * 512 + ks * 4096 + half * 2048; }
template <int OFF> __device__ __forceinline__ s16x4 tr_read(int vb) {
  s16x4 r; asm volatile("ds_read_b64_tr_b16 %0, %1 offset:%2" : "=&v"(r) : "v"(vb), "i"(OFF) : "memory"); return r;
}
template <int D0> __device__ __forceinline__ void pv_one(f32x16& od, int vb, bf16x8 pa0, bf16x8 pa1, bf16x8 pa2, bf16x8 pa3) {
  const s16x4 l0 = tr_read<v_rd_off(D0, 0, 0)>(vb), h0 = tr_read<v_rd_off(D0, 0, 1)>(vb), l1 = tr_read<v_rd_off(D0, 1, 0)>(vb), h1 = tr_read<v_rd_off(D0, 1, 1)>(vb);
  const s16x4 l2 = tr_read<v_rd_off(D0, 2, 0)>(vb), h2 = tr_read<v_rd_off(D0, 2, 1)>(vb), l3 = tr_read<v_rd_off(D0, 3, 0)>(vb), h3 = tr_read<v_rd_off(D0, 3, 1)>(vb);
  asm volatile("s_waitcnt lgkmcnt(0)" ::: "memory"); SBAR();
#define PK(L, H) (bf16x8){L[0], L[1], L[2], L[3], H[0], H[1], H[2], H[3]}
  od = __builtin_amdgcn_mfma_f32_32x32x16_bf16(pa0, PK(l0, h0), od, 0, 0, 0);
  od = __builtin_amdgcn_mfma_f32_32x32x16_bf16(pa1, PK(l1, h1), od, 0, 0, 0);
  od = __builtin_amdgcn_mfma_f32_32x32x16_bf16(pa2, PK(l2, h2), od, 0, 0, 0);
  od = __builtin_amdgcn_mfma_f32_32x32x16_bf16(pa3, PK(l3, h3), od, 0, 0, 0);
#undef PK
}
__device__ __forceinline__ void pv_d0(f32x16* o, int vb, bf16x8 pa0, bf16x8 pa1, bf16x8 pa2, bf16x8 pa3) {
  pv_one<0>(o[0], vb, pa0, pa1, pa2, pa3); pv_one<1>(o[1], vb, pa0, pa1, pa2, pa3); pv_one<2>(o[2], vb, pa0, pa1, pa2, pa3); pv_one<3>(o[3], vb, pa0, pa1, pa2, pa3);
}

struct Unit {
  const bf16* Q; bf16* O;
  const bf16* K0; const bf16* V0;
  const bf16* K1; const bf16* V1;
  int n0, n1, ldk;
  int mode;
  int a, b;
  float sink2;
  const float* tab;
};
__device__ __forceinline__ void mask_nat(f32x16& p0, f32x16& p1, bool rowvis, int cs4, int cqb, const float* trow) {
  const float NEG = -__builtin_inff();
  if (!rowvis) {
#pragma unroll
    for (int r = 0; r < 16; ++r) { p0[r] = NEG; p1[r] = NEG; }
    return; }
#pragma unroll
  for (int r = 0; r < 16; ++r) { const int cc = (r & 3) + 8 * (r >> 2);
    { const int i0 = min(max(cc - cqb, 0), 30); const float bv = trow[i0]; p0[r] = ((unsigned)(cc - cs4) < 16u) ? p0[r] + bv : NEG; }
    { const int i1 = min(max(cc + 32 - cqb, 0), 30); const float bv = trow[i1]; p1[r] = ((unsigned)(cc + 32 - cs4) < 16u) ? p1[r] + bv : NEG; } }
}
__device__ __forceinline__ void mask_win(f32x16& p0, f32x16& p1, int dq) {
  const float NEG = -__builtin_inff();
#pragma unroll
  for (int r = 0; r < 16; ++r) { const int cc = (r & 3) + 8 * (r >> 2);
    if ((unsigned)(dq + cc) > 256u) p0[r] = NEG;
    if ((unsigned)(dq + cc + 32) > 256u) p1[r] = NEG; }
}

__device__ __forceinline__ void attn_unit(const Unit& U, char* lds, const int tid_in) {
  int tid_l = tid_in; asm volatile("" : "+v"(tid_l));
  const int tid = tid_l, wid = __builtin_amdgcn_readfirstlane(tid >> 6), lane = tid & 63, r32 = lane & 31, hi = lane >> 5;
  bf16* V_lds = (bf16*)lds; bf16* K_lds = (bf16*)(lds + 2 * SHM_V);
  float* ws = (float*)(lds + WS_OFF) + wid * 64; float* li_l = ws; float* al_l = ws + 32;
  float* tabL = (float*)(lds + TAB_OFF);
  if (U.mode == 1) { for (int i = tid; i < 465; i += 512) tabL[i] = U.tab[i] * (1.0f / SCALE); }
  float m_reg = -1e30f, l_reg = 0; f32x16 o[4] = {}; bf16x8 qr[8];
  const bf16* Qw = U.Q + (long)(wid * QBLK + r32) * LDQ + hi * 8;
#pragma unroll
  for (int d0 = 0; d0 < 8; ++d0) qr[d0] = ld8(Qw + d0 * 16);
  const int ldk = U.ldk, n0 = U.n0, NT = U.n0 + U.n1;
  const int sr = tid >> 4, sc = (tid & 15) * 8, vst0 = v_st(sr, sc), vst1 = v_st(32 + sr, sc);
  const int vb0 = (int)(uintptr_t)V_lds + v_rd_base(lane);
  struct { bf16x8 vs0, vs1, ks0, ks1; } sr_[1];
  const int maskA = U.a, maskB = U.b;
#define SLOAD(i, t) do { const int t_ = (t); const bf16* Kp_ = t_ < n0 ? U.K0 + (long)t_ * KVBLK * ldk : U.K1 + (long)(t_ - n0) * KVBLK * ldk;  \
    const bf16* Vp_ = t_ < n0 ? U.V0 + (long)t_ * KVBLK * ldk : U.V1 + (long)(t_ - n0) * KVBLK * ldk;                                         \
    sr_[i].vs0 = ld8(&Vp_[(long)sr * ldk + sc]); sr_[i].vs1 = ld8(&Vp_[(long)(32 + sr) * ldk + sc]);                                           \
    sr_[i].ks0 = ld8(&Kp_[(long)sr * ldk + sc]); sr_[i].ks1 = ld8(&Kp_[(long)(32 + sr) * ldk + sc]); } while (0)
#define SWRITE(b, i) do { *(bf16x8*)((char*)V_lds + (b) * SHM_V + vst0) = sr_[i].vs0;          \
    *(bf16x8*)((char*)V_lds + (b) * SHM_V + vst1) = sr_[i].vs1; int kc = sc * 2;               \
    *(bf16x8*)((char*)K_lds + (b) * SHM_K + KSWZ(sr, kc)) = sr_[i].ks0;                       \
    *(bf16x8*)((char*)K_lds + (b) * SHM_K + KSWZ(32 + sr, kc)) = sr_[i].ks1; } while (0)
#define SWAIT() asm volatile("s_waitcnt vmcnt(0)" ::: "memory")
#define RESC(a) do { if (__any((a) < 1.f)) { if (hi == 0) al_l[r32] = (a); asm volatile("s_waitcnt lgkmcnt(0)" ::: "memory"); \
    for (int d = 0; d < 4; ++d) for (int r = 0; r < 16; ++r) o[d][r] *= al_l[crow(r, hi)]; } } while (0)
#define MASK(P0, P1, t) do { if (U.mode != 0 && (t) >= n0) { const int tl_ = (t) - n0; int ln_ = lane; asm volatile("" : "+v"(ln_));     \
    const int r32_ = ln_ & 31, hi_ = ln_ >> 5;                                                                                                  \
    if (U.mode == 1) { const int rq_ = maskA + (wid >> 1), rsq_ = min(max(rq_ - 4, 0), 56), kr_ = maskB + tl_; const bool rv_ = (unsigned)(kr_ - rsq_) < 8u; const int dr_ = rv_ ? kr_ - rq_ + 7 : 0; \
        const int cq_ = 32 * (wid & 1) + r32_, cs_ = min(max(cq_ - 8, 0), 48);                                                                   \
        mask_nat(P0, P1, rv_, cs_ - 4 * hi_, cq_ - 15 - 4 * hi_, tabL + dr_ * 31); }                                                             \
    else { mask_win(P0, P1, maskB + tl_ * KVBLK - (maskA + 32 * wid + r32_) + 4 * hi_ + 128); } } } while (0)
  f32x16 pA0, pA1, pB0, pB1; float mnA, mnB, alA, alB; bf16x8 pa0, pa1, pa2, pa3;
  constexpr int SE = 0, SO = 0;
  SLOAD(SE, 0); asm volatile("s_waitcnt vmcnt(0)" ::: "memory"); SWRITE(0, SE); __syncthreads();
  qkt(pA0, pA1, K_lds, qr, r32, hi); MASK(pA0, pA1, 0); partialSM(pA0, pA1, m_reg, mnA, alA);
  SLOAD(SO, 1);
  SWAIT(); SWRITE(1, SO); __syncthreads();
  for (int j = 1; j + 1 < NT; j += 2) {
    SBAR(); qkt(pB0, pB1, (bf16*)((char*)K_lds + SHM_K), qr, r32, hi);
    finishSM(pA0, pA1, alA, l_reg, pa0, pa1, pa2, pa3); SBAR();
    SLOAD(SO, j + 1); SBAR();
    pv_d0(o, vb0, pa0, pa1, pa2, pa3); MASK(pB0, pB1, j); partialSM(pB0, pB1, m_reg, mnB, alB);
    __syncthreads(); SWAIT(); SWRITE(0, SE);
    RESC(alB); __syncthreads();
    SBAR(); qkt(pA0, pA1, K_lds, qr, r32, hi);
    finishSM(pB0, pB1, alB, l_reg, pa0, pa1, pa2, pa3); SBAR();
    SLOAD(SE, j + 2); SBAR();
    pv_d0(o, vb0 + (int)SHM_V, pa0, pa1, pa2, pa3); MASK(pA0, pA1, j + 1); partialSM(pA0, pA1, m_reg, mnA, alA);
    __syncthreads(); SWAIT(); SWRITE(1, SO);
    RESC(alA); __syncthreads();
  }
  SBAR(); qkt(pB0, pB1, (bf16*)((char*)K_lds + SHM_K), qr, r32, hi);
  finishSM(pA0, pA1, alA, l_reg, pa0, pa1, pa2, pa3); SBAR();
  pv_d0(o, vb0, pa0, pa1, pa2, pa3); MASK(pB0, pB1, NT - 1); partialSM(pB0, pB1, m_reg, mnB, alB);
  __syncthreads(); RESC(alB);
  finishSM(pB0, pB1, alB, l_reg, pa0, pa1, pa2, pa3); SBAR();
  pv_d0(o, vb0 + (int)SHM_V, pa0, pa1, pa2, pa3);
  l_reg += __builtin_amdgcn_exp2f(U.sink2 - m_reg * (SCALE * 1.4426950408889634f));
  if (hi == 0) li_l[r32] = l_reg; asm volatile("s_waitcnt lgkmcnt(0)" ::: "memory");
  float rli[16];
#pragma unroll
  for (int r = 0; r < 16; ++r) rli[r] = __builtin_amdgcn_rcpf(li_l[crow(r, hi)]);
  __syncthreads();
  { bf16* stg = (bf16*)(lds + wid * 8192);
#pragma unroll
    for (int r = 0; r < 16; ++r) { const int orow = crow(r, hi);
#pragma unroll
      for (int d0 = 0; d0 < 4; ++d0) stg[orow * 128 + d0 * 32 + r32] = (bf16)(cvtpk(o[d0][r] * rli[r], 0.f) & 0xffffu); }
    asm volatile("s_waitcnt lgkmcnt(0)" ::: "memory");
    bf16* Ow = U.O + (long)(wid * QBLK) * LDQ;
#pragma unroll
    for (int i = 0; i < 8; ++i) { const int row = 4 * i + (lane >> 4), ch = lane & 15; const u32x4 v = *(const u32x4*)(stg + row * 128 + ch * 8);
      *(u32x4*)(Ow + (long)row * LDQ + ch * 8) = v; } }
  __syncthreads();
#undef SLOAD
#undef SWRITE
#undef SWAIT
#undef RESC
#undef MASK
}
#undef KSWZ
#undef SBAR
}
constexpr int DM = 2048, R_CTX = 4096, R_LAT = 8192, RT = 12288, FF = 5632, NGU = 11264, DIN = 12288, HD = 128;
constexpr int NWAVES = 8, NTHR = 512;
constexpr float EPS_N = 1e-6f, SM_SCALE = 0.08838834764831845f;
constexpr size_t MiB = 1u << 20;
constexpr size_t WS_CTL = 0, CTL_ZERO_BYTES = 1 * MiB;
constexpr size_t WS_MODS = 1 * MiB;
constexpr size_t WS_ROPE = 2 * MiB;
constexpr size_t WS_CACHE = 4 * MiB;
constexpr size_t WS_W = 16 * MiB, W_LAYER = 200 * MiB;
constexpr size_t W_GU1 = 0, W_D1 = 44 * MiB, W_IN = 66 * MiB, W_B = 114 * MiB, W_O = 126 * MiB, W_GU2 = 134 * MiB, W_D2 = 178 * MiB;
constexpr size_t WS_H = 416 * MiB;
constexpr size_t WS_ACT = 464 * MiB;
constexpr size_t WS_Z = 596 * MiB;
constexpr size_t WS_QKVG = 884 * MiB;
constexpr size_t WS_END = 1172 * MiB;
constexpr int CW_BAR = 4096;
constexpr int EXCH_OFF = 131072, LDSCTL_OFF = 139264, MISC_OFF = LDSCTL_OFF + 320, LDS_BYTES = 147456;
constexpr size_t OUT_YP = 0, OUT_YS = 8388608, OUT_KGQA = 25165824, OUT_VGQA = 27262976, OUT_KNAT = 29360128, OUT_VNAT = 37748736, OUT_KWIN = 46137344, OUT_VWIN = 48234496, OUT_TOTAL = 50331648;

constexpr int MAP_GU = 1, MAP_IN = 2;
struct Args { const float* in[25]; float* out; unsigned char* ws; };

struct Frame {
    LAS unsigned char* lds;
    int tid, lane, wave, G, bid;
    float* out; unsigned char* ws;
};
#define CAS __attribute__((address_space(4)))
__device__ __forceinline__ const float* in_ptr(int k) { const CAS char* p = (const CAS char*)__builtin_amdgcn_kernarg_segment_ptr(); asm volatile("" : "+s"(p)); return *(const float* const CAS*)(p + 8 * k); }

__device__ __forceinline__ float shx(float v, int mask, int lane) { return __uint_as_float((unsigned)__builtin_amdgcn_ds_bpermute((lane ^ mask) << 2, (int)__float_as_uint(v))); }
__device__ __forceinline__ float wave_sum(float v, int lane) {
#pragma unroll
    for (int o = 1; o < 64; o <<= 1) v += shx(v, o, lane);
    return v;
}
__device__ __forceinline__ float bf2f(unsigned b) { return __uint_as_float(b << 16); }
__device__ __forceinline__ float bflo(unsigned w) { return __uint_as_float(w << 16); }
__device__ __forceinline__ float bfhi(unsigned w) { return __uint_as_float(w & 0xffff0000u); }
__device__ __forceinline__ float sigm(float x) { return 1.f / (1.f + __expf(-x)); }

__device__ __forceinline__ int rowmap(int MAP, int s) {
    if (MAP == 1) { const int n = s >= FF ? 1 : 0, j = s - FF * n, pn = j >> 7, jj = j & 127, wc = jj >> 5, fq = (jj & 31) >> 3, bj = (jj & 7) >> 2, e = jj & 3;
        return 256 * pn + 128 * bj + 32 * wc + 16 * n + 4 * fq + e; }
    if (MAP == 2) { const int pn = s >> 8, c = s & 255, bj = c >> 7, d = c & 127; const bool ropet = pn < 5 || (pn >= 18 && pn < 23);
        if (ropet) { const int h2 = d >> 6, n = (d & 63) >> 5, w1 = (d & 31) >> 4, fq = (d & 15) >> 2, e = d & 3; return 256 * pn + 128 * bj + 32 * (2 * h2 + w1) + 16 * n + 4 * fq + e; }
        const int wc = d >> 5, fq = (d & 31) >> 3, n = (d & 7) >> 2, e = d & 3; return 256 * pn + 128 * bj + 32 * wc + 16 * n + 4 * fq + e; }
    return s;
}
__device__ __forceinline__ void transpose_item(const float* W, int K, int N, bf16* WT, LAS float* scr, int k0, int n0, int lane, int MAP) {
    f32x4 tv[16];
#pragma unroll
    for (int i = 0; i < 16; ++i) tv[i] = *(const GAS f32x4*)(W + (size_t)(k0 + 4 * i + (lane >> 4)) * N + n0 + 4 * (lane & 15));
#pragma unroll
    for (int i = 0; i < 16; ++i) { LAS float* s = scr + (4 * i + (lane >> 4)) * 65 + 4 * (lane & 15); s[0] = tv[i].x; s[1] = tv[i].y; s[2] = tv[i].z; s[3] = tv[i].w; }
    LDS_WAIT(); asm volatile("" ::: "memory");
    const int c = lane & 7;
#pragma unroll
    for (int j = 0; j < 8; ++j) {
        const int n = 8 * j + (lane >> 3); const LAS float* s = scr + (8 * c) * 65 + n;
        v4u o; o.x = pk2(s[0], s[65]); o.y = pk2(s[130], s[195]); o.z = pk2(s[260], s[325]); o.w = pk2(s[390], s[455]);
        *(GAS v4u*)(WT + (size_t)rowmap(MAP, n0 + n) * K + k0 + 8 * c) = o;
    }
    LDS_WAIT(); asm volatile("" ::: "memory");
}
__device__ __forceinline__ void transpose_matrix(Frame& F, const float* W, int K, int N, bf16* WT, int MAP) {
    LAS float* scr = (LAS float*)(F.lds + F.wave * 16640);
    const int gw = F.bid * NWAVES + F.wave, NGW = F.G * NWAVES, nb = N / 64, items = (K / 64) * nb;
    for (int it = gw; it < items; it += NGW) transpose_item(W, K, N, WT, scr, 64 * (it / nb), 64 * (it % nb), F.lane, MAP);
}
__device__ __forceinline__ void cvt_array(Frame& F, const float* src, bf16* dst, int n8) {
    for (int i = F.bid * NTHR + F.tid; i < n8; i += F.G * NTHR) {
        const f32x4 a = *(const GAS f32x4*)(src + (size_t)i * 8), b = *(const GAS f32x4*)(src + (size_t)i * 8 + 4);
        v4u o; o.x = pk2(a.x, a.y); o.y = pk2(a.z, a.w); o.z = pk2(b.x, b.y); o.w = pk2(b.z, b.w);
        *(GAS v4u*)(dst + (size_t)i * 8) = o;
    }
}
__device__ __forceinline__ void mods_phase(Frame& F) {
    LAS float* sv = (LAS float*)F.lds;
    LAS f32x4* red = (LAS f32x4*)(F.lds + 24576);
    const float* c_lat = in_ptr(8); const float* c_ctx = in_ptr(9); const float* w_mod = in_ptr(10); const float* b_mod = in_ptr(11);
    float* mods = (float*)(F.ws + WS_MODS);
    for (int i = F.tid; i < 3 * 2048; i += NTHR) { const int g = i >> 11, k = i & 2047; const float c = (g == 0) ? c_ctx[k] : c_lat[(g - 1) * 2048 + k]; sv[i] = c / (1.f + __expf(-c)); }
    __syncthreads();
    for (int cb = F.bid; cb < 256; cb += F.G) {
        const int l = cb >> 7, col0 = (cb & 127) * 144;
        if (F.tid < 504) {
            const int c4 = F.tid % 36, kg = F.tid / 36;
            const GAS f32x4* wp = (const GAS f32x4*)(w_mod + (size_t)l * 2048 * 18432 + col0 + 4 * c4);
            f32x4 a0 = {0.f, 0.f, 0.f, 0.f}, a1 = a0, a2 = a0;
#pragma unroll 4
            for (int k = kg; k < 2048; k += 14) { const f32x4 w = wp[(size_t)k * 4608]; a0 += sv[k] * w; a1 += sv[2048 + k] * w; a2 += sv[4096 + k] * w; }
            red[(kg * 3 + 0) * 36 + c4] = a0; red[(kg * 3 + 1) * 36 + c4] = a1; red[(kg * 3 + 2) * 36 + c4] = a2;
        }
        __syncthreads();
        if (F.tid < 108) {
            const int g = F.tid / 36, c4 = F.tid % 36; f32x4 s = *(const GAS f32x4*)(b_mod + (size_t)l * 18432 + col0 + 4 * c4);
            for (int kg = 0; kg < 14; ++kg) s += red[(kg * 3 + g) * 36 + c4];
            *(GAS f32x4*)(mods + (size_t)(l * 3 + g) * 18432 + col0 + 4 * c4) = s;
        }
        __syncthreads();
    }
}
__device__ __forceinline__ void prologue(Frame& F) {
    unsigned char* ws = F.ws;
    for (int l = 0; l < 2; ++l) {
        unsigned char* wl = ws + WS_W + (size_t)l * W_LAYER;
        transpose_matrix(F, in_ptr(13) + (size_t)l * DM * NGU, DM, NGU, (bf16*)(wl + W_GU1), MAP_GU);
        transpose_matrix(F, in_ptr(14) + (size_t)l * FF * DM, FF, DM, (bf16*)(wl + W_D1), 0);
        transpose_matrix(F, in_ptr(15) + (size_t)l * DM * DIN, DM, DIN, (bf16*)(wl + W_IN), MAP_IN);
        for (int i = 0; i < 3; ++i) transpose_matrix(F, in_ptr(20) + (size_t)(l * 3 + i) * 1024 * DM, 1024, DM, (bf16*)(wl + W_B) + (size_t)i * DM * 1024, 0);
        transpose_matrix(F, in_ptr(21) + (size_t)l * DM * DM, DM, DM, (bf16*)(wl + W_O), 0);
        transpose_matrix(F, in_ptr(22) + (size_t)l * DM * NGU, DM, NGU, (bf16*)(wl + W_GU2), MAP_GU);
        transpose_matrix(F, in_ptr(23) + (size_t)l * FF * DM, FF, DM, (bf16*)(wl + W_D2), 0);
    }
    cvt_array(F, in_ptr(2), (bf16*)(ws + WS_CACHE), 524288 / 8);
    cvt_array(F, in_ptr(3), (bf16*)(ws + WS_CACHE + 1 * MiB), 524288 / 8);
    cvt_array(F, in_ptr(6), (bf16*)(ws + WS_CACHE + 2 * MiB), 524288 / 8);
    cvt_array(F, in_ptr(7), (bf16*)(ws + WS_CACHE + 3 * MiB), 524288 / 8);
    cvt_array(F, in_ptr(4), (bf16*)(ws + WS_CACHE + 4 * MiB), 2097152 / 8);
    cvt_array(F, in_ptr(5), (bf16*)(ws + WS_CACHE + 8 * MiB), 2097152 / 8);
    { float* ct = (float*)(ws + WS_ROPE); float* st = ct + 2048;
      for (int i = F.bid * NTHR + F.tid; i < 2048; i += F.G * NTHR) { const int pos = i >> 5, f = i & 31;
          const float inv = exp2f(-(float)f * (13.287712379549449f / 32.0f)); const float ang = (float)pos * inv;
          const float kf = rintf(ang * 0.6366197723675814f); float r = fmaf(-kf, 1.5707962512969971f, ang); r = fmaf(-kf, 7.5497894158615964e-08f, r); r = fmaf(-kf, 5.3903029534742384e-15f, r);
          const float r2 = r * r;
          const float sn = r + r * r2 * (-1.6666667e-1f + r2 * (8.3333338e-3f + r2 * (-1.9841270e-4f + r2 * 2.7557319e-6f)));
          const float cs = 1.0f + r2 * (-0.5f + r2 * (4.1666668e-2f + r2 * (-1.3888889e-3f + r2 * (2.4801587e-5f + r2 * -2.7557319e-7f))));
          const int q = ((int)kf) & 3; const float sv_ = (q == 0) ? sn : (q == 1) ? cs : (q == 2) ? -sn : -cs, cv_ = (q == 0) ? cs : (q == 1) ? -sn : (q == 2) ? -cs : sn;
          ct[i] = cv_; st[i] = sv_; } }
    __syncthreads();
    mods_phase(F);
}

__device__ __forceinline__ void adaln_phase(Frame& F, int l, int which, bool from_inputs) {
    const float* X = F.out; bf16* H = (bf16*)(F.ws + WS_H); const float* mods = (const float*)(F.ws + WS_MODS);
    const float* gn = in_ptr(12) + (size_t)(l * 3 + which) * DM; const float* xin0 = in_ptr(0); const float* xin1 = in_ptr(1);
    const int gw = F.bid * NWAVES + F.wave, NGW = F.G * NWAVES, lane = F.lane;
#define ADALN_SRC(row) (from_inputs ? ((row) < R_CTX ? xin0 + (size_t)(row) * DM : xin1 + (size_t)((row) - R_CTX) * DM) : X + (size_t)(row) * DM)
    f32x4 v[8], vn[8];
    if (gw < RT) { const float* src = ADALN_SRC(gw);
#pragma unroll
        for (int j = 0; j < 8; ++j) v[j] = ((const GAS f32x4*)src)[64 * j + lane]; }
    for (int row = gw; row < RT; row += NGW) {
        const int g = row < R_CTX ? 0 : 1 + ((row - R_CTX) >> 12);
        const int nrow = row + NGW;
        if (nrow < RT) { const float* src = ADALN_SRC(nrow);
#pragma unroll
            for (int j = 0; j < 8; ++j) vn[j] = ((const GAS f32x4*)src)[64 * j + lane]; }
        float ss = 0.f;
#pragma unroll
        for (int j = 0; j < 8; ++j) ss += (v[j].x * v[j].x + v[j].y * v[j].y) + (v[j].z * v[j].z + v[j].w * v[j].w);
        const float rstd = 1.0f / sqrtf(wave_sum(ss, lane) * (1.0f / DM) + EPS_N);
        const GAS f32x4* gnp = (const GAS f32x4*)gn; const float* mg = mods + (size_t)(l * 3 + g) * 18432 + (size_t)which * 3 * DM;
        const GAS f32x4* shp = (const GAS f32x4*)mg; const GAS f32x4* scp = (const GAS f32x4*)(mg + DM);
        GAS unsigned long long* o8 = (GAS unsigned long long*)(H + (size_t)row * DM);
#pragma unroll
        for (int j = 0; j < 8; ++j) {
            const f32x4 a = gnp[64 * j + lane] * (1.0f + scp[64 * j + lane]) * rstd, b = shp[64 * j + lane]; const f32x4 h = v[j] * a + b;
            o8[64 * j + lane] = (unsigned long long)pk2(h.x, h.y) | ((unsigned long long)pk2(h.z, h.w) << 32);
        }
#pragma unroll
        for (int j = 0; j < 8; ++j) v[j] = vn[j];
    }
#undef ADALN_SRC
}
__device__ __forceinline__ void final_phase(Frame& F) {
    float* X = F.out; const GAS f32x4* gf = (const GAS f32x4*)in_ptr(24);
    const int gw = F.bid * NWAVES + F.wave, NGW = F.G * NWAVES, lane = F.lane;
    for (int row = gw; row < RT; row += NGW) {
        GAS f32x4* xr = (GAS f32x4*)(X + (size_t)row * DM);
        f32x4 v[8];
#pragma unroll
        for (int j = 0; j < 8; ++j) v[j] = xr[64 * j + lane];
        float ss = 0.f;
#pragma unroll
        for (int j = 0; j < 8; ++j) ss += (v[j].x * v[j].x + v[j].y * v[j].y) + (v[j].z * v[j].z + v[j].w * v[j].w);
        const float rstd = 1.0f / sqrtf(wave_sum(ss, lane) * (1.0f / DM) + EPS_N);
#pragma unroll
        for (int j = 0; j < 8; ++j) xr[64 * j + lane] = v[j] * rstd * gf[64 * j + lane];
    }
}
__device__ __forceinline__ bool make_unit(Frame& F, int l, int id, att::Unit& U) {
    if (id >= 1152) return false;
    unsigned char* qb = F.ws + WS_QKVG;
    const bf16* QA = (const bf16*)qb; const bf16* QB = (const bf16*)(qb + 24 * MiB); const bf16* QC = (const bf16*)(qb + 48 * MiB); const bf16* KB = (const bf16*)(qb + 72 * MiB); const bf16* VB = (const bf16*)(qb + 96 * MiB);
    const bf16* KA = (const bf16*)(qb + 120 * MiB); const bf16* VA = (const bf16*)(qb + 126 * MiB); const bf16* KC = (const bf16*)(qb + 132 * MiB); const bf16* VC = (const bf16*)(qb + 138 * MiB);
    const bf16* CKA = (const bf16*)(F.ws + WS_CACHE); const bf16* CVA = (const bf16*)(F.ws + WS_CACHE + 1 * MiB); const bf16* CKC = (const bf16*)(F.ws + WS_CACHE + 2 * MiB); const bf16* CVC = (const bf16*)(F.ws + WS_CACHE + 3 * MiB);
    const bf16* CKB = (const bf16*)(F.ws + WS_CACHE + 4 * MiB); const bf16* CVB = (const bf16*)(F.ws + WS_CACHE + 8 * MiB);
    bf16* O = (bf16*)(F.ws + WS_ACT);
    const float LOG2E = 1.4426950408889634f;
    U.mode = 0; U.a = 0; U.b = 0; U.sink2 = -__builtin_inff(); U.tab = in_ptr(18); U.n0 = 0;
    if (id < 768) {
        const int type = id >> 8, v = id & 255, xcd = v & 7, j = v >> 3; int b, h, q;
        if (type != 1) { const int combo = xcd >> 1, idx = (xcd & 1) * 32 + j; b = combo >> 1; h = (combo & 1) * 4 + (idx >> 4); q = idx & 15; }
        else { const int combo = xcd * 2 + (j >> 4); b = combo >> 3; h = combo & 7; q = j & 15; }
        const size_t lat0 = R_CTX + (size_t)b * 4096, row0 = lat0 + (size_t)q * 256, cb = (size_t)(b * 2 + l) * 512;
        U.n0 = 8;
        if (type == 0) { const int kvh = h >> 2; U.ldk = 256;
            U.Q = QA + row0 * 1024 + h * 128; U.O = O + row0 * 1024 + h * 128;
            U.K0 = CKA + cb * 256 + kvh * 128; U.V0 = CVA + cb * 256 + kvh * 128; U.K1 = KA + lat0 * 256 + kvh * 128; U.V1 = VA + lat0 * 256 + kvh * 128; U.n1 = 64; }
        else if (type == 1) { U.ldk = 1024; const int R0 = q * 4, kr0 = min(max(R0 - 4, 0), 52);
            U.Q = QB + row0 * 1024 + h * 128; U.O = O + (size_t)RT * 1024 + row0 * 1024 + h * 128;
            U.K0 = CKB + cb * 1024 + h * 128; U.V0 = CVB + cb * 1024 + h * 128; U.K1 = KB + (lat0 + (size_t)kr0 * 64) * 1024 + h * 128; U.V1 = VB + (lat0 + (size_t)kr0 * 64) * 1024 + h * 128; U.n1 = 12;
            U.mode = 1; U.a = R0; U.b = kr0; U.tab = in_ptr(18) + (size_t)(l * 8 + h) * 465; }
        else { const int kvh = h >> 2; U.ldk = 256; const int kp0 = max(q * 256 - 128, 0), kp1 = min(q * 256 + 384, 4096);
            U.Q = QC + row0 * 1024 + h * 128; U.O = O + (size_t)2 * RT * 1024 + row0 * 1024 + h * 128;
            U.K0 = CKC + cb * 256 + kvh * 128; U.V0 = CVC + cb * 256 + kvh * 128; U.K1 = KC + (lat0 + kp0) * 256 + kvh * 128; U.V1 = VC + (lat0 + kp0) * 256 + kvh * 128; U.n1 = (kp1 - kp0) >> 6;
            U.mode = 2; U.a = q * 256; U.b = kp0; U.sink2 = in_ptr(19)[l * 8 + h] * LOG2E; }
    } else {
        const int v = id - 768, b = v / 24, rem = v - 24 * b, br = rem >> 3, h = rem & 7; const size_t row0 = (size_t)b * 256;
        const int kvh = br == 1 ? h : (h >> 2); U.ldk = br == 1 ? 1024 : 256;
        const bf16* Qx = br == 0 ? QA : br == 1 ? QB : QC; const bf16* Kx = br == 0 ? KA : br == 1 ? KB : KC; const bf16* Vx = br == 0 ? VA : br == 1 ? VB : VC;
        U.Q = Qx + row0 * 1024 + h * 128; U.O = O + (size_t)br * RT * 1024 + row0 * 1024 + h * 128;
        U.K1 = Kx + row0 * U.ldk + kvh * 128; U.V1 = Vx + row0 * U.ldk + kvh * 128; U.K0 = U.K1; U.V0 = U.V1; U.n1 = 4;
        if (br == 2) U.sink2 = in_ptr(19)[l * 8 + h] * LOG2E;
    }
    return true;
}
__device__ __forceinline__ void attn_phase(Frame& F, int l, char* lds) {
    for (int id = F.bid; ; id += F.G) { att::Unit U; if (!make_unit(F, l, id, U)) break; att::attn_unit(U, lds, F.tid); }
}

namespace pg8 {
struct EpiSwiglu {
    static constexpr bool PERM = false, AFTER_DRAIN = false, CHAIN = false;
    bf16_t* ACT;
    __device__ __forceinline__ void operator()(const f32x4 (&acc)[2][2][4][2], const Unit& u, int wr, int wc, int fr, int fq) const {
        { int ln_; asm volatile("v_mbcnt_lo_u32_b32 %0, -1, 0\n\tv_mbcnt_hi_u32_b32 %0, -1, %0" : "=v"(ln_)); fr = ln_ & 15; fq = ln_ >> 4; }
        const int row0 = u.pm * BM + wr * 64 + fr, col0 = u.pn * 128 + wc * 32 + 8 * fq;
#pragma unroll
        for (int ai = 0; ai < 2; ++ai)
#pragma unroll
            for (int m = 0; m < 4; ++m) { u32x4 w;
#pragma unroll
                for (int bj = 0; bj < 2; ++bj) { const f32x4 a = acc[ai][bj][m][0], b = acc[ai][bj][m][1]; f32x4 r;
#pragma unroll
                    for (int e = 0; e < 4; ++e) r[e] = a[e] * __builtin_amdgcn_rcpf(1.0f + __expf(-a[e])) * b[e];
                    w[2 * bj] = cvt_pk_bf16(r[0], r[1]); w[2 * bj + 1] = cvt_pk_bf16(r[2], r[3]); }
                *(u32x4*)(ACT + (size_t)(row0 + ai * HALF + m * 16) * 5632 + col0) = w; }
    }
};
struct EpiResid {
    static constexpr bool PERM = false, AFTER_DRAIN = false, CHAIN = false;
    float* X; const float* base_ctx; const float* base_lat; const float* gate; float coef;
    __device__ __forceinline__ void operator()(const f32x4 (&acc)[2][2][4][2], const Unit& u, int wr, int wc, int fr, int fq) const {
        { int ln_; asm volatile("v_mbcnt_lo_u32_b32 %0, -1, 0\n\tv_mbcnt_hi_u32_b32 %0, -1, %0" : "=v"(ln_)); fr = ln_ & 15; fq = ln_ >> 4; }
        const int col0 = u.pn * BM + wc * 32 + 4 * fq;
        const int grp = u.pm < 16 ? 0 : (u.pm < 32 ? 1 : 2);
        const float* bs = u.pm < 16 ? base_ctx + (size_t)u.pm * BM * 2048 : base_lat + (size_t)(u.pm - 16) * BM * 2048;
        f32x4 gv[2][2];
#pragma unroll
        for (int bj = 0; bj < 2; ++bj)
#pragma unroll
            for (int n = 0; n < 2; ++n) gv[bj][n] = *(const f32x4*)(gate + (size_t)grp * 18432 + col0 + bj * HALF + n * 16) * coef;
#pragma unroll
        for (int ai = 0; ai < 2; ++ai) {
            f32x4 bv[4][2][2];
#pragma unroll
            for (int m = 0; m < 4; ++m) { const size_t off = (size_t)(wr * 64 + fr + ai * HALF + m * 16) * 2048 + col0;
#pragma unroll
                for (int bj = 0; bj < 2; ++bj)
#pragma unroll
                    for (int n = 0; n < 2; ++n) bv[m][bj][n] = *(const f32x4*)(bs + off + bj * HALF + n * 16); }
#pragma unroll
            for (int m = 0; m < 4; ++m) { const size_t off = (size_t)(wr * 64 + fr + ai * HALF + m * 16) * 2048 + col0;
#pragma unroll
                for (int bj = 0; bj < 2; ++bj)
#pragma unroll
                    for (int n = 0; n < 2; ++n) *(f32x4*)(X + (size_t)u.pm * BM * 2048 + off + bj * HALF + n * 16) = bv[m][bj][n] + gv[bj][n] * acc[ai][bj][m][n]; } }
    }
};
struct EpiBranch {
    static constexpr bool PERM = false, AFTER_DRAIN = false, CHAIN = true;
    bf16_t* Mb; const bf16_t* GT;
    __device__ __forceinline__ void operator()(f32x4 (&acc)[2][2][4][2], const Unit& u, int wr, int wc, int fr, int fq) const {
        { int ln_; asm volatile("v_mbcnt_lo_u32_b32 %0, -1, 0\n\tv_mbcnt_hi_u32_b32 %0, -1, %0" : "=v"(ln_)); fr = ln_ & 15; fq = ln_ >> 4; }
        const int br = u.pm / 48, pm = u.pm - 48 * br, pn = u.pn & 7;
        const int row0 = pm * BM + wr * 64 + fr, col0 = pn * BM + wc * 32 + 4 * fq;
        const int o2 = br < 2 ? 2048 : 0;
        const float keep = br < 2 ? 1.0f : 0.0f;
#pragma unroll
        for (int aq = 0; aq < 4; ++aq) { const int ai = aq >> 1, m0 = (aq & 1) * 2;
            unsigned long long ga[2][2][2], gb[2][2][2];
#pragma unroll
            for (int mm = 0; mm < 2; ++mm) { const size_t row = (size_t)(row0 + ai * HALF + (m0 + mm) * 16);
#pragma unroll
                for (int bj = 0; bj < 2; ++bj)
#pragma unroll
                    for (int n = 0; n < 2; ++n) { const bf16_t* gp = GT + row * 6144 + br * 2048 + col0 + bj * HALF + n * 16; ga[mm][bj][n] = *(const unsigned long long*)gp; gb[mm][bj][n] = *(const unsigned long long*)(gp + o2); } }
#pragma unroll
            for (int mm = 0; mm < 2; ++mm) { const size_t row = (size_t)(row0 + ai * HALF + (m0 + mm) * 16);
#pragma unroll
                for (int bj = 0; bj < 2; ++bj)
#pragma unroll
                    for (int n = 0; n < 2; ++n) { const unsigned a0 = (unsigned)ga[mm][bj][n], a1 = (unsigned)(ga[mm][bj][n] >> 32), b0 = (unsigned)gb[mm][bj][n], b1 = (unsigned)(gb[mm][bj][n] >> 32);
                        const f32x4 num = {__uint_as_float(a0 << 16), __uint_as_float(a0 & 0xffff0000u), __uint_as_float(a1 << 16), __uint_as_float(a1 & 0xffff0000u)};
                        const f32x4 den = {__uint_as_float(b0 << 16), __uint_as_float(b0 & 0xffff0000u), __uint_as_float(b1 << 16), __uint_as_float(b1 & 0xffff0000u)};
                        f32x4 r;
#pragma unroll
                        for (int e = 0; e < 4; ++e) { const float nu = fmaxf(num[e], 1e-20f), de = fmaxf(den[e], 1e-20f); r[e] = br < 2 ? nu * __builtin_amdgcn_rcpf(de) : nu; }
                        if (br == 2) { const f32x4 t = acc[ai][bj][m0 + mm][n] * r;
                            *(unsigned long long*)(Mb + row * 2048 + col0 + bj * HALF + n * 16) = (unsigned long long)cvt_pk_bf16(t[0], t[1]) | ((unsigned long long)cvt_pk_bf16(t[2], t[3]) << 32); }
                        acc[ai][bj][m0 + mm][n] *= r * keep;
                        asm volatile("" : "+v"(acc[ai][bj][m0 + mm][n])); } }
            __builtin_amdgcn_sched_barrier(0); }
    }
};
struct EpiInproj {
    static constexpr bool PERM = false, AFTER_DRAIN = false, CHAIN = false;
    unsigned char* qkvg; float* out; const float* gq; const float* gk; const float* ropec; int l; PG8_LAS float* P;
    __device__ __forceinline__ void operator()(const f32x4 (&acc)[2][2][4][2], const Unit& u, int wr, int wc, int fr, int fq) const {
        { int ln_; asm volatile("v_mbcnt_lo_u32_b32 %0, -1, 0\n\tv_mbcnt_hi_u32_b32 %0, -1, %0" : "=v"(ln_)); fr = ln_ & 15; fq = ln_ >> 4; }
        constexpr size_t MiB_ = 1u << 20;
        const int pn = u.pn; const bool isctx = u.pm < 16;
        bf16_t* dst; int dld; float* fo = nullptr; int fld = 0; int kind = 0, norm = 0;
        if (pn < 4)        { dst = (bf16_t*)qkvg + pn * 256; dld = 1024; kind = 1; norm = 1; }
        else if (pn == 4)  { dst = (bf16_t*)(qkvg + 120 * MiB_); dld = 256; kind = 1; norm = 2; fo = out + 25165824; fld = 256; }
        else if (pn == 5)  { dst = (bf16_t*)(qkvg + 126 * MiB_); dld = 256; fo = out + 27262976; fld = 256; }
        else if (pn < 10)  { dst = (bf16_t*)(qkvg + 24 * MiB_) + (pn - 6) * 256; dld = 1024; }
        else if (pn < 14)  { dst = (bf16_t*)(qkvg + 72 * MiB_) + (pn - 10) * 256; dld = 1024; fo = out + 29360128 + (pn - 10) * 256; fld = 1024; }
        else if (pn < 18)  { dst = (bf16_t*)(qkvg + 96 * MiB_) + (pn - 14) * 256; dld = 1024; fo = out + 37748736 + (pn - 14) * 256; fld = 1024; }
        else if (pn < 22)  { dst = (bf16_t*)(qkvg + 48 * MiB_) + (pn - 18) * 256; dld = 1024; kind = 1; }
        else if (pn == 22) { dst = (bf16_t*)(qkvg + 132 * MiB_); dld = 256; kind = 1; fo = out + 46137344; fld = 256; }
        else if (pn == 23) { dst = (bf16_t*)(qkvg + 138 * MiB_); dld = 256; fo = out + 48234496; fld = 256; }
        else               { dst = (bf16_t*)(qkvg + 144 * MiB_) + (pn - 24) * 256; dld = 6144; kind = 2; }
        if (!isctx) fo = nullptr;
        const int rl0 = wr * 64 + fr;
        const size_t grow0 = (size_t)u.pm * BM;
        const size_t frow0 = ((size_t)(u.pm * 2 + l)) * 256;
        if (kind != 1) {
            const int c0 = 32 * wc + 8 * fq;
#pragma unroll
            for (int ai = 0; ai < 2; ++ai)
#pragma unroll
                for (int m = 0; m < 4; ++m) { const int rl = rl0 + ai * HALF + m * 16;
#pragma unroll
                    for (int bj = 0; bj < 2; ++bj) { f32x4 a = acc[ai][bj][m][0], b = acc[ai][bj][m][1];
                        if (kind == 2) {
#pragma unroll
                            for (int e = 0; e < 4; ++e) { a[e] = __builtin_amdgcn_rcpf(1.0f + __expf(-a[e])); b[e] = __builtin_amdgcn_rcpf(1.0f + __expf(-b[e])); } }
                        u32x4 w; w.x = cvt_pk_bf16(a[0], a[1]); w.y = cvt_pk_bf16(a[2], a[3]); w.z = cvt_pk_bf16(b[0], b[1]); w.w = cvt_pk_bf16(b[2], b[3]);
                        *(u32x4*)(dst + (grow0 + rl) * dld + bj * HALF + c0) = w;
                        if (fo) { float* fp = fo + (frow0 + rl) * fld + bj * HALF + c0; *(f32x4*)fp = a; *(f32x4*)(fp + 4) = b; } } }
            return;
        }
        const int db = 64 * (wc >> 1) + 16 * (wc & 1) + 4 * fq;
        if (norm) {
#pragma unroll
            for (int ai = 0; ai < 2; ++ai)
#pragma unroll
                for (int m = 0; m < 4; ++m)
#pragma unroll
                    for (int bj = 0; bj < 2; ++bj) { const f32x4 a = acc[ai][bj][m][0], b = acc[ai][bj][m][1];
                        float ss = (a[0] * a[0] + a[1] * a[1]) + (a[2] * a[2] + a[3] * a[3]) + (b[0] * b[0] + b[1] * b[1]) + (b[2] * b[2] + b[3] * b[3]);
                        ss += shx(ss, 16, 16 * fq + fr); ss += shx(ss, 32, 16 * fq + fr);
                        if (fq == 0) P[((rl0 + ai * HALF + m * 16) * 2 + bj) * 4 + wc] = ss; }
            asm volatile("s_waitcnt lgkmcnt(0)" ::: "memory"); __builtin_amdgcn_s_barrier(); asm volatile("" ::: "memory");
        }
        f32x4 g0 = {1.f, 1.f, 1.f, 1.f}, g1 = g0;
        if (norm) { const float* gg = norm == 1 ? gq : gk; g0 = *(const f32x4*)(gg + db); g1 = *(const f32x4*)(gg + db + 32); }
        const int fi = 16 * (wc & 1) + 4 * fq;
#pragma unroll
        for (int ai = 0; ai < 2; ++ai) { f32x4 csv[4], snv[4];
#pragma unroll
            for (int m = 0; m < 4; ++m) { csv[m] = (f32x4){1.f, 1.f, 1.f, 1.f}; snv[m] = (f32x4){0.f, 0.f, 0.f, 0.f};
                if (!isctx) { const int nl = (int)((grow0 + rl0 + ai * HALF + m * 16 - 4096) & 4095); const int pos = (wc >> 1) ? (nl & 63) : (nl >> 6);
                    csv[m] = *(const f32x4*)(ropec + pos * 32 + fi); snv[m] = *(const f32x4*)(ropec + 2048 + pos * 32 + fi); } }
#pragma unroll
            for (int m = 0; m < 4; ++m) { const int rl = rl0 + ai * HALF + m * 16;
                const f32x4 cs = csv[m], sn = snv[m];
#pragma unroll
                for (int bj = 0; bj < 2; ++bj) { f32x4 a = acc[ai][bj][m][0], b = acc[ai][bj][m][1];
                    if (norm) { const f32x4 pp = *(const PG8_LAS f32x4*)(P + (rl * 2 + bj) * 4); const float rstd = 1.0f / sqrtf(((pp[0] + pp[1]) + (pp[2] + pp[3])) * (1.0f / 128.0f) + 1e-6f);
                        a = a * rstd * g0; b = b * rstd * g1; }
                    const f32x4 y1 = a * cs - b * sn, y2 = b * cs + a * sn;
                    bf16_t* dp = dst + (grow0 + rl) * dld + bj * HALF + db;
                    *(unsigned long long*)dp = (unsigned long long)cvt_pk_bf16(y1[0], y1[1]) | ((unsigned long long)cvt_pk_bf16(y1[2], y1[3]) << 32);
                    *(unsigned long long*)(dp + 32) = (unsigned long long)cvt_pk_bf16(y2[0], y2[1]) | ((unsigned long long)cvt_pk_bf16(y2[2], y2[3]) << 32);
                    if (fo) { float* fp = fo + (frow0 + rl) * fld + bj * HALF + db; *(f32x4*)fp = y1; *(f32x4*)(fp + 32) = y2; } } } }
    }
};
struct EpiF32 {
    static constexpr bool PERM = false, AFTER_DRAIN = false, CHAIN = false;
    float* C; int ldc;
    __device__ __forceinline__ void operator()(const f32x4 (&acc)[2][2][4][2], const Unit& u, int wr, int wc, int fr, int fq) const {
        { int ln_; asm volatile("v_mbcnt_lo_u32_b32 %0, -1, 0\n\tv_mbcnt_hi_u32_b32 %0, -1, %0" : "=v"(ln_)); fr = ln_ & 15; fq = ln_ >> 4; }
        const int row0 = u.pm * BM + wr * 64 + fr, col0 = u.pn * BM + wc * 32 + 4 * fq;
#pragma unroll
        for (int ai = 0; ai < 2; ++ai)
#pragma unroll
            for (int m = 0; m < 4; ++m) { float* rowp = C + (size_t)(row0 + ai * HALF + m * 16) * ldc + col0;
#pragma unroll
                for (int bj = 0; bj < 2; ++bj)
#pragma unroll
                    for (int n = 0; n < 2; ++n) *(f32x4*)(rowp + bj * HALF + n * 16) = acc[ai][bj][m][n]; }
    }
};
struct BranchOrder {
    int G, c;
    __device__ __forceinline__ bool next(int i, Unit& u) const { const int j = i / 3, br = i - 3 * j; const int tile = j * G + c; if (tile >= 384) return false;
        u.pm = br * 48 + (tile >> 3); u.pn = br * 8 + (tile & 7); return true; }
    __device__ __forceinline__ void a_ready(const Unit&) const {}
    __device__ __forceinline__ void done(const Unit&) const {}
};
struct EpiBranchF32 {
    static constexpr bool PERM = false, AFTER_DRAIN = false, CHAIN = false;
    float* Y3;
    __device__ __forceinline__ void operator()(const f32x4 (&acc)[2][2][4][2], const Unit& u, int wr, int wc, int fr, int fq) const {
        { int ln_; asm volatile("v_mbcnt_lo_u32_b32 %0, -1, 0\n\tv_mbcnt_hi_u32_b32 %0, -1, %0" : "=v"(ln_)); fr = ln_ & 15; fq = ln_ >> 4; }
        const int br = u.pm / 48, pm = u.pm - 48 * br, pn = u.pn & 7;
        const int row0 = pm * BM + wr * 64 + fr, col0 = pn * BM + wc * 32 + 4 * fq; float* base = Y3 + (size_t)br * 12288 * 2048;
#pragma unroll
        for (int ai = 0; ai < 2; ++ai)
#pragma unroll
            for (int m = 0; m < 4; ++m) { float* rowp = base + (size_t)(row0 + ai * HALF + m * 16) * 2048 + col0;
#pragma unroll
                for (int bj = 0; bj < 2; ++bj)
#pragma unroll
                    for (int n = 0; n < 2; ++n) *(f32x4*)(rowp + bj * HALF + n * 16) = acc[ai][bj][m][n]; }
    }
};
}

__global__ void __launch_bounds__(NTHR, 2) mega_fwd(Args args) {
    extern __shared__ __attribute__((aligned(16))) unsigned char lds[];
    Frame F;
    F.lds = (LAS unsigned char*)lds; F.tid = threadIdx.x; F.lane = F.tid & 63; F.wave = __builtin_amdgcn_readfirstlane(F.tid >> 6); F.G = gridDim.x; F.bid = blockIdx.x;
    F.out = (float*)in_ptr(25); F.ws = (unsigned char*)in_ptr(26);
    for (int u = F.tid; u < (LDS_BYTES - LDSCTL_OFF) / 4; u += NTHR) ((LAS unsigned*)(F.lds + LDSCTL_OFF))[u] = 0u;
    __syncthreads();
    volatile LAS unsigned* MISC = (volatile LAS unsigned*)(F.lds + MISC_OFF);
    XcdBarrier bar = xcd_barrier_post((unsigned*)(F.ws + WS_CTL) + CW_BAR, MISC + 8, F.tid);
#define RELAUNDER() do { asm volatile("v_mbcnt_lo_u32_b32 %0, -1, 0\n\tv_mbcnt_hi_u32_b32 %0, -1, %0" : "=v"(F.lane)); \
    asm volatile("" : "+s"(F.wave), "+s"(F.bid), "+s"(F.G), "+s"(F.ws), "+s"(F.out), "+s"(bar.bar), "+s"(bar.x)); F.tid = F.wave * 64 + F.lane; } while (0)
#define GRID_BAR() do { RELAUNDER(); xcd_barrier(bar, F.tid); RELAUNDER(); } while (0)

    prologue(F); GRID_BAR();

    for (int l = 0; l < 2; ++l) {
        unsigned char* wl = F.ws + WS_W + (size_t)l * W_LAYER;
        const float* modl = (const float*)(F.ws + WS_MODS) + (size_t)l * 3 * 18432;
        adaln_phase(F, l, 0, l == 0); GRID_BAR();
        { pg8::Gemm g{(const bf16*)(F.ws + WS_H), (const bf16*)(wl + W_GU1), RT, NGU, DM}; pg8::StaticOrder S; S.init(RT, NGU, F.G, F.bid);
          pg8::EpiSwiglu E{(bf16*)(F.ws + WS_ACT)};
          pg8::gemm_phase<pg8::EpiSwiglu, pg8::StaticOrder, true, true>(F.lds, g, S, E, F.tid); }
        GRID_BAR();
        { pg8::Gemm g{(const bf16*)(F.ws + WS_ACT), (const bf16*)(wl + W_D1), RT, DM, FF}; pg8::StaticOrder S; S.init(RT, DM, F.G, F.bid);
          pg8::EpiResid E{F.out, l == 0 ? in_ptr(0) : F.out, l == 0 ? in_ptr(1) : F.out + (size_t)R_CTX * DM, modl + 2 * DM, 0.5f};
          pg8::gemm_phase<pg8::EpiResid, pg8::StaticOrder, true, true>(F.lds, g, S, E, F.tid); }
        GRID_BAR();
        adaln_phase(F, l, 1, false); GRID_BAR();
        { pg8::Gemm g{(const bf16*)(F.ws + WS_H), (const bf16*)(wl + W_IN), RT, DIN, DM}; pg8::StaticOrder S; S.init(RT, DIN, F.G, F.bid);
          pg8::EpiInproj E{F.ws + WS_QKVG, F.out, in_ptr(16) + l * HD, in_ptr(17) + l * HD, (const float*)(F.ws + WS_ROPE), l, (LAS float*)(F.lds + EXCH_OFF)};
          pg8::gemm_phase<pg8::EpiInproj, pg8::StaticOrder, true, true>(F.lds, g, S, E, F.tid); }
        GRID_BAR();
        attn_phase(F, l, (char*)lds); GRID_BAR();
        { pg8::Gemm g{(const bf16*)(F.ws + WS_ACT)  , (const bf16*)(wl + W_B), 3 * RT, 3 * DM, 1024}; pg8::BranchOrder S{F.G, F.bid};
          pg8::EpiBranch E{(bf16*)(F.ws + WS_H), (const bf16*)(F.ws + WS_QKVG + 144 * MiB)};
          pg8::gemm_phase<pg8::EpiBranch, pg8::BranchOrder, true, true>(F.lds, g, S, E, F.tid); }
        GRID_BAR();
        { pg8::Gemm g{(const bf16*)(F.ws + WS_H)  , (const bf16*)(wl + W_O), RT, DM, DM}; pg8::StaticOrder S; S.init(RT, DM, F.G, F.bid);
          pg8::EpiResid E{F.out, F.out, F.out + (size_t)R_CTX * DM, modl + 5 * DM, 1.0f};
          pg8::gemm_phase<pg8::EpiResid, pg8::StaticOrder, true, true>(F.lds, g, S, E, F.tid); }
        GRID_BAR();
        adaln_phase(F, l, 2, false); GRID_BAR();
        { pg8::Gemm g{(const bf16*)(F.ws + WS_H), (const bf16*)(wl + W_GU2), RT, NGU, DM}; pg8::StaticOrder S; S.init(RT, NGU, F.G, F.bid);
          pg8::EpiSwiglu E{(bf16*)(F.ws + WS_ACT)};
          pg8::gemm_phase<pg8::EpiSwiglu, pg8::StaticOrder, true, true>(F.lds, g, S, E, F.tid); }
        GRID_BAR();
        { pg8::Gemm g{(const bf16*)(F.ws + WS_ACT), (const bf16*)(wl + W_D2), RT, DM, FF}; pg8::StaticOrder S; S.init(RT, DM, F.G, F.bid);
          pg8::EpiResid E{F.out, F.out, F.out + (size_t)R_CTX * DM, modl + 8 * DM, 0.5f};
          pg8::gemm_phase<pg8::EpiResid, pg8::StaticOrder, true, true>(F.lds, g, S, E, F.tid); }
        GRID_BAR();
    }
    final_phase(F);
#undef GRID_BAR
}

extern "C" void kernel_launch(void* const* d_in, const int* in_sizes, int n_in, void* d_out, int out_size, void* d_ws, size_t ws_size, hipStream_t stream) {
    static int grid = 0;
    if (grid == 0) {
        if (n_in != 25 || out_size != (int)OUT_TOTAL || ws_size < WS_END) { fprintf(stderr, "kernel_launch: unexpected shapes: n_in %d out %d ws %zu (need %zu)\n", n_in, out_size, ws_size, (size_t)WS_END); grid = -1; return; }
        int dev = 0, cus = 0, per_cu = 0;
        if (hipGetDevice(&dev) != hipSuccess || hipDeviceGetAttribute(&cus, hipDeviceAttributeMultiprocessorCount, dev) != hipSuccess) { grid = -1; return; }
        if (hipFuncSetAttribute((const void*)mega_fwd, hipFuncAttributeMaxDynamicSharedMemorySize, LDS_BYTES) != hipSuccess) { fprintf(stderr, "kernel_launch: hipFuncSetAttribute failed\n"); grid = -1; return; }
        if (hipOccupancyMaxActiveBlocksPerMultiprocessor(&per_cu, (const void*)mega_fwd, NTHR, LDS_BYTES) != hipSuccess || per_cu < 1) { fprintf(stderr, "kernel_launch: occupancy query says %d\n", per_cu); (void)hipGetLastError(); grid = -1; return; }
        grid = cus;
    }
    if (grid < 0) return;
    if (hipMemsetAsync((char*)d_ws + WS_CTL, 0, CTL_ZERO_BYTES, stream) != hipSuccess) return;
    Args a{};
    for (int i = 0; i < 25; ++i) a.in[i] = (const float*)d_in[i];
    a.out = (float*)d_out; a.ws = (unsigned char*)d_ws;
    hipLaunchKernelGGL(mega_fwd, dim3(grid), dim3(NTHR), LDS_BYTES, stream, a);
}
```

```cpp
#include <hip/hip_runtime.h>
#include <cstdio>
#include <cstdint>
namespace pg8 {
#define PG8_LAS __attribute__((address_space(3)))
typedef unsigned short bf16_t;
typedef short bf16x8 __attribute__((ext_vector_type(8)));
typedef float f32x4 __attribute__((ext_vector_type(4)));
typedef unsigned u32x4 __attribute__((ext_vector_type(4)));
constexpr int BM = 256, BK = 64, HALF = 128, HTB = HALF * BK * 2  , STAGE_BYTES = 8 * HTB, NXCD = 8, WGM = 8;

__host__ __device__ __forceinline__ int lds_byte(int r, int c) { const int st = (r >> 4) * 2 + (c >> 5), rr = r & 15, cc = c & 31, ob = rr * 64 + cc * 2; return st * 1024 + (ob ^ (((ob >> 9) & 1) << 5)); }
__host__ __device__ __forceinline__ void stage_rc(int b, int& R, int& C) { const int st = b / 1024, sb = b % 1024, swz = sb ^ (((sb >> 9) & 1) << 5); R = (st >> 1) * 16 + swz / 64; C = (st & 1) * 32 + (swz % 64) / 2; }
__host__ __device__ __forceinline__ int perm32(int rho) { const int n = rho >> 4, i = rho & 15; return 8 * (i >> 2) + 4 * n + (i & 3); }

struct Unit { int pm, pn; };
struct Gemm { const bf16_t* A; const bf16_t* Bt; int M, N, K; };

struct StaticOrder {
    int nM, nN, nwg, G, c;
    __host__ __device__ void init(int M, int N, int G_, int c_) { nM = M / BM; nN = N / BM; nwg = nM * nN; G = G_; c = c_; }
    __host__ __device__ bool next(int i, Unit& u) const {
        const long L = (long)i * G + c; if (L >= nwg) return false;
        int wgid = (int)L; { const int q = nwg / NXCD, r = nwg % NXCD, xcd = wgid % NXCD, off = wgid / NXCD; wgid = (xcd < r ? xcd * (q + 1) : r * (q + 1) + (xcd - r) * q) + off; }
        const int nig = WGM * nN, gid = wgid / nig, fm = gid * WGM, gsz = (nM - fm) < WGM ? (nM - fm) : WGM;
        u.pm = fm + ((wgid % nig) % gsz); u.pn = (wgid % nig) / gsz; return true;
    }
    __device__ __forceinline__ void a_ready(const Unit&) const {}
    __device__ __forceinline__ void done(const Unit&) const {}
};

__device__ __forceinline__ unsigned cvt_pk_bf16(float lo, float hi) { unsigned r; asm volatile("v_cvt_pk_bf16_f32 %0, %1, %2" : "=v"(r) : "v"(lo), "v"(hi)); return r; }
typedef float f32x2 __attribute__((ext_vector_type(2)));
__device__ __forceinline__ f32x2 gelu_pk(f32x2 v) {
    const f32x2 av = __builtin_elementwise_abs(v), d = av * 0.2316418882f + 1.0f;
    f32x2 t; t.x = __builtin_amdgcn_rcpf(d.x); t.y = __builtin_amdgcn_rcpf(d.y);
    f32x2 q = t * 0.5307027145f + (-0.7265760135f); q = q * t + 0.7107068705f; q = q * t + (-0.142248368f); q = q * t + 0.127414796f; q = q * t;
    const f32x2 s = (v * v) * (-0.72134752044f);
    f32x2 e; e.x = __builtin_amdgcn_exp2f(s.x); e.y = __builtin_amdgcn_exp2f(s.y);
    const f32x2 m = v * (q * e), r = v - m;
    f32x2 o; o.x = v.x < 0.f ? m.x : r.x; o.y = v.y < 0.f ? m.y : r.y; return o;
}

template <int ACT  > struct EpiBf16 {
    static constexpr bool PERM = true, AFTER_DRAIN = false, CHAIN = false; static_assert(ACT == 0 || ACT == 1, "EpiBf16: ACT is 0 (none) or 1 (gelu_pk)");
    bf16_t* O; int ldc; const float* bias; int split_cols; size_t split_stride; float scale0;
    __device__ __forceinline__ void operator()(const f32x4 (&acc)[2][2][4][2], const Unit& u, int wr, int wc, int fr, int fq) const {
        const int row0 = u.pm * BM + wr * 64 + fr; int colt = u.pn * BM; bf16_t* base = O;
        float sc = 1.f; if (split_cols) { const int t = colt / split_cols; base += (size_t)t * split_stride; colt -= t * split_cols; if (t == 0) sc = scale0; }
        const int col0 = colt + wc * 32 + 8 * fq, bcol0 = u.pn * BM + wc * 32 + 8 * fq;
        f32x4 bv[2][2];
#pragma unroll
        for (int bj = 0; bj < 2; ++bj)
#pragma unroll
            for (int n = 0; n < 2; ++n) bv[bj][n] = bias ? *(const f32x4*)(bias + bcol0 + bj * HALF + 4 * n) : (f32x4){0.f, 0.f, 0.f, 0.f};
#pragma unroll
        for (int ai = 0; ai < 2; ++ai)
#pragma unroll
            for (int m = 0; m < 4; ++m) { bf16_t* rowp = base + (size_t)(row0 + ai * HALF + m * 16) * ldc + col0;
#pragma unroll
                for (int bj = 0; bj < 2; ++bj) { f32x4 v0 = acc[ai][bj][m][0] + bv[bj][0], v1 = acc[ai][bj][m][1] + bv[bj][1];
                    if (ACT == 1) { f32x2 a = gelu_pk((f32x2){v0[0], v0[1]}), b = gelu_pk((f32x2){v0[2], v0[3]}), c = gelu_pk((f32x2){v1[0], v1[1]}), d = gelu_pk((f32x2){v1[2], v1[3]});
                        v0 = (f32x4){a.x, a.y, b.x, b.y}; v1 = (f32x4){c.x, c.y, d.x, d.y}; }
                    v0 = v0 * sc; v1 = v1 * sc; u32x4 w; w.x = cvt_pk_bf16(v0[0], v0[1]); w.y = cvt_pk_bf16(v0[2], v0[3]); w.z = cvt_pk_bf16(v1[0], v1[1]); w.w = cvt_pk_bf16(v1[2], v1[3]);
                    *(u32x4*)(rowp + bj * HALF) = w; } }
    }
};

template <class Epi, class Sched, bool ALIGN_EPI = false, bool SP2 = false>
__device__ __forceinline__ void gemm_phase(PG8_LAS unsigned char* lds, const Gemm g, const Sched& S, const Epi& E, const int tid_in) {
    int tid_l = tid_in; asm volatile("" : "+v"(tid_l));
    const int tid = tid_l, wid = __builtin_amdgcn_readfirstlane(tid >> 6), lane = tid & 63, wr = wid >> 2, wc = wid & 3, fr = lane & 15, fq = lane >> 4;
    const int K = g.K, nt = K / BK;
    unsigned voffA[2], voffB[2];
#pragma unroll
    for (int i = 0; i < 2; ++i) { int R, C; stage_rc(tid * 16 + i * 8192, R, C); const int Rb = Epi::PERM ? ((R & ~31) + perm32(R & 31)) : R;
        voffA[i] = (unsigned)(R * K + C) * 2u; voffB[i] = (unsigned)(Rb * K + C) * 2u; }
    const size_t kstep = (size_t)(BK * 2);
    const size_t hstep = (size_t)HALF * K * 2;
    const size_t tstep = 2 * hstep;
    const unsigned ldsw = (unsigned)wid * 1024u;
    const int aoff = lds_byte(wr * 64 + fr, fq * 8), boff = lds_byte(wc * 32 + fr, fq * 8);
#define PG8_SA(b, h) (((b) * 2 + (h)) * HTB)
#define PG8_SB(b, h) ((4 + (b) * 2 + (h)) * HTB)
#define PG8_STAGE(bufoff, gbase, voff) do { _Pragma("unroll") for (int _i = 0; _i < 2; ++_i) \
        __builtin_amdgcn_global_load_lds((const unsigned*)((const char*)(gbase) + (voff)[_i]), (PG8_LAS unsigned*)(lds + (bufoff) + ldsw + _i * 8192), 16, 0, 0); } while (0)
#define PG8_LDA(dst, b, h) do { _Pragma("unroll") for (int m = 0; m < 4; ++m) _Pragma("unroll") for (int k = 0; k < 2; ++k) dst[m][k] = *(const PG8_LAS bf16x8*)(lds + PG8_SA(b, h) + aoff + m * 2048 + k * 1024); } while (0)
#define PG8_LDB(dst, b, h) do { _Pragma("unroll") for (int n = 0; n < 2; ++n) _Pragma("unroll") for (int k = 0; k < 2; ++k) dst[n][k] = *(const PG8_LAS bf16x8*)(lds + PG8_SB(b, h) + boff + n * 2048 + k * 1024); } while (0)
#define PG8_MMA(ai, bj, At, Bt) do { __builtin_amdgcn_s_setprio(1); _Pragma("unroll") for (int m = 0; m < 4; ++m) _Pragma("unroll") for (int n = 0; n < 2; ++n) _Pragma("unroll") for (int k = 0; k < 2; ++k) \
        acc[ai][bj][m][n] = __builtin_amdgcn_mfma_f32_16x16x32_bf16(Bt[n][k], At[m][k], acc[ai][bj][m][n], 0, 0, 0); __builtin_amdgcn_s_setprio(0); } while (0)
#define PG8_WAIT_V(n) asm volatile("s_waitcnt vmcnt(" #n ")" ::: "memory")
#define PG8_WAIT_L(n) asm volatile("s_waitcnt lgkmcnt(" #n ")" ::: "memory")
#define PG8_BAR __builtin_amdgcn_s_barrier()
#define PG8_SCHED __builtin_amdgcn_sched_barrier(0)
    Unit cur, nxt; int ui = 0;
    if (!S.next(0, cur)) return;
    f32x4 acc[2][2][4][2];
#pragma unroll
    for (int a = 0; a < 2; ++a)
#pragma unroll
        for (int b = 0; b < 2; ++b)
#pragma unroll
            for (int m = 0; m < 4; ++m)
#pragma unroll
                for (int n = 0; n < 2; ++n) acc[a][b][m][n] = (f32x4){0.f, 0.f, 0.f, 0.f};
    bf16x8 At[4][2], B0[2][2], B1[2][2];
    const char* cA = (const char*)g.A + (size_t)cur.pm * tstep; const char* cB = (const char*)g.Bt + (size_t)cur.pn * tstep;
    S.a_ready(cur);
    if constexpr (SP2) {
        PG8_STAGE(PG8_SB(0, 0), cB, voffB); PG8_STAGE(PG8_SB(0, 1), cB + hstep, voffB); PG8_STAGE(PG8_SA(0, 0), cA, voffA); PG8_STAGE(PG8_SA(0, 1), cA + hstep, voffA);
        if (wr == 1) PG8_BAR;
        PG8_WAIT_V(2); PG8_BAR;
        PG8_STAGE(PG8_SB(1, 0), cB + kstep, voffB); PG8_STAGE(PG8_SA(1, 0), cA + kstep, voffA); PG8_STAGE(PG8_SB(1, 1), cB + hstep + kstep, voffB);
        PG8_WAIT_V(6); PG8_BAR;
    } else {
        PG8_STAGE(PG8_SB(0, 0), cB, voffB); PG8_STAGE(PG8_SA(0, 0), cA, voffA); PG8_STAGE(PG8_SB(0, 1), cB + hstep, voffB); PG8_STAGE(PG8_SA(0, 1), cA + hstep, voffA);
        if (wr == 1) PG8_BAR;
        PG8_WAIT_V(4); PG8_BAR;
        PG8_STAGE(PG8_SB(1, 0), cB + kstep, voffB); PG8_STAGE(PG8_SA(1, 0), cA + kstep, voffA); PG8_STAGE(PG8_SB(1, 1), cB + hstep + kstep, voffB);
        PG8_WAIT_V(6); PG8_BAR;
    }
    for (;;) {
        const bool has_next = S.next(ui + 1, nxt);
        const char* nA = has_next ? (const char*)g.A + (size_t)nxt.pm * tstep : cA; const char* nB = has_next ? (const char*)g.Bt + (size_t)nxt.pn * tstep : cB;
        for (int t = 0; t < nt; t += 2) {
            const bool last = (t == nt - 2);
            const char* a1 = cA + (size_t)(t + 1) * kstep;
            const char* a2 = last ? nA : cA + (size_t)(t + 2) * kstep; const char* b2 = last ? nB : cB + (size_t)(t + 2) * kstep;
            const char* a3 = a2 + kstep; const char* b3 = b2 + kstep;
            if (last && has_next) S.a_ready(nxt);
            if constexpr (SP2) {
            PG8_LDB(B0, 0, 0); PG8_LDB(B1, 0, 1); PG8_SCHED; PG8_LDA(At, 0, 0); PG8_STAGE(PG8_SA(1, 1), a1 + hstep, voffA);
            PG8_WAIT_V(8); PG8_WAIT_L(0); PG8_BAR; PG8_MMA(0, 0, At, B0); PG8_MMA(0, 1, At, B1); PG8_BAR; PG8_SCHED;
            PG8_LDA(At, 0, 1); PG8_STAGE(PG8_SB(0, 0), b2, voffB); PG8_STAGE(PG8_SB(0, 1), b2 + hstep, voffB); PG8_STAGE(PG8_SA(0, 0), a2, voffA);
            PG8_WAIT_V(8); PG8_WAIT_L(0); PG8_BAR; PG8_MMA(1, 0, At, B0); PG8_MMA(1, 1, At, B1); PG8_BAR; PG8_SCHED;
            PG8_LDB(B0, 1, 0); PG8_LDB(B1, 1, 1); PG8_SCHED; PG8_LDA(At, 1, 0); PG8_STAGE(PG8_SA(0, 1), a2 + hstep, voffA);
            PG8_WAIT_V(8); PG8_WAIT_L(0); PG8_BAR; PG8_MMA(0, 0, At, B0); PG8_MMA(0, 1, At, B1); PG8_BAR; PG8_SCHED;
            PG8_LDA(At, 1, 1); PG8_STAGE(PG8_SB(1, 0), b3, voffB); PG8_STAGE(PG8_SB(1, 1), b3 + hstep, voffB); PG8_STAGE(PG8_SA(1, 0), a3, voffA);
            PG8_WAIT_V(8); PG8_WAIT_L(0); PG8_BAR; PG8_MMA(1, 0, At, B0); PG8_MMA(1, 1, At, B1); PG8_BAR; PG8_SCHED;
            } else {
            PG8_LDB(B0, 0, 0); PG8_SCHED; PG8_LDA(At, 0, 0); PG8_STAGE(PG8_SA(1, 1), a1 + hstep, voffA);
            PG8_WAIT_L(8); PG8_BAR; PG8_WAIT_L(0); PG8_MMA(0, 0, At, B0); PG8_BAR; PG8_SCHED;
            PG8_LDB(B1, 0, 1); PG8_STAGE(PG8_SB(0, 0), b2, voffB);
            PG8_BAR; PG8_WAIT_L(0); PG8_MMA(0, 1, At, B1); PG8_BAR;
            PG8_LDA(At, 0, 1); PG8_STAGE(PG8_SA(0, 0), a2, voffA);
            PG8_BAR; PG8_WAIT_L(0); PG8_MMA(1, 0, At, B0); PG8_BAR; PG8_SCHED;
            PG8_STAGE(PG8_SB(0, 1), b2 + hstep, voffB);
            PG8_WAIT_V(6); PG8_BAR; PG8_MMA(1, 1, At, B1); PG8_BAR;
            PG8_LDB(B0, 1, 0); PG8_SCHED; PG8_LDA(At, 1, 0); PG8_STAGE(PG8_SA(0, 1), a2 + hstep, voffA);
            PG8_WAIT_L(8); PG8_BAR; PG8_WAIT_L(0); PG8_MMA(0, 0, At, B0); PG8_BAR; PG8_SCHED;
            PG8_LDB(B1, 1, 1); PG8_STAGE(PG8_SB(1, 0), b3, voffB);
            PG8_BAR; PG8_WAIT_L(0); PG8_MMA(0, 1, At, B1); PG8_BAR;
            PG8_LDA(At, 1, 1); PG8_STAGE(PG8_SA(1, 0), a3, voffA);
            PG8_BAR; PG8_WAIT_L(0); PG8_MMA(1, 0, At, B0); PG8_BAR; PG8_SCHED;
            PG8_STAGE(PG8_SB(1, 1), b3 + hstep, voffB);
            PG8_WAIT_V(6); PG8_BAR; PG8_MMA(1, 1, At, B1); PG8_BAR;
            }
        }
        if constexpr (ALIGN_EPI) { if (wr == 0) PG8_BAR; }
        if constexpr (!Epi::AFTER_DRAIN) { E(acc, cur, wr, wc, fr, fq); S.done(cur); }
        if (!has_next) break;
        if constexpr (!Epi::CHAIN) {
#pragma unroll
        for (int a = 0; a < 2; ++a)
#pragma unroll
            for (int b = 0; b < 2; ++b)
#pragma unroll
                for (int m = 0; m < 4; ++m)
#pragma unroll
                    for (int n = 0; n < 2; ++n) acc[a][b][m][n] = (f32x4){0.f, 0.f, 0.f, 0.f};
        }
        cur = nxt; cA = nA; cB = nB; ++ui;
        if constexpr (ALIGN_EPI) { if (wr == 1) PG8_BAR; }
    }
    PG8_WAIT_V(0);
    if constexpr (!ALIGN_EPI) { if (wr == 0) PG8_BAR; }
    PG8_BAR;
    if constexpr (Epi::AFTER_DRAIN) { E.fused(acc, cur, wr, wc, fr, fq, lds, wid, lane); S.done(cur); }
#undef PG8_SA
#undef PG8_SB
#undef PG8_STAGE
#undef PG8_LDA
#undef PG8_LDB
#undef PG8_MMA
#undef PG8_WAIT_V
#undef PG8_WAIT_L
#undef PG8_BAR
#undef PG8_SCHED
}
}
#define GAS __attribute__((address_space(1)))
#define LAS __attribute__((address_space(3)))
typedef unsigned short bf16;
typedef unsigned v4u __attribute__((ext_vector_type(4)));
typedef float f32x4 __attribute__((ext_vector_type(4)));
typedef short bf16x8 __attribute__((ext_vector_type(8)));
typedef GAS unsigned gu32;
typedef GAS unsigned long long gu64;
#define RLX_AGENT __ATOMIC_RELAXED, __HIP_MEMORY_SCOPE_AGENT
#define LDS_WAIT() asm volatile("s_waitcnt lgkmcnt(0)" ::: "memory")
#define VM_WAIT() asm volatile("s_waitcnt vmcnt(0)" ::: "memory")
__device__ __forceinline__ unsigned long long rt() { return __builtin_amdgcn_s_memrealtime(); }
__device__ __forceinline__ unsigned f2bf(float f) { unsigned u = __builtin_bit_cast(unsigned, f); return (u + 0x7fffu + ((u >> 16) & 1u)) >> 16; }
__device__ __forceinline__ unsigned pk2(float lo, float hi) { return f2bf(lo) | (f2bf(hi) << 16); }

#define XB_TMO      128
#define XB_XCNT(j)  (256  + 64 * (j))
#define XB_XSUB(j)  (1280 + 64 * (j))
#define XB_XGEN(j)  (2304 + 64 * (j))
#define XB_TOP      3328
#define XB_TOPGEN   3392
#define XCD_BAR_WORDS 3456
#define XB_SPIN_CAP (1u << 18)

__device__ __forceinline__ unsigned xb_ld(unsigned* p)              { return __hip_atomic_load(p, __ATOMIC_RELAXED, __HIP_MEMORY_SCOPE_AGENT); }
__device__ __forceinline__ unsigned xb_add(unsigned* p, unsigned v) { return __hip_atomic_fetch_add(p, v, __ATOMIC_RELAXED, __HIP_MEMORY_SCOPE_AGENT); }
__device__ __forceinline__ unsigned xb_xcc_id() { return (unsigned)__builtin_amdgcn_s_getreg((3 << 11) | 20) & 0xFu; }
#define XB_SPIN(cond, bar) do { unsigned _sp = 0; while (cond) { __builtin_amdgcn_s_sleep(1); \
    if ((++_sp & 255u) == 0u) { if (xb_ld(&(bar)[XB_TMO])) break; if (_sp > XB_SPIN_CAP) { atomicAdd(&(bar)[XB_TMO], 1u); break; } } } } while (0)

struct XcdBarrier {
    unsigned* bar; unsigned x;
    volatile LAS unsigned* st;
};

__device__ __forceinline__ XcdBarrier xcd_barrier_post(unsigned* bar, volatile LAS unsigned* st, const int tid) {
    XcdBarrier b; b.bar = bar; b.x = xb_xcc_id(); b.st = st;
    if (tid == 0) (void)xb_add(&bar[XB_XCNT(b.x)], 1u);
    return b;
}
__device__ __forceinline__ void xcd_barrier_complete(unsigned* bar, unsigned x, unsigned& nloc, unsigned& nx) {
    const unsigned G = gridDim.x * gridDim.y * gridDim.z;
    unsigned sum, cnt, mine, sp = 0u;
    for (;;) {
        sum = 0u; cnt = 0u; mine = 0u;
#pragma unroll
        for (unsigned j = 0; j < 16; ++j) { const unsigned c = xb_ld(&bar[XB_XCNT(j)]); sum += c; cnt += (c > 0u) ? 1u : 0u; mine = (j == x) ? c : mine; }
        if (sum == G) break;
        __builtin_amdgcn_s_sleep(1);
        if ((++sp & 255u) == 0u) { if (xb_ld(&bar[XB_TMO])) break; if (sp > XB_SPIN_CAP) { atomicAdd(&bar[XB_TMO], 1u); break; } }
    }
    nloc = mine > 0u ? mine : 1u; nx = cnt > 0u ? cnt : 1u;
}

__device__ __forceinline__ void xcd_barrier(const XcdBarrier& b, const int tid) {
    asm volatile("s_waitcnt vmcnt(0)" ::: "memory");
    __syncthreads();
    if (tid == 0) {
        unsigned* bar = b.bar;
        __builtin_amdgcn_s_waitcnt(0);
        unsigned nloc = b.st[0], nx = b.st[1];
        if (nloc == 0u) { xcd_barrier_complete(bar, b.x, nloc, nx); b.st[0] = nloc; b.st[1] = nx; }
        const unsigned old = xb_add(&bar[XB_XSUB(b.x)], 1u);
        const unsigned gen = old / nloc;
        if (old + 1u == (gen + 1u) * nloc) {
            __builtin_amdgcn_fence(__ATOMIC_RELEASE, "agent");
            asm volatile("s_waitcnt vmcnt(0)" ::: "memory");
            const unsigned og = xb_add(&bar[XB_TOP], 1u);
            const unsigned tg = og / nx;
            if (og + 1u == (tg + 1u) * nx) xb_add(&bar[XB_TOPGEN], 1u);
            else XB_SPIN(xb_ld(&bar[XB_TOPGEN]) == tg, bar);
            __builtin_amdgcn_fence(__ATOMIC_ACQUIRE, "agent");
            xb_add(&bar[XB_XGEN(b.x)], 1u);
            asm volatile("s_waitcnt vmcnt(0)" ::: "memory");
        } else {
            XB_SPIN(xb_ld(&bar[XB_XGEN(b.x)]) == gen, bar);
            __builtin_amdgcn_fence(__ATOMIC_ACQUIRE, "agent");
            asm volatile("s_waitcnt vmcnt(0)" ::: "memory");
        }
    }
    __syncthreads();
}
namespace att {
typedef __attribute__((ext_vector_type(8))) short bf16x8;
typedef __attribute__((ext_vector_type(4))) short s16x4;
typedef __attribute__((ext_vector_type(16))) float f32x16;
typedef __attribute__((ext_vector_type(4))) unsigned u32x4;
typedef unsigned short bf16;
constexpr int D = 128, NW = 8, QBLK = 32, KVBLK = 64, LDQ = 1024;
constexpr float SCALE = 0.088388347648318440f, THR = 8.f;
constexpr int SHM_V = KVBLK * D * 2, SHM_K = KVBLK * D * 2;
constexpr int WS_OFF = 2 * SHM_V + 2 * SHM_K, TAB_OFF = WS_OFF + NW * 64 * 4, ATT_LDS_BYTES = TAB_OFF + 2048;
#define KSWZ(row, colB) ((row) * 256 + ((colB) ^ (((row) & 7) << 4)))
#define SBAR() __builtin_amdgcn_sched_barrier(0)
__device__ __forceinline__ int crow(int r, int hi) { return (r & 3) + 8 * (r >> 2) + 4 * hi; }
__device__ __forceinline__ unsigned cvtpk(float lo, float hi) { unsigned r; asm volatile("v_cvt_pk_bf16_f32 %0, %1, %2" : "=v"(r) : "v"(lo), "v"(hi)); return r; }
__device__ __forceinline__ bf16x8 ld8(const bf16* p) { return *reinterpret_cast<const bf16x8*>(p); }

__device__ __forceinline__ void partialSM(f32x16& p0, f32x16& p1, float& m_reg, float& mn, float& alpha) {
  constexpr float C = SCALE * 1.4426950408889634f;
  float pmax = p0[0]; for (int r = 1; r < 16; ++r) pmax = fmaxf(pmax, p0[r]); for (int r = 0; r < 16; ++r) pmax = fmaxf(pmax, p1[r]);
  { auto rr = __builtin_amdgcn_permlane32_swap(__float_as_uint(pmax), __float_as_uint(pmax), false, false);
    pmax = fmaxf(__uint_as_float(rr[0]), __uint_as_float(rr[1])); }
  if (__builtin_expect(__all(pmax - m_reg <= THR / SCALE), 1)) { mn = m_reg; alpha = 1.f; }
  else { mn = fmaxf(m_reg, pmax); alpha = __builtin_amdgcn_exp2f((m_reg - mn) * C); m_reg = mn; }
  float mnC = -mn * C;
  for (int r = 0; r < 16; ++r) p0[r] = fmaf(p0[r], C, mnC); for (int r = 0; r < 16; ++r) p1[r] = fmaf(p1[r], C, mnC);
  for (int r = 0; r < 16; ++r) p0[r] = __builtin_amdgcn_exp2f(p0[r]);
}
__device__ __forceinline__ void finishSM(f32x16& p0, f32x16& p1, float alpha, float& l_reg, bf16x8& pa0, bf16x8& pa1, bf16x8& pa2, bf16x8& pa3) {
  for (int r = 0; r < 16; ++r) p1[r] = __builtin_amdgcn_exp2f(p1[r]);
  float ps = 0; for (int r = 0; r < 16; ++r) ps += p0[r]; for (int r = 0; r < 16; ++r) ps += p1[r];
  { auto rr = __builtin_amdgcn_permlane32_swap(__float_as_uint(ps), __float_as_uint(ps), false, false);
    ps = __uint_as_float(rr[0]) + __uint_as_float(rr[1]); }
  l_reg = l_reg * alpha + ps;
#define PK4(P, BASE, OUT) do { unsigned a0 = cvtpk(P[BASE + 0], P[BASE + 1]), a1 = cvtpk(P[BASE + 2], P[BASE + 3]);   \
    unsigned b0 = cvtpk(P[BASE + 4], P[BASE + 5]), b1 = cvtpk(P[BASE + 6], P[BASE + 7]);                              \
    auto r0 = __builtin_amdgcn_permlane32_swap(a0, b0, false, false); auto r1 = __builtin_amdgcn_permlane32_swap(a1, b1, false, false); \
    u32x4 w = {r0[0], r1[0], r0[1], r1[1]}; OUT = *reinterpret_cast<bf16x8*>(&w); } while (0)
  PK4(p0, 0, pa0); PK4(p0, 8, pa1); PK4(p1, 0, pa2); PK4(p1, 8, pa3);
#undef PK4
}
__device__ __forceinline__ void qkt(f32x16& p0, f32x16& p1, const bf16* Ks, const bf16x8* qr, int r32, int hi) {
  p0 = f32x16{}; p1 = f32x16{};
  const char* kb[4];
#pragma unroll
  for (int dd = 0; dd < 4; ++dd) kb[dd] = (const char*)Ks + KSWZ(r32, (dd * 16 + hi * 8) * 2);
#pragma unroll
  for (int d0 = 0; d0 < 8; ++d0) { const char* a = kb[d0 & 3] + (d0 >> 2) * 128;
    bf16x8 b0 = *reinterpret_cast<const bf16x8*>(a);
    bf16x8 b1 = *reinterpret_cast<const bf16x8*>(a + 32 * 256);
    p0 = __builtin_amdgcn_mfma_f32_32x32x16_bf16(b0, qr[d0], p0, 0, 0, 0);
    p1 = __builtin_amdgcn_mfma_f32_32x32x16_bf16(b1, qr[d0], p1, 0, 0, 0); }
}
__device__ __forceinline__ int v_st(int k, int c) { const int kk = (k & ~0xC) | ((k & 4) << 1) | ((k & 8) >> 1); return ((kk >> 3) * 4 + (c >> 5)) * 512 + ((kk & 7) * 32 + (c & 31)) * 2; }
__device__ __forceinline__ int v_rd_base(int lane) { return ((lane & 3) << 3) | (((lane >> 2) & 3) << 6) | (((lane >> 4) & 1) << 5) | (((lane >> 5) & 1) << 8); }
constexpr int v_rd_off(int d0, int ks, int half) { return d0 * 512 + ks * 4096 + half * 2048; }
template <int OFF> __device__ __forceinline__ s16x4 tr_read(int vb) {
  s16x4 r; asm volatile("ds_read_b64_tr_b16 %0, %1 offset:%2" : "=&v"(r) : "v"(vb), "i"(OFF) : "memory"); return r;
}
template <int D0> __device__ __forceinline__ void pv_one(f32x16& od, int vb, bf16x8 pa0, bf16x8 pa1, bf16x8 pa2, bf16x8 pa3) {
  const s16x4 l0 = tr_read<v_rd_off(D0, 0, 0)>(vb), h0 = tr_read<v_rd_off(D0, 0, 1)>(vb), l1 = tr_read<v_rd_off(D0, 1, 0)>(vb), h1 = tr_read<v_rd_off(D0, 1, 1)>(vb);
  const s16x4 l2 = tr_read<v_rd_off(D0, 2, 0)>(vb), h2 = tr_read<v_rd_off(D0, 2, 1)>(vb), l3 = tr_read<v_rd_off(D0, 3, 0)>(vb), h3 = tr_read<v_rd_off(D0, 3, 1)>(vb);
  asm volatile("s_waitcnt lgkmcnt(0)" ::: "memory"); SBAR();
#define PK(L, H) (bf16x8){L[0], L[1], L[2], L[3], H[0], H[1], H[2], H[3]}
  od = __builtin_amdgcn_mfma_f32_32x32x16_bf16(pa0, PK(l0, h0), od, 0, 0, 0);
  od = __builtin_amdgcn_mfma_f32_32x32x16_bf16(pa1, PK(l1, h1), od, 0, 0, 0);
  od = __builtin_amdgcn_mfma_f32_32x32x16_bf16(pa2, PK(l2, h2), od, 0, 0, 0);
  od = __builtin_amdgcn_mfma_f32_32x32x16_bf16(pa3, PK(l3, h3), od, 0, 0, 0);
#undef PK
}
__device__ __forceinline__ void pv_d0(f32x16* o, int vb, bf16x8 pa0, bf16x8 pa1, bf16x8 pa2, bf16x8 pa3) {
  pv_one<0>(o[0], vb, pa0, pa1, pa2, pa3); pv_one<1>(o[1], vb, pa0, pa1, pa2, pa3); pv_one<2>(o[2], vb, pa0, pa1, pa2, pa3); pv_one<3>(o[3], vb, pa0, pa1, pa2, pa3);
}

struct Unit {
  const bf16* Q; bf16* O;
  const bf16* K0; const bf16* V0;
  const bf16* K1; const bf16* V1;
  int n0, n1, ldk;
  int mode;
  int a, b;
  float sink2;
  const float* tab;
};
__device__ __forceinline__ void mask_nat(f32x16& p0, f32x16& p1, bool rowvis, int cs4, int cqb, const float* trow) {
  const float NEG = -__builtin_inff();
  if (!rowvis) {
#pragma unroll
    for (int r = 0; r < 16; ++r) { p0[r] = NEG; p1[r] = NEG; }
    return; }
#pragma unroll
  for (int r = 0; r < 16; ++r) { const int cc = (r & 3) + 8 * (r >> 2);
    { const int i0 = min(max(cc - cqb, 0), 30); const float bv = trow[i0]; p0[r] = ((unsigned)(cc - cs4) < 16u) ? p0[r] + bv : NEG; }
    { const int i1 = min(max(cc + 32 - cqb, 0), 30); const float bv = trow[i1]; p1[r] = ((unsigned)(cc + 32 - cs4) < 16u) ? p1[r] + bv : NEG; } }
}
__device__ __forceinline__ void mask_win(f32x16& p0, f32x16& p1, int dq) {
  const float NEG = -__builtin_inff();
#pragma unroll
  for (int r = 0; r < 16; ++r) { const int cc = (r & 3) + 8 * (r >> 2);
    if ((unsigned)(dq + cc) > 256u) p0[r] = NEG;
    if ((unsigned)(dq + cc + 32) > 256u) p1[r] = NEG; }
}

__device__ __forceinline__ void attn_unit(const Unit& U, char* lds, const int tid_in) {
  int tid_l = tid_in; asm volatile("" : "+v"(tid_l));
  const int tid = tid_l, wid = __builtin_amdgcn_readfirstlane(tid >> 6), lane = tid & 63, r32 = lane & 31, hi = lane >> 5;
  bf16* V_lds = (bf16*)lds; bf16* K_lds = (bf16*)(lds + 2 * SHM_V);
  float* ws = (float*)(lds + WS_OFF) + wid * 64; float* li_l = ws; float* al_l = ws + 32;
  float* tabL = (float*)(lds + TAB_OFF);
  if (U.mode == 1) { for (int i = tid; i < 465; i += 512) tabL[i] = U.tab[i] * (1.0f / SCALE); }
  float m_reg = -1e30f, l_reg = 0; f32x16 o[4] = {}; bf16x8 qr[8];
  const bf16* Qw = U.Q + (long)(wid * QBLK + r32) * LDQ + hi * 8;
#pragma unroll
  for (int d0 = 0; d0 < 8; ++d0) qr[d0] = ld8(Qw + d0 * 16);
  const int ldk = U.ldk, n0 = U.n0, NT = U.n0 + U.n1;
  const int sr = tid >> 4, sc = (tid & 15) * 8, vst0 = v_st(sr, sc), vst1 = v_st(32 + sr, sc);
  const int vb0 = (int)(uintptr_t)V_lds + v_rd_base(lane);
  struct { bf16x8 vs0, vs1, ks0, ks1; } sr_[1];
  const int maskA = U.a, maskB = U.b;
#define SLOAD(i, t) do { const int t_ = (t); const bf16* Kp_ = t_ < n0 ? U.K0 + (long)t_ * KVBLK * ldk : U.K1 + (long)(t_ - n0) * KVBLK * ldk;  \
    const bf16* Vp_ = t_ < n0 ? U.V0 + (long)t_ * KVBLK * ldk : U.V1 + (long)(t_ - n0) * KVBLK * ldk;                                         \
    sr_[i].vs0 = ld8(&Vp_[(long)sr * ldk + sc]); sr_[i].vs1 = ld8(&Vp_[(long)(32 + sr) * ldk + sc]);                                           \
    sr_[i].ks0 = ld8(&Kp_[(long)sr * ldk + sc]); sr_[i].ks1 = ld8(&Kp_[(long)(32 + sr) * ldk + sc]); } while (0)
#define SWRITE(b, i) do { *(bf16x8*)((char*)V_lds + (b) * SHM_V + vst0) = sr_[i].vs0;          \
    *(bf16x8*)((char*)V_lds + (b) * SHM_V + vst1) = sr_[i].vs1; int kc = sc * 2;               \
    *(bf16x8*)((char*)K_lds + (b) * SHM_K + KSWZ(sr, kc)) = sr_[i].ks0;                       \
    *(bf16x8*)((char*)K_lds + (b) * SHM_K + KSWZ(32 + sr, kc)) = sr_[i].ks1; } while (0)
#define SWAIT() asm volatile("s_waitcnt vmcnt(0)" ::: "memory")
#define RESC(a) do { if (__any((a) < 1.f)) { if (hi == 0) al_l[r32] = (a); asm volatile("s_waitcnt lgkmcnt(0)" ::: "memory"); \
    for (int d = 0; d < 4; ++d) for (int r = 0; r < 16; ++r) o[d][r] *= al_l[crow(r, hi)]; } } while (0)
#define MASK(P0, P1, t) do { if (U.mode != 0 && (t) >= n0) { const int tl_ = (t) - n0; int ln_ = lane; asm volatile("" : "+v"(ln_));     \
    const int r32_ = ln_ & 31, hi_ = ln_ >> 5;                                                                                                  \
    if (U.mode == 1) { const int rq_ = maskA + (wid >> 1), rsq_ = min(max(rq_ - 4, 0), 56), kr_ = maskB + tl_; const bool rv_ = (unsigned)(kr_ - rsq_) < 8u; const int dr_ = rv_ ? kr_ - rq_ + 7 : 0; \
        const int cq_ = 32 * (wid & 1) + r32_, cs_ = min(max(cq_ - 8, 0), 48);                                                                   \
        mask_nat(P0, P1, rv_, cs_ - 4 * hi_, cq_ - 15 - 4 * hi_, tabL + dr_ * 31); }                                                             \
    else { mask_win(P0, P1, maskB + tl_ * KVBLK - (maskA + 32 * wid + r32_) + 4 * hi_ + 128); } } } while (0)
  f32x16 pA0, pA1, pB0, pB1; float mnA, mnB, alA, alB; bf16x8 pa0, pa1, pa2, pa3;
  constexpr int SE = 0, SO = 0;
  SLOAD(SE, 0); asm volatile("s_waitcnt vmcnt(0)" ::: "memory"); SWRITE(0, SE); __syncthreads();
  qkt(pA0, pA1, K_lds, qr, r32, hi); MASK(pA0, pA1, 0); partialSM(pA0, pA1, m_reg, mnA, alA);
  SLOAD(SO, 1);
  SWAIT(); SWRITE(1, SO); __syncthreads();
  for (int j = 1; j + 1 < NT; j += 2) {
    SBAR(); SLOAD(SO, j + 1); SBAR();
    qkt(pB0, pB1, (bf16*)((char*)K_lds + SHM_K), qr, r32, hi);
    finishSM(pA0, pA1, alA, l_reg, pa0, pa1, pa2, pa3); SBAR();
    pv_d0(o, vb0, pa0, pa1, pa2, pa3); MASK(pB0, pB1, j); partialSM(pB0, pB1, m_reg, mnB, alB);
    __syncthreads(); SWAIT(); SWRITE(0, SE);
    RESC(alB); __syncthreads();
    SBAR(); SLOAD(SE, j + 2); SBAR();
    qkt(pA0, pA1, K_lds, qr, r32, hi);
    finishSM(pB0, pB1, alB, l_reg, pa0, pa1, pa2, pa3); SBAR();
    pv_d0(o, vb0 + (int)SHM_V, pa0, pa1, pa2, pa3); MASK(pA0, pA1, j + 1); partialSM(pA0, pA1, m_reg, mnA, alA);
    __syncthreads(); SWAIT(); SWRITE(1, SO);
    RESC(alA); __syncthreads();
  }
  SBAR(); qkt(pB0, pB1, (bf16*)((char*)K_lds + SHM_K), qr, r32, hi);
  finishSM(pA0, pA1, alA, l_reg, pa0, pa1, pa2, pa3); SBAR();
  pv_d0(o, vb0, pa0, pa1, pa2, pa3); MASK(pB0, pB1, NT - 1); partialSM(pB0, pB1, m_reg, mnB, alB);
  __syncthreads(); RESC(alB);
  finishSM(pB0, pB1, alB, l_reg, pa0, pa1, pa2, pa3); SBAR();
  pv_d0(o, vb0 + (int)SHM_V, pa0, pa1, pa2, pa3);
  l_reg += __builtin_amdgcn_exp2f(U.sink2 - m_reg * (SCALE * 1.4426950408889634f));
  if (hi == 0) li_l[r32] = l_reg; asm volatile("s_waitcnt lgkmcnt(0)" ::: "memory");
  float rli[16];
#pragma unroll
  for (int r = 0; r < 16; ++r) rli[r] = __builtin_amdgcn_rcpf(li_l[crow(r, hi)]);
  __syncthreads();
  { bf16* stg = (bf16*)(lds + wid * 8192);
#pragma unroll
    for (int r = 0; r < 16; ++r) { const int orow = crow(r, hi);
#pragma unroll
      for (int d0 = 0; d0 < 4; ++d0) stg[orow * 128 + d0 * 32 + r32] = (bf16)(cvtpk(o[d0][r] * rli[r], 0.f) & 0xffffu); }
    asm volatile("s_waitcnt lgkmcnt(0)" ::: "memory");
    bf16* Ow = U.O + (long)(wid * QBLK) * LDQ;
#pragma unroll
    for (int i = 0; i < 8; ++i) { const int row = 4 * i + (lane >> 4), ch = lane & 15; const u32x4 v = *(const u32x4*)(stg + row * 128 + ch * 8);
      *(u32x4*)(Ow + (long)row * LDQ + ch * 8) = v; } }
  __syncthreads();
#undef SLOAD
#undef SWRITE
#undef SWAIT
#undef RESC
#undef MASK
}
#undef KSWZ
#undef SBAR
}
constexpr int DM = 2048, R_CTX = 4096, R_LAT = 8192, RT = 12288, FF = 5632, NGU = 11264, DIN = 12288, HD = 128;
constexpr int NWAVES = 8, NTHR = 512;
constexpr float EPS_N = 1e-6f, SM_SCALE = 0.08838834764831845f;
constexpr size_t MiB = 1u << 20;
constexpr size_t WS_CTL = 0, CTL_ZERO_BYTES = 1 * MiB;
constexpr size_t WS_MODS = 1 * MiB;
constexpr size_t WS_ROPE = 2 * MiB;
constexpr size_t WS_CACHE = 4 * MiB;
constexpr size_t WS_W = 16 * MiB, W_LAYER = 200 * MiB;
constexpr size_t W_GU1 = 0, W_D1 = 44 * MiB, W_IN = 66 * MiB, W_B = 114 * MiB, W_O = 126 * MiB, W_GU2 = 134 * MiB, W_D2 = 178 * MiB;
constexpr size_t WS_H = 416 * MiB;
constexpr size_t WS_ACT = 464 * MiB;
constexpr size_t WS_Z = 596 * MiB;
constexpr size_t WS_QKVG = 884 * MiB;
constexpr size_t WS_END = 1172 * MiB;
constexpr int CW_BAR = 4096;
constexpr int EXCH_OFF = 131072, LDSCTL_OFF = 139264, MISC_OFF = LDSCTL_OFF + 320, LDS_BYTES = 147456;
constexpr size_t OUT_YP = 0, OUT_YS = 8388608, OUT_KGQA = 25165824, OUT_VGQA = 27262976, OUT_KNAT = 29360128, OUT_VNAT = 37748736, OUT_KWIN = 46137344, OUT_VWIN = 48234496, OUT_TOTAL = 50331648;

constexpr int MAP_GU = 1, MAP_IN = 2;
struct Args { const float* in[25]; float* out; unsigned char* ws; };

struct Frame {
    LAS unsigned char* lds;
    int tid, lane, wave, G, bid;
    float* out; unsigned char* ws;
};
#define CAS __attribute__((address_space(4)))
__device__ __forceinline__ const float* in_ptr(int k) { const CAS char* p = (const CAS char*)__builtin_amdgcn_kernarg_segment_ptr(); asm volatile("" : "+s"(p)); return *(const float* const CAS*)(p + 8 * k); }

__device__ __forceinline__ float shx(float v, int mask, int lane) { return __uint_as_float((unsigned)__builtin_amdgcn_ds_bpermute((lane ^ mask) << 2, (int)__float_as_uint(v))); }
__device__ __forceinline__ float wave_sum(float v, int lane) {
#pragma unroll
    for (int o = 1; o < 64; o <<= 1) v += shx(v, o, lane);
    return v;
}
__device__ __forceinline__ float bf2f(unsigned b) { return __uint_as_float(b << 16); }
__device__ __forceinline__ float bflo(unsigned w) { return __uint_as_float(w << 16); }
__device__ __forceinline__ float bfhi(unsigned w) { return __uint_as_float(w & 0xffff0000u); }
__device__ __forceinline__ float sigm(float x) { return 1.f / (1.f + __expf(-x)); }

__device__ __forceinline__ int rowmap(int MAP, int s) {
    if (MAP == 1) { const int n = s >= FF ? 1 : 0, j = s - FF * n, pn = j >> 7, jj = j & 127, wc = jj >> 5, fq = (jj & 31) >> 3, bj = (jj & 7) >> 2, e = jj & 3;
        return 256 * pn + 128 * bj + 32 * wc + 16 * n + 4 * fq + e; }
    if (MAP == 2) { const int pn = s >> 8, c = s & 255, bj = c >> 7, d = c & 127; const bool ropet = pn < 5 || (pn >= 18 && pn < 23);
        if (ropet) { const int h2 = d >> 6, n = (d & 63) >> 5, w1 = (d & 31) >> 4, fq = (d & 15) >> 2, e = d & 3; return 256 * pn + 128 * bj + 32 * (2 * h2 + w1) + 16 * n + 4 * fq + e; }
        const int wc = d >> 5, fq = (d & 31) >> 3, n = (d & 7) >> 2, e = d & 3; return 256 * pn + 128 * bj + 32 * wc + 16 * n + 4 * fq + e; }
    return s;
}
__device__ __forceinline__ void transpose_item(const float* W, int K, int N, bf16* WT, LAS float* scr, int k0, int n0, int lane, int MAP) {
    f32x4 tv[16];
#pragma unroll
    for (int i = 0; i < 16; ++i) tv[i] = *(const GAS f32x4*)(W + (size_t)(k0 + 4 * i + (lane >> 4)) * N + n0 + 4 * (lane & 15));
#pragma unroll
    for (int i = 0; i < 16; ++i) { LAS float* s = scr + (4 * i + (lane >> 4)) * 65 + 4 * (lane & 15); s[0] = tv[i].x; s[1] = tv[i].y; s[2] = tv[i].z; s[3] = tv[i].w; }
    LDS_WAIT(); asm volatile("" ::: "memory");
    const int c = lane & 7;
#pragma unroll
    for (int j = 0; j < 8; ++j) {
        const int n = 8 * j + (lane >> 3); const LAS float* s = scr + (8 * c) * 65 + n;
        v4u o; o.x = pk2(s[0], s[65]); o.y = pk2(s[130], s[195]); o.z = pk2(s[260], s[325]); o.w = pk2(s[390], s[455]);
        *(GAS v4u*)(WT + (size_t)rowmap(MAP, n0 + n) * K + k0 + 8 * c) = o;
    }
    LDS_WAIT(); asm volatile("" ::: "memory");
}
__device__ __forceinline__ void transpose_matrix(Frame& F, const float* W, int K, int N, bf16* WT, int MAP) {
    LAS float* scr = (LAS float*)(F.lds + F.wave * 16640);
    const int gw = F.bid * NWAVES + F.wave, NGW = F.G * NWAVES, nb = N / 64, items = (K / 64) * nb;
    for (int it = gw; it < items; it += NGW) transpose_item(W, K, N, WT, scr, 64 * (it / nb), 64 * (it % nb), F.lane, MAP);
}
__device__ __forceinline__ void cvt_array(Frame& F, const float* src, bf16* dst, int n8) {
    for (int i = F.bid * NTHR + F.tid; i < n8; i += F.G * NTHR) {
        const f32x4 a = *(const GAS f32x4*)(src + (size_t)i * 8), b = *(const GAS f32x4*)(src + (size_t)i * 8 + 4);
        v4u o; o.x = pk2(a.x, a.y); o.y = pk2(a.z, a.w); o.z = pk2(b.x, b.y); o.w = pk2(b.z, b.w);
        *(GAS v4u*)(dst + (size_t)i * 8) = o;
    }
}
__device__ __forceinline__ void mods_phase(Frame& F) {
    LAS float* sv = (LAS float*)F.lds;
    LAS f32x4* red = (LAS f32x4*)(F.lds + 24576);
    const float* c_lat = in_ptr(8); const float* c_ctx = in_ptr(9); const float* w_mod = in_ptr(10); const float* b_mod = in_ptr(11);
    float* mods = (float*)(F.ws + WS_MODS);
    for (int i = F.tid; i < 3 * 2048; i += NTHR) { const int g = i >> 11, k = i & 2047; const float c = (g == 0) ? c_ctx[k] : c_lat[(g - 1) * 2048 + k]; sv[i] = c / (1.f + __expf(-c)); }
    __syncthreads();
    for (int cb = F.bid; cb < 256; cb += F.G) {
        const int l = cb >> 7, col0 = (cb & 127) * 144;
        if (F.tid < 504) {
            const int c4 = F.tid % 36, kg = F.tid / 36;
            const GAS f32x4* wp = (const GAS f32x4*)(w_mod + (size_t)l * 2048 * 18432 + col0 + 4 * c4);
            f32x4 a0 = {0.f, 0.f, 0.f, 0.f}, a1 = a0, a2 = a0;
#pragma unroll 4
            for (int k = kg; k < 2048; k += 14) { const f32x4 w = wp[(size_t)k * 4608]; a0 += sv[k] * w; a1 += sv[2048 + k] * w; a2 += sv[4096 + k] * w; }
            red[(kg * 3 + 0) * 36 + c4] = a0; red[(kg * 3 + 1) * 36 + c4] = a1; red[(kg * 3 + 2) * 36 + c4] = a2;
        }
        __syncthreads();
        if (F.tid < 108) {
            const int g = F.tid / 36, c4 = F.tid % 36; f32x4 s = *(const GAS f32x4*)(b_mod + (size_t)l * 18432 + col0 + 4 * c4);
            for (int kg = 0; kg < 14; ++kg) s += red[(kg * 3 + g) * 36 + c4];
            *(GAS f32x4*)(mods + (size_t)(l * 3 + g) * 18432 + col0 + 4 * c4) = s;
        }
        __syncthreads();
    }
}
__device__ __forceinline__ void prologue(Frame& F) {
    unsigned char* ws = F.ws;
    for (int l = 0; l < 2; ++l) {
        unsigned char* wl = ws + WS_W + (size_t)l * W_LAYER;
        transpose_matrix(F, in_ptr(13) + (size_t)l * DM * NGU, DM, NGU, (bf16*)(wl + W_GU1), MAP_GU);
        transpose_matrix(F, in_ptr(14) + (size_t)l * FF * DM, FF, DM, (bf16*)(wl + W_D1), 0);
        transpose_matrix(F, in_ptr(15) + (size_t)l * DM * DIN, DM, DIN, (bf16*)(wl + W_IN), MAP_IN);
        for (int i = 0; i < 3; ++i) transpose_matrix(F, in_ptr(20) + (size_t)(l * 3 + i) * 1024 * DM, 1024, DM, (bf16*)(wl + W_B) + (size_t)i * DM * 1024, 0);
        transpose_matrix(F, in_ptr(21) + (size_t)l * DM * DM, DM, DM, (bf16*)(wl + W_O), 0);
        transpose_matrix(F, in_ptr(22) + (size_t)l * DM * NGU, DM, NGU, (bf16*)(wl + W_GU2), MAP_GU);
        transpose_matrix(F, in_ptr(23) + (size_t)l * FF * DM, FF, DM, (bf16*)(wl + W_D2), 0);
    }
    cvt_array(F, in_ptr(2), (bf16*)(ws + WS_CACHE), 524288 / 8);
    cvt_array(F, in_ptr(3), (bf16*)(ws + WS_CACHE + 1 * MiB), 524288 / 8);
    cvt_array(F, in_ptr(6), (bf16*)(ws + WS_CACHE + 2 * MiB), 524288 / 8);
    cvt_array(F, in_ptr(7), (bf16*)(ws + WS_CACHE + 3 * MiB), 524288 / 8);
    cvt_array(F, in_ptr(4), (bf16*)(ws + WS_CACHE + 4 * MiB), 2097152 / 8);
    cvt_array(F, in_ptr(5), (bf16*)(ws + WS_CACHE + 8 * MiB), 2097152 / 8);
    { float* ct = (float*)(ws + WS_ROPE); float* st = ct + 2048;
      for (int i = F.bid * NTHR + F.tid; i < 2048; i += F.G * NTHR) { const int pos = i >> 5, f = i & 31;
          const float inv = exp2f(-(float)f * (13.287712379549449f / 32.0f)); const float ang = (float)pos * inv;
          const float kf = rintf(ang * 0.6366197723675814f); float r = fmaf(-kf, 1.5707962512969971f, ang); r = fmaf(-kf, 7.5497894158615964e-08f, r); r = fmaf(-kf, 5.3903029534742384e-15f, r);
          const float r2 = r * r;
          const float sn = r + r * r2 * (-1.6666667e-1f + r2 * (8.3333338e-3f + r2 * (-1.9841270e-4f + r2 * 2.7557319e-6f)));
          const float cs = 1.0f + r2 * (-0.5f + r2 * (4.1666668e-2f + r2 * (-1.3888889e-3f + r2 * (2.4801587e-5f + r2 * -2.7557319e-7f))));
          const int q = ((int)kf) & 3; const float sv_ = (q == 0) ? sn : (q == 1) ? cs : (q == 2) ? -sn : -cs, cv_ = (q == 0) ? cs : (q == 1) ? -sn : (q == 2) ? -cs : sn;
          ct[i] = cv_; st[i] = sv_; } }
    __syncthreads();
    mods_phase(F);
}

__device__ __forceinline__ void adaln_phase(Frame& F, int l, int which, bool from_inputs) {
    const float* X = F.out; bf16* H = (bf16*)(F.ws + WS_H); const float* mods = (const float*)(F.ws + WS_MODS);
    const float* gn = in_ptr(12) + (size_t)(l * 3 + which) * DM; const float* xin0 = in_ptr(0); const float* xin1 = in_ptr(1);
    const int gw = F.bid * NWAVES + F.wave, NGW = F.G * NWAVES, lane = F.lane;
#define ADALN_SRC(row) (from_inputs ? ((row) < R_CTX ? xin0 + (size_t)(row) * DM : xin1 + (size_t)((row) - R_CTX) * DM) : X + (size_t)(row) * DM)
    f32x4 v[8], vn[8];
    if (gw < RT) { const float* src = ADALN_SRC(gw);
#pragma unroll
        for (int j = 0; j < 8; ++j) v[j] = ((const GAS f32x4*)src)[64 * j + lane]; }
    for (int row = gw; row < RT; row += NGW) {
        const int g = row < R_CTX ? 0 : 1 + ((row - R_CTX) >> 12);
        const int nrow = row + NGW;
        if (nrow < RT) { const float* src = ADALN_SRC(nrow);
#pragma unroll
            for (int j = 0; j < 8; ++j) vn[j] = ((const GAS f32x4*)src)[64 * j + lane]; }
        float ss = 0.f;
#pragma unroll
        for (int j = 0; j < 8; ++j) ss += (v[j].x * v[j].x + v[j].y * v[j].y) + (v[j].z * v[j].z + v[j].w * v[j].w);
        const float rstd = 1.0f / sqrtf(wave_sum(ss, lane) * (1.0f / DM) + EPS_N);
        const GAS f32x4* gnp = (const GAS f32x4*)gn; const float* mg = mods + (size_t)(l * 3 + g) * 18432 + (size_t)which * 3 * DM;
        const GAS f32x4* shp = (const GAS f32x4*)mg; const GAS f32x4* scp = (const GAS f32x4*)(mg + DM);
        GAS unsigned long long* o8 = (GAS unsigned long long*)(H + (size_t)row * DM);
#pragma unroll
        for (int j = 0; j < 8; ++j) {
            const f32x4 a = gnp[64 * j + lane] * (1.0f + scp[64 * j + lane]) * rstd, b = shp[64 * j + lane]; const f32x4 h = v[j] * a + b;
            o8[64 * j + lane] = (unsigned long long)pk2(h.x, h.y) | ((unsigned long long)pk2(h.z, h.w) << 32);
        }
#pragma unroll
        for (int j = 0; j < 8; ++j) v[j] = vn[j];
    }
#undef ADALN_SRC
}
__device__ __forceinline__ void final_phase(Frame& F) {
    float* X = F.out; const GAS f32x4* gf = (const GAS f32x4*)in_ptr(24);
    const int gw = F.bid * NWAVES + F.wave, NGW = F.G * NWAVES, lane = F.lane;
    for (int row = gw; row < RT; row += NGW) {
        GAS f32x4* xr = (GAS f32x4*)(X + (size_t)row * DM);
        f32x4 v[8];
#pragma unroll
        for (int j = 0; j < 8; ++j) v[j] = xr[64 * j + lane];
        float ss = 0.f;
#pragma unroll
        for (int j = 0; j < 8; ++j) ss += (v[j].x * v[j].x + v[j].y * v[j].y) + (v[j].z * v[j].z + v[j].w * v[j].w);
        const float rstd = 1.0f / sqrtf(wave_sum(ss, lane) * (1.0f / DM) + EPS_N);
#pragma unroll
        for (int j = 0; j < 8; ++j) xr[64 * j + lane] = v[j] * rstd * gf[64 * j + lane];
    }
}
__device__ __forceinline__ bool make_unit(Frame& F, int l, int id, att::Unit& U) {
    if (id >= 1152) return false;
    unsigned char* qb = F.ws + WS_QKVG;
    const bf16* QA = (const bf16*)qb; const bf16* QB = (const bf16*)(qb + 24 * MiB); const bf16* QC = (const bf16*)(qb + 48 * MiB); const bf16* KB = (const bf16*)(qb + 72 * MiB); const bf16* VB = (const bf16*)(qb + 96 * MiB);
    const bf16* KA = (const bf16*)(qb + 120 * MiB); const bf16* VA = (const bf16*)(qb + 126 * MiB); const bf16* KC = (const bf16*)(qb + 132 * MiB); const bf16* VC = (const bf16*)(qb + 138 * MiB);
    const bf16* CKA = (const bf16*)(F.ws + WS_CACHE); const bf16* CVA = (const bf16*)(F.ws + WS_CACHE + 1 * MiB); const bf16* CKC = (const bf16*)(F.ws + WS_CACHE + 2 * MiB); const bf16* CVC = (const bf16*)(F.ws + WS_CACHE + 3 * MiB);
    const bf16* CKB = (const bf16*)(F.ws + WS_CACHE + 4 * MiB); const bf16* CVB = (const bf16*)(F.ws + WS_CACHE + 8 * MiB);
    bf16* O = (bf16*)(F.ws + WS_ACT);
    const float LOG2E = 1.4426950408889634f;
    U.mode = 0; U.a = 0; U.b = 0; U.sink2 = -__builtin_inff(); U.tab = in_ptr(18); U.n0 = 0;
    if (id < 768) {
        const int type = id >> 8, v = id & 255, xcd = v & 7, j = v >> 3; int b, h, q;
        if (type != 1) { const int combo = xcd >> 1, idx = (xcd & 1) * 32 + j; b = combo >> 1; h = (combo & 1) * 4 + (idx >> 4); q = idx & 15; }
        else { const int combo = xcd * 2 + (j >> 4); b = combo >> 3; h = combo & 7; q = j & 15; }
        const size_t lat0 = R_CTX + (size_t)b * 4096, row0 = lat0 + (size_t)q * 256, cb = (size_t)(b * 2 + l) * 512;
        U.n0 = 8;
        if (type == 0) { const int kvh = h >> 2; U.ldk = 256;
            U.Q = QA + row0 * 1024 + h * 128; U.O = O + row0 * 1024 + h * 128;
            U.K0 = CKA + cb * 256 + kvh * 128; U.V0 = CVA + cb * 256 + kvh * 128; U.K1 = KA + lat0 * 256 + kvh * 128; U.V1 = VA + lat0 * 256 + kvh * 128; U.n1 = 64; }
        else if (type == 1) { U.ldk = 1024; const int R0 = q * 4, kr0 = min(max(R0 - 4, 0), 52);
            U.Q = QB + row0 * 1024 + h * 128; U.O = O + (size_t)RT * 1024 + row0 * 1024 + h * 128;
            U.K0 = CKB + cb * 1024 + h * 128; U.V0 = CVB + cb * 1024 + h * 128; U.K1 = KB + (lat0 + (size_t)kr0 * 64) * 1024 + h * 128; U.V1 = VB + (lat0 + (size_t)kr0 * 64) * 1024 + h * 128; U.n1 = 12;
            U.mode = 1; U.a = R0; U.b = kr0; U.tab = in_ptr(18) + (size_t)(l * 8 + h) * 465; }
        else { const int kvh = h >> 2; U.ldk = 256; const int kp0 = max(q * 256 - 128, 0), kp1 = min(q * 256 + 384, 4096);
            U.Q = QC + row0 * 1024 + h * 128; U.O = O + (size_t)2 * RT * 1024 + row0 * 1024 + h * 128;
            U.K0 = CKC + cb * 256 + kvh * 128; U.V0 = CVC + cb * 256 + kvh * 128; U.K1 = KC + (lat0 + kp0) * 256 + kvh * 128; U.V1 = VC + (lat0 + kp0) * 256 + kvh * 128; U.n1 = (kp1 - kp0) >> 6;
            U.mode = 2; U.a = q * 256; U.b = kp0; U.sink2 = in_ptr(19)[l * 8 + h] * LOG2E; }
    } else {
        const int v = id - 768, b = v / 24, rem = v - 24 * b, br = rem >> 3, h = rem & 7; const size_t row0 = (size_t)b * 256;
        const int kvh = br == 1 ? h : (h >> 2); U.ldk = br == 1 ? 1024 : 256;
        const bf16* Qx = br == 0 ? QA : br == 1 ? QB : QC; const bf16* Kx = br == 0 ? KA : br == 1 ? KB : KC; const bf16* Vx = br == 0 ? VA : br == 1 ? VB : VC;
        U.Q = Qx + row0 * 1024 + h * 128; U.O = O + (size_t)br * RT * 1024 + row0 * 1024 + h * 128;
        U.K1 = Kx + row0 * U.ldk + kvh * 128; U.V1 = Vx + row0 * U.ldk + kvh * 128; U.K0 = U.K1; U.V0 = U.V1; U.n1 = 4;
        if (br == 2) U.sink2 = in_ptr(19)[l * 8 + h] * LOG2E;
    }
    return true;
}
__device__ __forceinline__ void attn_phase(Frame& F, int l, char* lds) {
    for (int id = F.bid; ; id += F.G) { att::Unit U; if (!make_unit(F, l, id, U)) break; att::attn_unit(U, lds, F.tid); }
}

namespace pg8 {
struct EpiSwiglu {
    static constexpr bool PERM = false, AFTER_DRAIN = false, CHAIN = false;
    bf16_t* ACT;
    __device__ __forceinline__ void operator()(const f32x4 (&acc)[2][2][4][2], const Unit& u, int wr, int wc, int fr, int fq) const {
        { int ln_; asm volatile("v_mbcnt_lo_u32_b32 %0, -1, 0\n\tv_mbcnt_hi_u32_b32 %0, -1, %0" : "=v"(ln_)); fr = ln_ & 15; fq = ln_ >> 4; }
        const int row0 = u.pm * BM + wr * 64 + fr, col0 = u.pn * 128 + wc * 32 + 8 * fq;
#pragma unroll
        for (int ai = 0; ai < 2; ++ai)
#pragma unroll
            for (int m = 0; m < 4; ++m) { u32x4 w;
#pragma unroll
                for (int bj = 0; bj < 2; ++bj) { const f32x4 a = acc[ai][bj][m][0], b = acc[ai][bj][m][1]; f32x4 r;
#pragma unroll
                    for (int e = 0; e < 4; ++e) r[e] = a[e] * __builtin_amdgcn_rcpf(1.0f + __expf(-a[e])) * b[e];
                    w[2 * bj] = cvt_pk_bf16(r[0], r[1]); w[2 * bj + 1] = cvt_pk_bf16(r[2], r[3]); }
                *(u32x4*)(ACT + (size_t)(row0 + ai * HALF + m * 16) * 5632 + col0) = w; }
    }
};
struct EpiResid {
    static constexpr bool PERM = false, AFTER_DRAIN = false, CHAIN = false;
    float* X; const float* base_ctx; const float* base_lat; const float* gate; float coef;
    __device__ __forceinline__ void operator()(const f32x4 (&acc)[2][2][4][2], const Unit& u, int wr, int wc, int fr, int fq) const {
        { int ln_; asm volatile("v_mbcnt_lo_u32_b32 %0, -1, 0\n\tv_mbcnt_hi_u32_b32 %0, -1, %0" : "=v"(ln_)); fr = ln_ & 15; fq = ln_ >> 4; }
        const int col0 = u.pn * BM + wc * 32 + 4 * fq;
        const int grp = u.pm < 16 ? 0 : (u.pm < 32 ? 1 : 2);
        const float* bs = u.pm < 16 ? base_ctx + (size_t)u.pm * BM * 2048 : base_lat + (size_t)(u.pm - 16) * BM * 2048;
        f32x4 gv[2][2];
#pragma unroll
        for (int bj = 0; bj < 2; ++bj)
#pragma unroll
            for (int n = 0; n < 2; ++n) gv[bj][n] = *(const f32x4*)(gate + (size_t)grp * 18432 + col0 + bj * HALF + n * 16) * coef;
#pragma unroll
        for (int ai = 0; ai < 2; ++ai) {
            f32x4 bv[4][2][2];
#pragma unroll
            for (int m = 0; m < 4; ++m) { const size_t off = (size_t)(wr * 64 + fr + ai * HALF + m * 16) * 2048 + col0;
#pragma unroll
                for (int bj = 0; bj < 2; ++bj)
#pragma unroll
                    for (int n = 0; n < 2; ++n) bv[m][bj][n] = *(const f32x4*)(bs + off + bj * HALF + n * 16); }
#pragma unroll
            for (int m = 0; m < 4; ++m) { const size_t off = (size_t)(wr * 64 + fr + ai * HALF + m * 16) * 2048 + col0;
#pragma unroll
                for (int bj = 0; bj < 2; ++bj)
#pragma unroll
                    for (int n = 0; n < 2; ++n) *(f32x4*)(X + (size_t)u.pm * BM * 2048 + off + bj * HALF + n * 16) = bv[m][bj][n] + gv[bj][n] * acc[ai][bj][m][n]; } }
    }
};
struct EpiBranch {
    static constexpr bool PERM = false, AFTER_DRAIN = false, CHAIN = true;
    bf16_t* Mb; const bf16_t* GT;
    __device__ __forceinline__ void operator()(f32x4 (&acc)[2][2][4][2], const Unit& u, int wr, int wc, int fr, int fq) const {
        { int ln_; asm volatile("v_mbcnt_lo_u32_b32 %0, -1, 0\n\tv_mbcnt_hi_u32_b32 %0, -1, %0" : "=v"(ln_)); fr = ln_ & 15; fq = ln_ >> 4; }
        const int br = u.pm / 48, pm = u.pm - 48 * br, pn = u.pn & 7;
        const int row0 = pm * BM + wr * 64 + fr, col0 = pn * BM + wc * 32 + 4 * fq;
        const int o2 = br < 2 ? 2048 : 0;
        const float keep = br < 2 ? 1.0f : 0.0f;
#pragma unroll
        for (int aq = 0; aq < 4; ++aq) { const int ai = aq >> 1, m0 = (aq & 1) * 2;
            unsigned long long ga[2][2][2], gb[2][2][2];
#pragma unroll
            for (int mm = 0; mm < 2; ++mm) { const size_t row = (size_t)(row0 + ai * HALF + (m0 + mm) * 16);
#pragma unroll
                for (int bj = 0; bj < 2; ++bj)
#pragma unroll
                    for (int n = 0; n < 2; ++n) { const bf16_t* gp = GT + row * 6144 + br * 2048 + col0 + bj * HALF + n * 16; ga[mm][bj][n] = *(const unsigned long long*)gp; gb[mm][bj][n] = *(const unsigned long long*)(gp + o2); } }
#pragma unroll
            for (int mm = 0; mm < 2; ++mm) { const size_t row = (size_t)(row0 + ai * HALF + (m0 + mm) * 16);
#pragma unroll
                for (int bj = 0; bj < 2; ++bj)
#pragma unroll
                    for (int n = 0; n < 2; ++n) { const unsigned a0 = (unsigned)ga[mm][bj][n], a1 = (unsigned)(ga[mm][bj][n] >> 32), b0 = (unsigned)gb[mm][bj][n], b1 = (unsigned)(gb[mm][bj][n] >> 32);
                        const f32x4 num = {__uint_as_float(a0 << 16), __uint_as_float(a0 & 0xffff0000u), __uint_as_float(a1 << 16), __uint_as_float(a1 & 0xffff0000u)};
                        const f32x4 den = {__uint_as_float(b0 << 16), __uint_as_float(b0 & 0xffff0000u), __uint_as_float(b1 << 16), __uint_as_float(b1 & 0xffff0000u)};
                        f32x4 r;
#pragma unroll
                        for (int e = 0; e < 4; ++e) { const float nu = fmaxf(num[e], 1e-20f), de = fmaxf(den[e], 1e-20f); r[e] = br < 2 ? nu * __builtin_amdgcn_rcpf(de) : nu; }
                        if (br == 2) { const f32x4 t = acc[ai][bj][m0 + mm][n] * r;
                            *(unsigned long long*)(Mb + row * 2048 + col0 + bj * HALF + n * 16) = (unsigned long long)cvt_pk_bf16(t[0], t[1]) | ((unsigned long long)cvt_pk_bf16(t[2], t[3]) << 32); }
                        acc[ai][bj][m0 + mm][n] *= r * keep;
                        asm volatile("" : "+v"(acc[ai][bj][m0 + mm][n])); } }
            __builtin_amdgcn_sched_barrier(0); }
    }
};
struct EpiInproj {
    static constexpr bool PERM = false, AFTER_DRAIN = false, CHAIN = false;
    unsigned char* qkvg; float* out; const float* gq; const float* gk; const float* ropec; int l; PG8_LAS float* P;
    __device__ __forceinline__ void operator()(const f32x4 (&acc)[2][2][4][2], const Unit& u, int wr, int wc, int fr, int fq) const {
        { int ln_; asm volatile("v_mbcnt_lo_u32_b32 %0, -1, 0\n\tv_mbcnt_hi_u32_b32 %0, -1, %0" : "=v"(ln_)); fr = ln_ & 15; fq = ln_ >> 4; }
        constexpr size_t MiB_ = 1u << 20;
        const int pn = u.pn; const bool isctx = u.pm < 16;
        bf16_t* dst; int dld; float* fo = nullptr; int fld = 0; int kind = 0, norm = 0;
        if (pn < 4)        { dst = (bf16_t*)qkvg + pn * 256; dld = 1024; kind = 1; norm = 1; }
        else if (pn == 4)  { dst = (bf16_t*)(qkvg + 120 * MiB_); dld = 256; kind = 1; norm = 2; fo = out + 25165824; fld = 256; }
        else if (pn == 5)  { dst = (bf16_t*)(qkvg + 126 * MiB_); dld = 256; fo = out + 27262976; fld = 256; }
        else if (pn < 10)  { dst = (bf16_t*)(qkvg + 24 * MiB_) + (pn - 6) * 256; dld = 1024; }
        else if (pn < 14)  { dst = (bf16_t*)(qkvg + 72 * MiB_) + (pn - 10) * 256; dld = 1024; fo = out + 29360128 + (pn - 10) * 256; fld = 1024; }
        else if (pn < 18)  { dst = (bf16_t*)(qkvg + 96 * MiB_) + (pn - 14) * 256; dld = 1024; fo = out + 37748736 + (pn - 14) * 256; fld = 1024; }
        else if (pn < 22)  { dst = (bf16_t*)(qkvg + 48 * MiB_) + (pn - 18) * 256; dld = 1024; kind = 1; }
        else if (pn == 22) { dst = (bf16_t*)(qkvg + 132 * MiB_); dld = 256; kind = 1; fo = out + 46137344; fld = 256; }
        else if (pn == 23) { dst = (bf16_t*)(qkvg + 138 * MiB_); dld = 256; fo = out + 48234496; fld = 256; }
        else               { dst = (bf16_t*)(qkvg + 144 * MiB_) + (pn - 24) * 256; dld = 6144; kind = 2; }
        if (!isctx) fo = nullptr;
        const int rl0 = wr * 64 + fr;
        const size_t grow0 = (size_t)u.pm * BM;
        const size_t frow0 = ((size_t)(u.pm * 2 + l)) * 256;
        if (kind != 1) {
            const int c0 = 32 * wc + 8 * fq;
#pragma unroll
            for (int ai = 0; ai < 2; ++ai)
#pragma unroll
                for (int m = 0; m < 4; ++m) { const int rl = rl0 + ai * HALF + m * 16;
#pragma unroll
                    for (int bj = 0; bj < 2; ++bj) { f32x4 a = acc[ai][bj][m][0], b = acc[ai][bj][m][1];
                        if (kind == 2) {
#pragma unroll
                            for (int e = 0; e < 4; ++e) { a[e] = __builtin_amdgcn_rcpf(1.0f + __expf(-a[e])); b[e] = __builtin_amdgcn_rcpf(1.0f + __expf(-b[e])); } }
                        u32x4 w; w.x = cvt_pk_bf16(a[0], a[1]); w.y = cvt_pk_bf16(a[2], a[3]); w.z = cvt_pk_bf16(b[0], b[1]); w.w = cvt_pk_bf16(b[2], b[3]);
                        *(u32x4*)(dst + (grow0 + rl) * dld + bj * HALF + c0) = w;
                        if (fo) { float* fp = fo + (frow0 + rl) * fld + bj * HALF + c0; *(f32x4*)fp = a; *(f32x4*)(fp + 4) = b; } } }
            return;
        }
        const int db = 64 * (wc >> 1) + 16 * (wc & 1) + 4 * fq;
        if (norm) {
#pragma unroll
            for (int ai = 0; ai < 2; ++ai)
#pragma unroll
                for (int m = 0; m < 4; ++m)
#pragma unroll
                    for (int bj = 0; bj < 2; ++bj) { const f32x4 a = acc[ai][bj][m][0], b = acc[ai][bj][m][1];
                        float ss = (a[0] * a[0] + a[1] * a[1]) + (a[2] * a[2] + a[3] * a[3]) + (b[0] * b[0] + b[1] * b[1]) + (b[2] * b[2] + b[3] * b[3]);
                        ss += shx(ss, 16, 16 * fq + fr); ss += shx(ss, 32, 16 * fq + fr);
                        if (fq == 0) P[((rl0 + ai * HALF + m * 16) * 2 + bj) * 4 + wc] = ss; }
            asm volatile("s_waitcnt lgkmcnt(0)" ::: "memory"); __builtin_amdgcn_s_barrier(); asm volatile("" ::: "memory");
        }
        f32x4 g0 = {1.f, 1.f, 1.f, 1.f}, g1 = g0;
        if (norm) { const float* gg = norm == 1 ? gq : gk; g0 = *(const f32x4*)(gg + db); g1 = *(const f32x4*)(gg + db + 32); }
        const int fi = 16 * (wc & 1) + 4 * fq;
#pragma unroll
        for (int ai = 0; ai < 2; ++ai) { f32x4 csv[4], snv[4];
#pragma unroll
            for (int m = 0; m < 4; ++m) { csv[m] = (f32x4){1.f, 1.f, 1.f, 1.f}; snv[m] = (f32x4){0.f, 0.f, 0.f, 0.f};
                if (!isctx) { const int nl = (int)((grow0 + rl0 + ai * HALF + m * 16 - 4096) & 4095); const int pos = (wc >> 1) ? (nl & 63) : (nl >> 6);
                    csv[m] = *(const f32x4*)(ropec + pos * 32 + fi); snv[m] = *(const f32x4*)(ropec + 2048 + pos * 32 + fi); } }
#pragma unroll
            for (int m = 0; m < 4; ++m) { const int rl = rl0 + ai * HALF + m * 16;
                const f32x4 cs = csv[m], sn = snv[m];
#pragma unroll
                for (int bj = 0; bj < 2; ++bj) { f32x4 a = acc[ai][bj][m][0], b = acc[ai][bj][m][1];
                    if (norm) { const f32x4 pp = *(const PG8_LAS f32x4*)(P + (rl * 2 + bj) * 4); const float rstd = 1.0f / sqrtf(((pp[0] + pp[1]) + (pp[2] + pp[3])) * (1.0f / 128.0f) + 1e-6f);
                        a = a * rstd * g0; b = b * rstd * g1; }
                    const f32x4 y1 = a * cs - b * sn, y2 = b * cs + a * sn;
                    bf16_t* dp = dst + (grow0 + rl) * dld + bj * HALF + db;
                    *(unsigned long long*)dp = (unsigned long long)cvt_pk_bf16(y1[0], y1[1]) | ((unsigned long long)cvt_pk_bf16(y1[2], y1[3]) << 32);
                    *(unsigned long long*)(dp + 32) = (unsigned long long)cvt_pk_bf16(y2[0], y2[1]) | ((unsigned long long)cvt_pk_bf16(y2[2], y2[3]) << 32);
                    if (fo) { float* fp = fo + (frow0 + rl) * fld + bj * HALF + db; *(f32x4*)fp = y1; *(f32x4*)(fp + 32) = y2; } } } }
    }
};
struct EpiF32 {
    static constexpr bool PERM = false, AFTER_DRAIN = false, CHAIN = false;
    float* C; int ldc;
    __device__ __forceinline__ void operator()(const f32x4 (&acc)[2][2][4][2], const Unit& u, int wr, int wc, int fr, int fq) const {
        { int ln_; asm volatile("v_mbcnt_lo_u32_b32 %0, -1, 0\n\tv_mbcnt_hi_u32_b32 %0, -1, %0" : "=v"(ln_)); fr = ln_ & 15; fq = ln_ >> 4; }
        const int row0 = u.pm * BM + wr * 64 + fr, col0 = u.pn * BM + wc * 32 + 4 * fq;
#pragma unroll
        for (int ai = 0; ai < 2; ++ai)
#pragma unroll
            for (int m = 0; m < 4; ++m) { float* rowp = C + (size_t)(row0 + ai * HALF + m * 16) * ldc + col0;
#pragma unroll
                for (int bj = 0; bj < 2; ++bj)
#pragma unroll
                    for (int n = 0; n < 2; ++n) *(f32x4*)(rowp + bj * HALF + n * 16) = acc[ai][bj][m][n]; }
    }
};
struct BranchOrder {
    int G, c;
    __device__ __forceinline__ bool next(int i, Unit& u) const { const int j = i / 3, br = i - 3 * j; const int tile = j * G + c; if (tile >= 384) return false;
        u.pm = br * 48 + (tile >> 3); u.pn = br * 8 + (tile & 7); return true; }
    __device__ __forceinline__ void a_ready(const Unit&) const {}
    __device__ __forceinline__ void done(const Unit&) const {}
};
struct EpiBranchF32 {
    static constexpr bool PERM = false, AFTER_DRAIN = false, CHAIN = false;
    float* Y3;
    __device__ __forceinline__ void operator()(const f32x4 (&acc)[2][2][4][2], const Unit& u, int wr, int wc, int fr, int fq) const {
        { int ln_; asm volatile("v_mbcnt_lo_u32_b32 %0, -1, 0\n\tv_mbcnt_hi_u32_b32 %0, -1, %0" : "=v"(ln_)); fr = ln_ & 15; fq = ln_ >> 4; }
        const int br = u.pm / 48, pm = u.pm - 48 * br, pn = u.pn & 7;
        const int row0 = pm * BM + wr * 64 + fr, col0 = pn * BM + wc * 32 + 4 * fq; float* base = Y3 + (size_t)br * 12288 * 2048;
#pragma unroll
        for (int ai = 0; ai < 2; ++ai)
#pragma unroll
            for (int m = 0; m < 4; ++m) { float* rowp = base + (size_t)(row0 + ai * HALF + m * 16) * 2048 + col0;
#pragma unroll
                for (int bj = 0; bj < 2; ++bj)
#pragma unroll
                    for (int n = 0; n < 2; ++n) *(f32x4*)(rowp + bj * HALF + n * 16) = acc[ai][bj][m][n]; }
    }
};
}

__global__ void __launch_bounds__(NTHR, 2) mega_fwd(Args args) {
    extern __shared__ __attribute__((aligned(16))) unsigned char lds[];
    Frame F;
    F.lds = (LAS unsigned char*)lds; F.tid = threadIdx.x; F.lane = F.tid & 63; F.wave = __builtin_amdgcn_readfirstlane(F.tid >> 6); F.G = gridDim.x; F.bid = blockIdx.x;
    F.out = (float*)in_ptr(25); F.ws = (unsigned char*)in_ptr(26);
    for (int u = F.tid; u < (LDS_BYTES - LDSCTL_OFF) / 4; u += NTHR) ((LAS unsigned*)(F.lds + LDSCTL_OFF))[u] = 0u;
    __syncthreads();
    volatile LAS unsigned* MISC = (volatile LAS unsigned*)(F.lds + MISC_OFF);
    XcdBarrier bar = xcd_barrier_post((unsigned*)(F.ws + WS_CTL) + CW_BAR, MISC + 8, F.tid);
#define RELAUNDER() do { asm volatile("v_mbcnt_lo_u32_b32 %0, -1, 0\n\tv_mbcnt_hi_u32_b32 %0, -1, %0" : "=v"(F.lane)); \
    asm volatile("" : "+s"(F.wave), "+s"(F.bid), "+s"(F.G), "+s"(F.ws), "+s"(F.out), "+s"(bar.bar), "+s"(bar.x)); F.tid = F.wave * 64 + F.lane; } while (0)
#define GRID_BAR() do { RELAUNDER(); xcd_barrier(bar, F.tid); RELAUNDER(); } while (0)

    prologue(F); GRID_BAR();

    for (int l = 0; l < 2; ++l) {
        unsigned char* wl = F.ws + WS_W + (size_t)l * W_LAYER;
        const float* modl = (const float*)(F.ws + WS_MODS) + (size_t)l * 3 * 18432;
        adaln_phase(F, l, 0, l == 0); GRID_BAR();
        { pg8::Gemm g{(const bf16*)(F.ws + WS_H), (const bf16*)(wl + W_GU1), RT, NGU, DM}; pg8::StaticOrder S; S.init(RT, NGU, F.G, F.bid);
          pg8::EpiSwiglu E{(bf16*)(F.ws + WS_ACT)};
          pg8::gemm_phase<pg8::EpiSwiglu, pg8::StaticOrder, true, true>(F.lds, g, S, E, F.tid); }
        GRID_BAR();
        { pg8::Gemm g{(const bf16*)(F.ws + WS_ACT), (const bf16*)(wl + W_D1), RT, DM, FF}; pg8::StaticOrder S; S.init(RT, DM, F.G, F.bid);
          pg8::EpiResid E{F.out, l == 0 ? in_ptr(0) : F.out, l == 0 ? in_ptr(1) : F.out + (size_t)R_CTX * DM, modl + 2 * DM, 0.5f};
          pg8::gemm_phase<pg8::EpiResid, pg8::StaticOrder, true, true>(F.lds, g, S, E, F.tid); }
        GRID_BAR();
        adaln_phase(F, l, 1, false); GRID_BAR();
        { pg8::Gemm g{(const bf16*)(F.ws + WS_H), (const bf16*)(wl + W_IN), RT, DIN, DM}; pg8::StaticOrder S; S.init(RT, DIN, F.G, F.bid);
          pg8::EpiInproj E{F.ws + WS_QKVG, F.out, in_ptr(16) + l * HD, in_ptr(17) + l * HD, (const float*)(F.ws + WS_ROPE), l, (LAS float*)(F.lds + EXCH_OFF)};
          pg8::gemm_phase<pg8::EpiInproj, pg8::StaticOrder, true, true>(F.lds, g, S, E, F.tid); }
        GRID_BAR();
        attn_phase(F, l, (char*)lds); GRID_BAR();
        { pg8::Gemm g{(const bf16*)(F.ws + WS_ACT)  , (const bf16*)(wl + W_B), 3 * RT, 3 * DM, 1024}; pg8::BranchOrder S{F.G, F.bid};
          pg8::EpiBranch E{(bf16*)(F.ws + WS_H), (const bf16*)(F.ws + WS_QKVG + 144 * MiB)};
          pg8::gemm_phase<pg8::EpiBranch, pg8::BranchOrder, true, true>(F.lds, g, S, E, F.tid); }
        GRID_BAR();
        { pg8::Gemm g{(const bf16*)(F.ws + WS_H)  , (const bf16*)(wl + W_O), RT, DM, DM}; pg8::StaticOrder S; S.init(RT, DM, F.G, F.bid);
          pg8::EpiResid E{F.out, F.out, F.out + (size_t)R_CTX * DM, modl + 5 * DM, 1.0f};
          pg8::gemm_phase<pg8::EpiResid, pg8::StaticOrder, true, true>(F.lds, g, S, E, F.tid); }
        GRID_BAR();
        adaln_phase(F, l, 2, false); GRID_BAR();
        { pg8::Gemm g{(const bf16*)(F.ws + WS_H), (const bf16*)(wl + W_GU2), RT, NGU, DM}; pg8::StaticOrder S; S.init(RT, NGU, F.G, F.bid);
          pg8::EpiSwiglu E{(bf16*)(F.ws + WS_ACT)};
          pg8::gemm_phase<pg8::EpiSwiglu, pg8::StaticOrder, true, true>(F.lds, g, S, E, F.tid); }
        GRID_BAR();
        { pg8::Gemm g{(const bf16*)(F.ws + WS_ACT), (const bf16*)(wl + W_D2), RT, DM, FF}; pg8::StaticOrder S; S.init(RT, DM, F.G, F.bid);
          pg8::EpiResid E{F.out, F.out, F.out + (size_t)R_CTX * DM, modl + 8 * DM, 0.5f};
          pg8::gemm_phase<pg8::EpiResid, pg8::StaticOrder, true, true>(F.lds, g, S, E, F.tid); }
        GRID_BAR();
    }
    final_phase(F);
#undef GRID_BAR
}

extern "C" void kernel_launch(void* const* d_in, const int* in_sizes, int n_in, void* d_out, int out_size, void* d_ws, size_t ws_size, hipStream_t stream) {
    static int grid = 0;
    if (grid == 0) {
        if (n_in != 25 || out_size != (int)OUT_TOTAL || ws_size < WS_END) { fprintf(stderr, "kernel_launch: unexpected shapes: n_in %d out %d ws %zu (need %zu)\n", n_in, out_size, ws_size, (size_t)WS_END); grid = -1; return; }
        int dev = 0, cus = 0, per_cu = 0;
        if (hipGetDevice(&dev) != hipSuccess || hipDeviceGetAttribute(&cus, hipDeviceAttributeMultiprocessorCount, dev) != hipSuccess) { grid = -1; return; }
        if (hipFuncSetAttribute((const void*)mega_fwd, hipFuncAttributeMaxDynamicSharedMemorySize, LDS_BYTES) != hipSuccess) { fprintf(stderr, "kernel_launch: hipFuncSetAttribute failed\n"); grid = -1; return; }
        if (hipOccupancyMaxActiveBlocksPerMultiprocessor(&per_cu, (const void*)mega_fwd, NTHR, LDS_BYTES) != hipSuccess || per_cu < 1) { fprintf(stderr, "kernel_launch: occupancy query says %d\n", per_cu); (void)hipGetLastError(); grid = -1; return; }
        grid = cus;
    }
    if (grid < 0) return;
    if (hipMemsetAsync((char*)d_ws + WS_CTL, 0, CTL_ZERO_BYTES, stream) != hipSuccess) return;
    Args a{};
    for (int i = 0; i < 25; ++i) a.in[i] = (const float*)d_in[i];
    a.out = (float*)d_out; a.ws = (unsigned char*)d_ws;
    hipLaunchKernelGGL(mega_fwd, dim3(grid), dim3(NTHR), LDS_BYTES, stream, a);
}
```

```cpp
#include <hip/hip_runtime.h>
#include <cstdio>
#include <cstdint>
namespace pg8 {
#define PG8_LAS __attribute__((address_space(3)))
typedef unsigned short bf16_t;
typedef short bf16x8 __attribute__((ext_vector_type(8)));
typedef float f32x4 __attribute__((ext_vector_type(4)));
typedef unsigned u32x4 __attribute__((ext_vector_type(4)));
constexpr int BM = 256, BK = 64, HALF = 128, HTB = HALF * BK * 2  , STAGE_BYTES = 8 * HTB, NXCD = 8, WGM = 8;

__host__ __device__ __forceinline__ int lds_byte(int r, int c) { const int st = (r >> 4) * 2 + (c >> 5), rr = r & 15, cc = c & 31, ob = rr * 64 + cc * 2; return st * 1024 + (ob ^ (((ob >> 9) & 1) << 5)); }
__host__ __device__ __forceinline__ void stage_rc(int b, int& R, int& C) { const int st = b / 1024, sb = b % 1024, swz = sb ^ (((sb >> 9) & 1) << 5); R = (st >> 1) * 16 + swz / 64; C = (st & 1) * 32 + (swz % 64) / 2; }
__host__ __device__ __forceinline__ int perm32(int rho) { const int n = rho >> 4, i = rho & 15; return 8 * (i >> 2) + 4 * n + (i & 3); }

struct Unit { int pm, pn; };
struct Gemm { const bf16_t* A; const bf16_t* Bt; int M, N, K; };

struct StaticOrder {
    int nM, nN, nwg, G, c;
    __host__ __device__ void init(int M, int N, int G_, int c_) { nM = M / BM; nN = N / BM; nwg = nM * nN; G = G_; c = c_; }
    __host__ __device__ bool next(int i, Unit& u) const {
        const long L = (long)i * G + c; if (L >= nwg) return false;
        int wgid = (int)L; { const int q = nwg / NXCD, r = nwg % NXCD, xcd = wgid % NXCD, off = wgid / NXCD; wgid = (xcd < r ? xcd * (q + 1) : r * (q + 1) + (xcd - r) * q) + off; }
        const int nig = WGM * nN, gid = wgid / nig, fm = gid * WGM, gsz = (nM - fm) < WGM ? (nM - fm) : WGM;
        u.pm = fm + ((wgid % nig) % gsz); u.pn = (wgid % nig) / gsz; return true;
    }
    __device__ __forceinline__ void a_ready(const Unit&) const {}
    __device__ __forceinline__ void done(const Unit&) const {}
};

__device__ __forceinline__ unsigned cvt_pk_bf16(float lo, float hi) { unsigned r; asm volatile("v_cvt_pk_bf16_f32 %0, %1, %2" : "=v"(r) : "v"(lo), "v"(hi)); return r; }
typedef float f32x2 __attribute__((ext_vector_type(2)));
__device__ __forceinline__ f32x2 gelu_pk(f32x2 v) {
    const f32x2 av = __builtin_elementwise_abs(v), d = av * 0.2316418882f + 1.0f;
    f32x2 t; t.x = __builtin_amdgcn_rcpf(d.x); t.y = __builtin_amdgcn_rcpf(d.y);
    f32x2 q = t * 0.5307027145f + (-0.7265760135f); q = q * t + 0.7107068705f; q = q * t + (-0.142248368f); q = q * t + 0.127414796f; q = q * t;
    const f32x2 s = (v * v) * (-0.72134752044f);
    f32x2 e; e.x = __builtin_amdgcn_exp2f(s.x); e.y = __builtin_amdgcn_exp2f(s.y);
    const f32x2 m = v * (q * e), r = v - m;
    f32x2 o; o.x = v.x < 0.f ? m.x : r.x; o.y = v.y < 0.f ? m.y : r.y; return o;
}

template <int ACT  > struct EpiBf16 {
    static constexpr bool PERM = true, AFTER_DRAIN = false, CHAIN = false; static_assert(ACT == 0 || ACT == 1, "EpiBf16: ACT is 0 (none) or 1 (gelu_pk)");
    bf16_t* O; int ldc; const float* bias; int split_cols; size_t split_stride; float scale0;
    __device__ __forceinline__ void operator()(const f32x4 (&acc)[2][2][4][2], const Unit& u, int wr, int wc, int fr, int fq) const {
        const int row0 = u.pm * BM + wr * 64 + fr; int colt = u.pn * BM; bf16_t* base = O;
        float sc = 1.f; if (split_cols) { const int t = colt / split_cols; base += (size_t)t * split_stride; colt -= t * split_cols; if (t == 0) sc = scale0; }
        const int col0 = colt + wc * 32 + 8 * fq, bcol0 = u.pn * BM + wc * 32 + 8 * fq;
        f32x4 bv[2][2];
#pragma unroll
        for (int bj = 0; bj < 2; ++bj)
#pragma unroll
            for (int n = 0; n < 2; ++n) bv[bj][n] = bias ? *(const f32x4*)(bias + bcol0 + bj * HALF + 4 * n) : (f32x4){0.f, 0.f, 0.f, 0.f};
#pragma unroll
        for (int ai = 0; ai < 2; ++ai)
#pragma unroll
            for (int m = 0; m < 4; ++m) { bf16_t* rowp = base + (size_t)(row0 + ai * HALF + m * 16) * ldc + col0;
#pragma unroll
                for (int bj = 0; bj < 2; ++bj) { f32x4 v0 = acc[ai][bj][m][0] + bv[bj][0], v1 = acc[ai][bj][m][1] + bv[bj][1];
                    if (ACT == 1) { f32x2 a = gelu_pk((f32x2){v0[0], v0[1]}), b = gelu_pk((f32x2){v0[2], v0[3]}), c = gelu_pk((f32x2){v1[0], v1[1]}), d = gelu_pk((f32x2){v1[2], v1[3]});
                        v0 = (f32x4){a.x, a.y, b.x, b.y}; v1 = (f32x4){c.x, c.y, d.x, d.y}; }
                    v0 = v0 * sc; v1 = v1 * sc; u32x4 w; w.x = cvt_pk_bf16(v0[0], v0[1]); w.y = cvt_pk_bf16(v0[2], v0[3]); w.z = cvt_pk_bf16(v1[0], v1[1]); w.w = cvt_pk_bf16(v1[2], v1[3]);
                    *(u32x4*)(rowp + bj * HALF) = w; } }
    }
};

template <class Epi, class Sched, bool ALIGN_EPI = false, bool SP2 = false>
__device__ __forceinline__ void gemm_phase(PG8_LAS unsigned char* lds, const Gemm g, const Sched& S, const Epi& E, const int tid_in) {
    int tid_l = tid_in; asm volatile("" : "+v"(tid_l));
    const int tid = tid_l, wid = __builtin_amdgcn_readfirstlane(tid >> 6), lane = tid & 63, wr = wid >> 2, wc = wid & 3, fr = lane & 15, fq = lane >> 4;
    const int K = g.K, nt = K / BK;
    unsigned voffA[2], voffB[2];
#pragma unroll
    for (int i = 0; i < 2; ++i) { int R, C; stage_rc(tid * 16 + i * 8192, R, C); const int Rb = Epi::PERM ? ((R & ~31) + perm32(R & 31)) : R;
        voffA[i] = (unsigned)(R * K + C) * 2u; voffB[i] = (unsigned)(Rb * K + C) * 2u; }
    const size_t kstep = (size_t)(BK * 2);
    const size_t hstep = (size_t)HALF * K * 2;
    const size_t tstep = 2 * hstep;
    const unsigned ldsw = (unsigned)wid * 1024u;
    const int aoff = lds_byte(wr * 64 + fr, fq * 8), boff = lds_byte(wc * 32 + fr, fq * 8);
#define PG8_SA(b, h) (((b) * 2 + (h)) * HTB)
#define PG8_SB(b, h) ((4 + (b) * 2 + (h)) * HTB)
#define PG8_STAGE(bufoff, gbase, voff) do { _Pragma("unroll") for (int _i = 0; _i < 2; ++_i) \
        __builtin_amdgcn_global_load_lds((const unsigned*)((const char*)(gbase) + (voff)[_i]), (PG8_LAS unsigned*)(lds + (bufoff) + ldsw + _i * 8192), 16, 0, 0); } while (0)
#define PG8_LDA(dst, b, h) do { _Pragma("unroll") for (int m = 0; m < 4; ++m) _Pragma("unroll") for (int k = 0; k < 2; ++k) dst[m][k] = *(const PG8_LAS bf16x8*)(lds + PG8_SA(b, h) + aoff + m * 2048 + k * 1024); } while (0)
#define PG8_LDB(dst, b, h) do { _Pragma("unroll") for (int n = 0; n < 2; ++n) _Pragma("unroll") for (int k = 0; k < 2; ++k) dst[n][k] = *(const PG8_LAS bf16x8*)(lds + PG8_SB(b, h) + boff + n * 2048 + k * 1024); } while (0)
#define PG8_MMA(ai, bj, At, Bt) do { __builtin_amdgcn_s_setprio(1); _Pragma("unroll") for (int m = 0; m < 4; ++m) _Pragma("unroll") for (int n = 0; n < 2; ++n) _Pragma("unroll") for (int k = 0; k < 2; ++k) \
        acc[ai][bj][m][n] = __builtin_amdgcn_mfma_f32_16x16x32_bf16(Bt[n][k], At[m][k], acc[ai][bj][m][n], 0, 0, 0); __builtin_amdgcn_s_setprio(0); } while (0)
#define PG8_WAIT_V(n) asm volatile("s_waitcnt vmcnt(" #n ")" ::: "memory")
#define PG8_WAIT_L(n) asm volatile("s_waitcnt lgkmcnt(" #n ")" ::: "memory")
#define PG8_BAR __builtin_amdgcn_s_barrier()
#define PG8_SCHED __builtin_amdgcn_sched_barrier(0)
    Unit cur, nxt; int ui = 0;
    if (!S.next(0, cur)) return;
    f32x4 acc[2][2][4][2];
#pragma unroll
    for (int a = 0; a < 2; ++a)
#pragma unroll
        for (int b = 0; b < 2; ++b)
#pragma unroll
            for (int m = 0; m < 4; ++m)
#pragma unroll
                for (int n = 0; n < 2; ++n) acc[a][b][m][n] = (f32x4){0.f, 0.f, 0.f, 0.f};
    bf16x8 At[4][2], B0[2][2], B1[2][2];
    const char* cA = (const char*)g.A + (size_t)cur.pm * tstep; const char* cB = (const char*)g.Bt + (size_t)cur.pn * tstep;
    S.a_ready(cur);
    if constexpr (SP2) {
        PG8_STAGE(PG8_SB(0, 0), cB, voffB); PG8_STAGE(PG8_SB(0, 1), cB + hstep, voffB); PG8_STAGE(PG8_SA(0, 0), cA, voffA); PG8_STAGE(PG8_SA(0, 1), cA + hstep, voffA);
        if (wr == 1) PG8_BAR;
        PG8_WAIT_V(2); PG8_BAR;
        PG8_STAGE(PG8_SB(1, 0), cB + kstep, voffB); PG8_STAGE(PG8_SA(1, 0), cA + kstep, voffA); PG8_STAGE(PG8_SB(1, 1), cB + hstep + kstep, voffB);
        PG8_WAIT_V(6); PG8_BAR;
    } else {
        PG8_STAGE(PG8_SB(0, 0), cB, voffB); PG8_STAGE(PG8_SA(0, 0), cA, voffA); PG8_STAGE(PG8_SB(0, 1), cB + hstep, voffB); PG8_STAGE(PG8_SA(0, 1), cA + hstep, voffA);
        if (wr == 1) PG8_BAR;
        PG8_WAIT_V(4); PG8_BAR;
        PG8_STAGE(PG8_SB(1, 0), cB + kstep, voffB); PG8_STAGE(PG8_SA(1, 0), cA + kstep, voffA); PG8_STAGE(PG8_SB(1, 1), cB + hstep + kstep, voffB);
        PG8_WAIT_V(6); PG8_BAR;
    }
    for (;;) {
        const bool has_next = S.next(ui + 1, nxt);
        const char* nA = has_next ? (const char*)g.A + (size_t)nxt.pm * tstep : cA; const char* nB = has_next ? (const char*)g.Bt + (size_t)nxt.pn * tstep : cB;
        for (int t = 0; t < nt; t += 2) {
            const bool last = (t == nt - 2);
            const char* a1 = cA + (size_t)(t + 1) * kstep;
            const char* a2 = last ? nA : cA + (size_t)(t + 2) * kstep; const char* b2 = last ? nB : cB + (size_t)(t + 2) * kstep;
            const char* a3 = a2 + kstep; const char* b3 = b2 + kstep;
            if (last && has_next) S.a_ready(nxt);
            if constexpr (SP2) {
            PG8_LDB(B0, 0, 0); PG8_LDB(B1, 0, 1); PG8_SCHED; PG8_LDA(At, 0, 0); PG8_STAGE(PG8_SA(1, 1), a1 + hstep, voffA);
            PG8_WAIT_V(8); PG8_WAIT_L(0); PG8_BAR; PG8_MMA(0, 0, At, B0); PG8_MMA(0, 1, At, B1); PG8_BAR; PG8_SCHED;
            PG8_LDA(At, 0, 1); PG8_STAGE(PG8_SB(0, 0), b2, voffB); PG8_STAGE(PG8_SB(0, 1), b2 + hstep, voffB); PG8_STAGE(PG8_SA(0, 0), a2, voffA);
            PG8_WAIT_V(8); PG8_WAIT_L(0); PG8_BAR; PG8_MMA(1, 0, At, B0); PG8_MMA(1, 1, At, B1); PG8_BAR; PG8_SCHED;
            PG8_LDB(B0, 1, 0); PG8_LDB(B1, 1, 1); PG8_SCHED; PG8_LDA(At, 1, 0); PG8_STAGE(PG8_SA(0, 1), a2 + hstep, voffA);
            PG8_WAIT_V(8); PG8_WAIT_L(0); PG8_BAR; PG8_MMA(0, 0, At, B0); PG8_MMA(0, 1, At, B1); PG8_BAR; PG8_SCHED;
            PG8_LDA(At, 1, 1); PG8_STAGE(PG8_SB(1, 0), b3, voffB); PG8_STAGE(PG8_SB(1, 1), b3 + hstep, voffB); PG8_STAGE(PG8_SA(1, 0), a3, voffA);
            PG8_WAIT_V(8); PG8_WAIT_L(0); PG8_BAR; PG8_MMA(1, 0, At, B0); PG8_MMA(1, 1, At, B1); PG8_BAR; PG8_SCHED;
            } else {
            PG8_LDB(B0, 0, 0); PG8_SCHED; PG8_LDA(At, 0, 0); PG8_STAGE(PG8_SA(1, 1), a1 + hstep, voffA);
            PG8_WAIT_L(8); PG8_BAR; PG8_WAIT_L(0); PG8_MMA(0, 0, At, B0); PG8_BAR; PG8_SCHED;
            PG8_LDB(B1, 0, 1); PG8_STAGE(PG8_SB(0, 0), b2, voffB);
            PG8_BAR; PG8_WAIT_L(0); PG8_MMA(0, 1, At, B1); PG8_BAR;
            PG8_LDA(At, 0, 1); PG8_STAGE(PG8_SA(0, 0), a2, voffA);
            PG8_BAR; PG8_WAIT_L(0); PG8_MMA(1, 0, At, B0); PG8_BAR; PG8_SCHED;
            PG8_STAGE(PG8_SB(0, 1), b2 + hstep, voffB);
            PG8_WAIT_V(6); PG8_BAR; PG8_MMA(1, 1, At, B1); PG8_BAR;
            PG8_LDB(B0, 1, 0); PG8_SCHED; PG8_LDA(At, 1, 0); PG8_STAGE(PG8_SA(0, 1), a2 + hstep, voffA);
            PG8_WAIT_L(8); PG8_BAR; PG8_WAIT_L(0); PG8_MMA(0, 0, At, B0); PG8_BAR; PG8_SCHED;
            PG8_LDB(B1, 1, 1); PG8_STAGE(PG8_SB(1, 0), b3, voffB);
            PG8_BAR; PG8_WAIT_L(0); PG8_MMA(0, 1, At, B1); PG8_BAR;
            PG8_LDA(At, 1, 1); PG8_STAGE(PG8_SA(1, 0), a3, voffA);
            PG8_BAR; PG8_WAIT_L(0); PG8_MMA(1, 0, At, B0); PG8_BAR; PG8_SCHED;
            PG8_STAGE(PG8_SB(1, 1), b3 + hstep, voffB);
            PG8_WAIT_V(6); PG8_BAR; PG8_MMA(1, 1, At, B1); PG8_BAR;
            }
        }
        if constexpr (ALIGN_EPI) { if (wr == 0) PG8_BAR; }
        if constexpr (!Epi::AFTER_DRAIN) { E(acc, cur, wr, wc, fr, fq); S.done(cur); }
        if (!has_next) break;
        if constexpr (!Epi::CHAIN) {
#pragma unroll
        for (int a = 0; a < 2; ++a)
#pragma unroll
            for (int b = 0; b < 2; ++b)
#pragma unroll
                for (int m = 0; m < 4; ++m)
#pragma unroll
                    for (int n = 0; n < 2; ++n) acc[a][b][m][n] = (f32x4){0.f, 0.f, 0.f, 0.f};
        }
        cur = nxt; cA = nA; cB = nB; ++ui;
        if constexpr (ALIGN_EPI) { if (wr == 1) PG8_BAR; }
    }
    PG8_WAIT_V(0);
    if constexpr (!ALIGN_EPI) { if (wr == 0) PG8_BAR; }
    PG8_BAR;
    if constexpr (Epi::AFTER_DRAIN) { E.fused(acc, cur, wr, wc, fr, fq, lds, wid, lane); S.done(cur); }
#undef PG8_SA
#undef PG8_SB
#undef PG8_STAGE
#undef PG8_LDA
#undef PG8_LDB
#undef PG8_MMA
#undef PG8_WAIT_V
#undef PG8_WAIT_L
#undef PG8_BAR
#undef PG8_SCHED
}
}
#define GAS __attribute__((address_space(1)))
#define LAS __attribute__((address_space(3)))
typedef unsigned short bf16;
typedef unsigned v4u __attribute__((ext_vector_type(4)));
typedef float f32x4 __attribute__((ext_vector_type(4)));
typedef short bf16x8 __attribute__((ext_vector_type(8)));
typedef GAS unsigned gu32;
typedef GAS unsigned long long gu64;
#define RLX_AGENT __ATOMIC_RELAXED, __HIP_MEMORY_SCOPE_AGENT
#define LDS_WAIT() asm volatile("s_waitcnt lgkmcnt(0)" ::: "memory")
#define VM_WAIT() asm volatile("s_waitcnt vmcnt(0)" ::: "memory")
__device__ __forceinline__ unsigned long long rt() { return __builtin_amdgcn_s_memrealtime(); }
__device__ __forceinline__ unsigned f2bf(float f) { unsigned u = __builtin_bit_cast(unsigned, f); return (u + 0x7fffu + ((u >> 16) & 1u)) >> 16; }
__device__ __forceinline__ unsigned pk2(float lo, float hi) { return f2bf(lo) | (f2bf(hi) << 16); }

#define XB_TMO      128
#define XB_XCNT(j)  (256  + 64 * (j))
#define XB_XSUB(j)  (1280 + 64 * (j))
#define XB_XGEN(j)  (2304 + 64 * (j))
#define XB_TOP      3328
#define XB_TOPGEN   3392
#define XCD_BAR_WORDS 3456
#define XB_SPIN_CAP (1u << 18)

__device__ __forceinline__ unsigned xb_ld(unsigned* p)              { return __hip_atomic_load(p, __ATOMIC_RELAXED, __HIP_MEMORY_SCOPE_AGENT); }
__device__ __forceinline__ unsigned xb_add(unsigned* p, unsigned v) { return __hip_atomic_fetch_add(p, v, __ATOMIC_RELAXED, __HIP_MEMORY_SCOPE_AGENT); }
__device__ __forceinline__ unsigned xb_xcc_id() { return (unsigned)__builtin_amdgcn_s_getreg((3 << 11) | 20) & 0xFu; }
#define XB_SPIN(cond, bar) do { unsigned _sp = 0; while (cond) { __builtin_amdgcn_s_sleep(1); \
    if ((++_sp & 255u) == 0u) { if (xb_ld(&(bar)[XB_TMO])) break; if (_sp > XB_SPIN_CAP) { atomicAdd(&(bar)[XB_TMO], 1u); break; } } } } while (0)

struct XcdBarrier {
    unsigned* bar; unsigned x;
    volatile LAS unsigned* st;
};

__device__ __forceinline__ XcdBarrier xcd_barrier_post(unsigned* bar, volatile LAS unsigned* st, const int tid) {
    XcdBarrier b; b.bar = bar; b.x = xb_xcc_id(); b.st = st;
    if (tid == 0) (void)xb_add(&bar[XB_XCNT(b.x)], 1u);
    return b;
}
__device__ __forceinline__ void xcd_barrier_complete(unsigned* bar, unsigned x, unsigned& nloc, unsigned& nx) {
    const unsigned G = gridDim.x * gridDim.y * gridDim.z;
    unsigned sum, cnt, mine, sp = 0u;
    for (;;) {
        sum = 0u; cnt = 0u; mine = 0u;
#pragma unroll
        for (unsigned j = 0; j < 16; ++j) { const unsigned c = xb_ld(&bar[XB_XCNT(j)]); sum += c; cnt += (c > 0u) ? 1u : 0u; mine = (j == x) ? c : mine; }
        if (sum == G) break;
        __builtin_amdgcn_s_sleep(1);
        if ((++sp & 255u) == 0u) { if (xb_ld(&bar[XB_TMO])) break; if (sp > XB_SPIN_CAP) { atomicAdd(&bar[XB_TMO], 1u); break; } }
    }
    nloc = mine > 0u ? mine : 1u; nx = cnt > 0u ? cnt : 1u;
}

__device__ __forceinline__ void xcd_barrier(const XcdBarrier& b, const int tid) {
    asm volatile("s_waitcnt vmcnt(0)" ::: "memory");
    __syncthreads();
    if (tid == 0) {
        unsigned* bar = b.bar;
        __builtin_amdgcn_s_waitcnt(0);
        unsigned nloc = b.st[0], nx = b.st[1];
        if (nloc == 0u) { xcd_barrier_complete(bar, b.x, nloc, nx); b.st[0] = nloc; b.st[1] = nx; }
        const unsigned old = xb_add(&bar[XB_XSUB(b.x)], 1u);
        const unsigned gen = old / nloc;
        if (old + 1u == (gen + 1u) * nloc) {
            __builtin_amdgcn_fence(__ATOMIC_RELEASE, "agent");
            asm volatile("s_waitcnt vmcnt(0)" ::: "memory");
            const unsigned og = xb_add(&bar[XB_TOP], 1u);
            const unsigned tg = og / nx;
            if (og + 1u == (tg + 1u) * nx) xb_add(&bar[XB_TOPGEN], 1u);
            else XB_SPIN(xb_ld(&bar[XB_TOPGEN]) == tg, bar);
            __builtin_amdgcn_fence(__ATOMIC_ACQUIRE, "agent");
            xb_add(&bar[XB_XGEN(b.x)], 1u);
            asm volatile("s_waitcnt vmcnt(0)" ::: "memory");
        } else {
            XB_SPIN(xb_ld(&bar[XB_XGEN(b.x)]) == gen, bar);
            __builtin_amdgcn_fence(__ATOMIC_ACQUIRE, "agent");
            asm volatile("s_waitcnt vmcnt(0)" ::: "memory");
        }
    }
    __syncthreads();
}
namespace att {
typedef __attribute__((ext_vector_type(8))) short bf16x8;
typedef __attribute__((ext_vector_type(4))) short s16x4;
typedef __attribute__((ext_vector_type(16))) float f32x16;
typedef __attribute__((ext_vector_type(4))) unsigned u32x4;
typedef unsigned short bf16;
constexpr int D = 128, NW = 8, QBLK = 32, KVBLK = 64, LDQ = 1024;
constexpr float SCALE = 0.088388347648318440f, THR = 8.f;
constexpr int SHM_V = KVBLK * D * 2, SHM_K = KVBLK * D * 2;
constexpr int WS_OFF = 2 * SHM_V + 2 * SHM_K, TAB_OFF = WS_OFF + NW * 64 * 4, ATT_LDS_BYTES = TAB_OFF + 2048;
#define KSWZ(row, colB) ((row) * 256 + ((colB) ^ (((row) & 7) << 4)))
#define SBAR() __builtin_amdgcn_sched_barrier(0)
__device__ __forceinline__ int crow(int r, int hi) { return (r & 3) + 8 * (r >> 2) + 4 * hi; }
__device__ __forceinline__ unsigned cvtpk(float lo, float hi) { unsigned r; asm volatile("v_cvt_pk_bf16_f32 %0, %1, %2" : "=v"(r) : "v"(lo), "v"(hi)); return r; }
__device__ __forceinline__ bf16x8 ld8(const bf16* p) { return *reinterpret_cast<const bf16x8*>(p); }

__device__ __forceinline__ void partialSM(f32x16& p0, f32x16& p1, float& m_reg, float& mn, float& alpha) {
  constexpr float C = SCALE * 1.4426950408889634f;
  float pmax = p0[0]; for (int r = 1; r < 16; ++r) pmax = fmaxf(pmax, p0[r]); for (int r = 0; r < 16; ++r) pmax = fmaxf(pmax, p1[r]);
  { auto rr = __builtin_amdgcn_permlane32_swap(__float_as_uint(pmax), __float_as_uint(pmax), false, false);
    pmax = fmaxf(__uint_as_float(rr[0]), __uint_as_float(rr[1])); }
  if (__builtin_expect(__all(pmax - m_reg <= THR / SCALE), 1)) { mn = m_reg; alpha = 1.f; }
  else { mn = fmaxf(m_reg, pmax); alpha = __builtin_amdgcn_exp2f((m_reg - mn) * C); m_reg = mn; }
  float mnC = -mn * C;
  for (int r = 0; r < 16; ++r) p0[r] = fmaf(p0[r], C, mnC); for (int r = 0; r < 16; ++r) p1[r] = fmaf(p1[r], C, mnC);
  for (int r = 0; r < 16; ++r) p0[r] = __builtin_amdgcn_exp2f(p0[r]);
}
__device__ __forceinline__ void finishSM(f32x16& p0, f32x16& p1, float alpha, float& l_reg, bf16x8& pa0, bf16x8& pa1, bf16x8& pa2, bf16x8& pa3) {
  for (int r = 0; r < 16; ++r) p1[r] = __builtin_amdgcn_exp2f(p1[r]);
  float ps = 0; for (int r = 0; r < 16; ++r) ps += p0[r]; for (int r = 0; r < 16; ++r) ps += p1[r];
  { auto rr = __builtin_amdgcn_permlane32_swap(__float_as_uint(ps), __float_as_uint(ps), false, false);
    ps = __uint_as_float(rr[0]) + __uint_as_float(rr[1]); }
  l_reg = l_reg * alpha + ps;
#define PK4(P, BASE, OUT) do { unsigned a0 = cvtpk(P[BASE + 0], P[BASE + 1]), a1 = cvtpk(P[BASE + 2], P[BASE + 3]);   \
    unsigned b0 = cvtpk(P[BASE + 4], P[BASE + 5]), b1 = cvtpk(P[BASE + 6], P[BASE + 7]);                              \
    auto r0 = __builtin_amdgcn_permlane32_swap(a0, b0, false, false); auto r1 = __builtin_amdgcn_permlane32_swap(a1, b1, false, false); \
    u32x4 w = {r0[0], r1[0], r0[1], r1[1]}; OUT = *reinterpret_cast<bf16x8*>(&w); } while (0)
  PK4(p0, 0, pa0); PK4(p0, 8, pa1); PK4(p1, 0, pa2); PK4(p1, 8, pa3);
#undef PK4
}
__device__ __forceinline__ void qkt(f32x16& p0, f32x16& p1, const bf16* Ks, const bf16x8* qr, int r32, int hi) {
  p0 = f32x16{}; p1 = f32x16{};
  const char* kb[4];
#pragma unroll
  for (int dd = 0; dd < 4; ++dd) kb[dd] = (const char*)Ks + KSWZ(r32, (dd * 16 + hi * 8) * 2);
#pragma unroll
  for (int d0 = 0; d0 < 8; ++d0) { const char* a = kb[d0 & 3] + (d0 >> 2) * 128;
    bf16x8 b0 = *reinterpret_cast<const bf16x8*>(a);
    bf16x8 b1 = *reinterpret_cast<const bf16x8*>(a + 32 * 256);
    p0 = __builtin_amdgcn_mfma_f32_32x32x16_bf16(b0, qr[d0], p0, 0, 0, 0);
    p1 = __builtin_amdgcn_mfma_f32_32x32x16_bf16(b1, qr[d0], p1, 0, 0, 0); }
}
__device__ __forceinline__ int v_st(int k, int c) { const int kk = (k & ~0xC) | ((k & 4) << 1) | ((k & 8) >> 1); return ((kk >> 3) * 4 + (c >> 5)) * 512 + ((kk & 7) * 32 + (c & 31)) * 2; }
__device__ __forceinline__ int v_rd_base(int lane) { return ((lane & 3) << 3) | (((lane >> 2) & 3) << 6) | (((lane >> 4) & 1) << 5) | (((lane >> 5) & 1) << 8); }
constexpr int v_rd_off(int d0, int ks, int half) { return d0 * 512 + ks * 4096 + half * 2048; }
template <int OFF> __device__ __forceinline__ s16x4 tr_read(int vb) {
  s16x4 r; asm volatile("ds_read_b64_tr_b16 %0, %1 offset:%2" : "=&v"(r) : "v"(vb), "i"(OFF) : "memory"); return r;
}
template <int D0> __device__ __forceinline__ void pv_one(f32x16& od, int vb, bf16x8 pa0, bf16x8 pa1, bf16x8 pa2, bf16x8 pa3) {
  const s16x4 l0 = tr_read<v_rd_off(D0, 0, 0)>(vb), h0 = tr_read<v_rd_off(D0, 0, 1)>(vb), l1 = tr_read<v_rd_off(D0, 1, 0)>(vb), h1 = tr_read<v_rd_off(D0, 1, 1)>(vb);
  const s16x4 l2 = tr_read<v_rd_off(D0, 2, 0)>(vb), h2 = tr_read<v_rd_off(D0, 2, 1)>(vb), l3 = tr_read<v_rd_off(D0, 3, 0)>(vb), h3 = tr_read<v_rd_off(D0, 3, 1)>(vb);
  asm volatile("s_waitcnt lgkmcnt(0)" ::: "memory"); SBAR();
#define PK(L, H) (bf16x8){L[0], L[1], L[2], L[3], H[0], H[1], H[2], H[3]}
  od = __builtin_amdgcn_mfma_f32_32x32x16_bf16(pa0, PK(l0, h0), od, 0, 0, 0);
  od = __builtin_amdgcn_mfma_f32_32x32x16_bf16(pa1, PK(l1, h1), od, 0, 0, 0);
  od = __builtin_amdgcn_mfma_f32_32x32x16_bf16(pa2, PK(l2, h2), od, 0, 0, 0);
  od = __builtin_amdgcn_mfma_f32_32x32x16_bf16(pa3, PK(l3, h3), od, 0, 0, 0);
#undef PK
}
__device__ __forceinline__ void pv_d0(f32x16* o, int vb, bf16x8 pa0, bf16x8 pa1, bf16x8 pa2, bf16x8 pa3) {
  pv_one<0>(o[0], vb, pa0, pa1, pa2, pa3); pv_one<1>(o[1], vb, pa0, pa1, pa2, pa3); pv_one<2>(o[2], vb, pa0, pa1, pa2, pa3); pv_one<3>(o[3], vb, pa0, pa1, pa2, pa3);
}

struct Unit {
  const bf16* Q; bf16* O;
  const bf16* K0; const bf16* V0;
  const bf16* K1; const bf16* V1;
  int n0, n1, ldk;
  int mode;
  int a, b;
  float sink2;
  const float* tab;
};
__device__ __forceinline__ void mask_nat(f32x16& p0, f32x16& p1, bool rowvis, int cs4, int cqb, const float* trow) {
  const float NEG = -__builtin_inff();
  if (!rowvis) {
#pragma unroll
    for (int r = 0; r < 16; ++r) { p0[r] = NEG; p1[r] = NEG; }
    return; }
#pragma unroll
  for (int r = 0; r < 16; ++r) { const int cc = (r & 3) + 8 * (r >> 2);
    { const int i0 = min(max(cc - cqb, 0), 30); const float bv = trow[i0]; p0[r] = ((unsigned)(cc - cs4) < 16u) ? p0[r] + bv : NEG; }
    { const int i1 = min(max(cc + 32 - cqb, 0), 30); const float bv = trow[i1]; p1[r] = ((unsigned)(cc + 32 - cs4) < 16u) ? p1[r] + bv : NEG; } }
}
__device__ __forceinline__ void mask_win(f32x16& p0, f32x16& p1, int dq) {
  const float NEG = -__builtin_inff();
#pragma unroll
  for (int r = 0; r < 16; ++r) { const int cc = (r & 3) + 8 * (r >> 2);
    if ((unsigned)(dq + cc) > 256u) p0[r] = NEG;
    if ((unsigned)(dq + cc + 32) > 256u) p1[r] = NEG; }
}

__device__ __forceinline__ void attn_unit(const Unit& U, char* lds, const int tid_in) {
  int tid_l = tid_in; asm volatile("" : "+v"(tid_l));
  const int tid = tid_l, wid = __builtin_amdgcn_readfirstlane(tid >> 6), lane = tid & 63, r32 = lane & 31, hi = lane >> 5;
  bf16* V_lds = (bf16*)lds; bf16* K_lds = (bf16*)(lds + 2 * SHM_V);
  float* ws = (float*)(lds + WS_OFF) + wid * 64; float* li_l = ws; float* al_l = ws + 32;
  float* tabL = (float*)(lds + TAB_OFF);
  if (U.mode == 1) { for (int i = tid; i < 465; i += 512) tabL[i] = U.tab[i] * (1.0f / SCALE); }
  float m_reg = -1e30f, l_reg = 0; f32x16 o[4] = {}; bf16x8 qr[8];
  const bf16* Qw = U.Q + (long)(wid * QBLK + r32) * LDQ + hi * 8;
#pragma unroll
  for (int d0 = 0; d0 < 8; ++d0) qr[d0] = ld8(Qw + d0 * 16);
  const int ldk = U.ldk, n0 = U.n0, NT = U.n0 + U.n1;
  const int sr = tid >> 4, sc = (tid & 15) * 8, vst0 = v_st(sr, sc), vst1 = v_st(32 + sr, sc);
  const int vb0 = (int)(uintptr_t)V_lds + v_rd_base(lane);
  struct { bf16x8 vs0, vs1, ks0, ks1; } sr_[1];
  const int maskA = U.a, maskB = U.b;
#define SLOAD(i, t) do { const int t_ = (t); const bf16* Kp_ = t_ < n0 ? U.K0 + (long)t_ * KVBLK * ldk : U.K1 + (long)(t_ - n0) * KVBLK * ldk;  \
    const bf16* Vp_ = t_ < n0 ? U.V0 + (long)t_ * KVBLK * ldk : U.V1 + (long)(t_ - n0) * KVBLK * ldk;                                         \
    sr_[i].vs0 = ld8(&Vp_[(long)sr * ldk + sc]); sr_[i].vs1 = ld8(&Vp_[(long)(32 + sr) * ldk + sc]);                                           \
    sr_[i].ks0 = ld8(&Kp_[(long)sr * ldk + sc]); sr_[i].ks1 = ld8(&Kp_[(long)(32 + sr) * ldk + sc]); } while (0)
#define SWRITE(b, i) do { *(bf16x8*)((char*)V_lds + (b) * SHM_V + vst0) = sr_[i].vs0;          \
    *(bf16x8*)((char*)V_lds + (b) * SHM_V + vst1) = sr_[i].vs1; int kc = sc * 2;               \
    *(bf16x8*)((char*)K_lds + (b) * SHM_K + KSWZ(sr, kc)) = sr_[i].ks0;                       \
    *(bf16x8*)((char*)K_lds + (b) * SHM_K + KSWZ(32 + sr, kc)) = sr_[i].ks1; } while (0)
#define SWAIT() asm volatile("s_waitcnt vmcnt(0)" ::: "memory")
#define RESC(a) do { if (__any((a) < 1.f)) { if (hi == 0) al_l[r32] = (a); asm volatile("s_waitcnt lgkmcnt(0)" ::: "memory"); \
    for (int d = 0; d < 4; ++d) for (int r = 0; r < 16; ++r) o[d][r] *= al_l[crow(r, hi)]; } } while (0)
#define MASK(P0, P1, t) do { if (U.mode != 0 && (t) >= n0) { const int tl_ = (t) - n0; int ln_ = lane; asm volatile("" : "+v"(ln_));     \
    const int r32_ = ln_ & 31, hi_ = ln_ >> 5;                                                                                                  \
    if (U.mode == 1) { const int rq_ = maskA + (wid >> 1), rsq_ = min(max(rq_ - 4, 0), 56), kr_ = maskB + tl_; const bool rv_ = (unsigned)(kr_ - rsq_) < 8u; const int dr_ = rv_ ? kr_ - rq_ + 7 : 0; \
        const int cq_ = 32 * (wid & 1) + r32_, cs_ = min(max(cq_ - 8, 0), 48);                                                                   \
        mask_nat(P0, P1, rv_, cs_ - 4 * hi_, cq_ - 15 - 4 * hi_, tabL + dr_ * 31); }                                                             \
    else { mask_win(P0, P1, maskB + tl_ * KVBLK - (maskA + 32 * wid + r32_) + 4 * hi_ + 128); } } } while (0)
  f32x16 pA0, pA1, pB0, pB1; float mnA, mnB, alA, alB; bf16x8 pa0, pa1, pa2, pa3;
  constexpr int SE = 0, SO = 0;
  SLOAD(SE, 0); asm volatile("s_waitcnt vmcnt(0)" ::: "memory"); SWRITE(0, SE); __syncthreads();
  qkt(pA0, pA1, K_lds, qr, r32, hi); MASK(pA0, pA1, 0); partialSM(pA0, pA1, m_reg, mnA, alA);
  SLOAD(SO, 1);
  SWAIT(); SWRITE(1, SO); __syncthreads();
  for (int j = 1; j + 1 < NT; j += 2) {
    SBAR(); SLOAD(SO, j + 1); SBAR();
    qkt(pB0, pB1, (bf16*)((char*)K_lds + SHM_K), qr, r32, hi);
    finishSM(pA0, pA1, alA, l_reg, pa0, pa1, pa2, pa3); SBAR();
    pv_d0(o, vb0, pa0, pa1, pa2, pa3); MASK(pB0, pB1, j); partialSM(pB0, pB1, m_reg, mnB, alB);
    __syncthreads(); SWAIT(); SWRITE(0, SE);
    RESC(alB); __syncthreads();
    SBAR(); SLOAD(SE, j + 2); SBAR();
    qkt(pA0, pA1, K_lds, qr, r32, hi);
    finishSM(pB0, pB1, alB, l_reg, pa0, pa1, pa2, pa3); SBAR();
    pv_d0(o, vb0 + (int)SHM_V, pa0, pa1, pa2, pa3); MASK(pA0, pA1, j + 1); partialSM(pA0, pA1, m_reg, mnA, alA);
    __syncthreads(); SWAIT(); SWRITE(1, SO);
    RESC(alA); __syncthreads();
  }
  SBAR(); qkt(pB0, pB1, (bf16*)((char*)K_lds + SHM_K), qr, r32, hi);
  finishSM(pA0, pA1, alA, l_reg, pa0, pa1, pa2, pa3); SBAR();
  pv_d0(o, vb0, pa0, pa1, pa2, pa3); MASK(pB0, pB1, NT - 1); partialSM(pB0, pB1, m_reg, mnB, alB);
  __syncthreads(); RESC(alB);
  finishSM(pB0, pB1, alB, l_reg, pa0, pa1, pa2, pa3); SBAR();
  pv_d0(o, vb0 + (int)SHM_V, pa0, pa1, pa2, pa3);
  l_reg += __builtin_amdgcn_exp2f(U.sink2 - m_reg * (SCALE * 1.4426950408889634f));
  if (hi == 0) li_l[r32] = l_reg; asm volatile("s_waitcnt lgkmcnt(0)" ::: "memory");
  float rli[16];
#pragma unroll
  for (int r = 0; r < 16; ++r) rli[r] = __builtin_amdgcn_rcpf(li_l[crow(r, hi)]);
  __syncthreads();
  { bf16* stg = (bf16*)(lds + wid * 8192);
#pragma unroll
    for (int r = 0; r < 16; ++r) { const int orow = crow(r, hi);
#pragma unroll
      for (int d0 = 0; d0 < 4; ++d0) stg[orow * 128 + d0 * 32 + r32] = (bf16)(cvtpk(o[d0][r] * rli[r], 0.f) & 0xffffu); }
    asm volatile("s_waitcnt lgkmcnt(0)" ::: "memory");
    bf16* Ow = U.O + (long)(wid * QBLK) * LDQ;
#pragma unroll
    for (int i = 0; i < 8; ++i) { const int row = 4 * i + (lane >> 4), ch = lane & 15; const u32x4 v = *(const u32x4*)(stg + row * 128 + ch * 8);
      *(u32x4*)(Ow + (long)row * LDQ + ch * 8) = v; } }
  __syncthreads();
#undef SLOAD
#undef SWRITE
#undef SWAIT
#undef RESC
#undef MASK
}
#undef KSWZ
#undef SBAR
}
constexpr int DM = 2048, R_CTX = 4096, R_LAT = 8192, RT = 12288, FF = 5632, NGU = 11264, DIN = 12288, HD = 128;
constexpr int NWAVES = 8, NTHR = 512;
constexpr float EPS_N = 1e-6f, SM_SCALE = 0.08838834764831845f;
constexpr size_t MiB = 1u << 20;
constexpr size_t WS_CTL = 0, CTL_ZERO_BYTES = 1 * MiB;
constexpr size_t WS_MODS = 1 * MiB;
constexpr size_t WS_ROPE = 2 * MiB;
constexpr size_t WS_CACHE = 4 * MiB;
constexpr size_t WS_W = 16 * MiB, W_LAYER = 200 * MiB;
constexpr size_t W_GU1 = 0, W_D1 = 44 * MiB, W_IN = 66 * MiB, W_B = 114 * MiB, W_O = 126 * MiB, W_GU2 = 134 * MiB, W_D2 = 178 * MiB;
constexpr size_t WS_H = 416 * MiB;
constexpr size_t WS_ACT = 464 * MiB;
constexpr size_t WS_Z = 596 * MiB;
constexpr size_t WS_QKVG = 884 * MiB;
constexpr size_t WS_END = 1172 * MiB;
constexpr int CW_BAR = 4096;
constexpr int EXCH_OFF = 131072, LDSCTL_OFF = 139264, MISC_OFF = LDSCTL_OFF + 320, LDS_BYTES = 147456;
constexpr size_t OUT_YP = 0, OUT_YS = 8388608, OUT_KGQA = 25165824, OUT_VGQA = 27262976, OUT_KNAT = 29360128, OUT_VNAT = 37748736, OUT_KWIN = 46137344, OUT_VWIN = 48234496, OUT_TOTAL = 50331648;

constexpr int MAP_GU = 1, MAP_IN = 2;
struct Args { const float* in[25]; float* out; unsigned char* ws; };

struct Frame {
    LAS unsigned char* lds;
    int tid, lane, wave, G, bid;
    float* out; unsigned char* ws;
};
#define CAS __attribute__((address_space(4)))
__device__ __forceinline__ const float* in_ptr(int k) { const CAS char* p = (const CAS char*)__builtin_amdgcn_kernarg_segment_ptr(); asm volatile("" : "+s"(p)); return *(const float* const CAS*)(p + 8 * k); }

__device__ __forceinline__ float shx(float v, int mask, int lane) { return __uint_as_float((unsigned)__builtin_amdgcn_ds_bpermute((lane ^ mask) << 2, (int)__float_as_uint(v))); }
__device__ __forceinline__ float wave_sum(float v, int lane) {
#pragma unroll
    for (int o = 1; o < 64; o <<= 1) v += shx(v, o, lane);
    return v;
}
__device__ __forceinline__ float bf2f(unsigned b) { return __uint_as_float(b << 16); }
__device__ __forceinline__ float bflo(unsigned w) { return __uint_as_float(w << 16); }
__device__ __forceinline__ float bfhi(unsigned w) { return __uint_as_float(w & 0xffff0000u); }
__device__ __forceinline__ float sigm(float x) { return 1.f / (1.f + __expf(-x)); }

__device__ __forceinline__ int rowmap(int MAP, int s) {
    if (MAP == 1) { const int n = s >= FF ? 1 : 0, j = s - FF * n, pn = j >> 7, jj = j & 127, wc = jj >> 5, fq = (jj & 31) >> 3, bj = (jj & 7) >> 2, e = jj & 3;
        return 256 * pn + 128 * bj + 32 * wc + 16 * n + 4 * fq + e; }
    if (MAP == 2) { const int pn = s >> 8, c = s & 255, bj = c >> 7, d = c & 127; const bool ropet = pn < 5 || (pn >= 18 && pn < 23);
        if (ropet) { const int h2 = d >> 6, n = (d & 63) >> 5, w1 = (d & 31) >> 4, fq = (d & 15) >> 2, e = d & 3; return 256 * pn + 128 * bj + 32 * (2 * h2 + w1) + 16 * n + 4 * fq + e; }
        const int wc = d >> 5, fq = (d & 31) >> 3, n = (d & 7) >> 2, e = d & 3; return 256 * pn + 128 * bj + 32 * wc + 16 * n + 4 * fq + e; }
    return s;
}
__device__ __forceinline__ void transpose_item(const float* W, int K, int N, bf16* WT, LAS float* scr, int k0, int n0, int lane, int MAP) {
    f32x4 tv[16];
#pragma unroll
    for (int i = 0; i < 16; ++i) tv[i] = *(const GAS f32x4*)(W + (size_t)(k0 + 4 * i + (lane >> 4)) * N + n0 + 4 * (lane & 15));
#pragma unroll
    for (int i = 0; i < 16; ++i) { LAS float* s = scr + (4 * i + (lane >> 4)) * 65 + 4 * (lane & 15); s[0] = tv[i].x; s[1] = tv[i].y; s[2] = tv[i].z; s[3] = tv[i].w; }
    LDS_WAIT(); asm volatile("" ::: "memory");
    const int c = lane & 7;
#pragma unroll
    for (int j = 0; j < 8; ++j) {
        const int n = 8 * j + (lane >> 3); const LAS float* s = scr + (8 * c) * 65 + n;
        v4u o; o.x = pk2(s[0], s[65]); o.y = pk2(s[130], s[195]); o.z = pk2(s[260], s[325]); o.w = pk2(s[390], s[455]);
        *(GAS v4u*)(WT + (size_t)rowmap(MAP, n0 + n) * K + k0 + 8 * c) = o;
    }
    LDS_WAIT(); asm volatile("" ::: "memory");
}
__device__ __forceinline__ void transpose_matrix(Frame& F, const float* W, int K, int N, bf16* WT, int MAP) {
    LAS float* scr = (LAS float*)(F.lds + F.wave * 16640);
    const int gw = F.bid * NWAVES + F.wave, NGW = F.G * NWAVES, nb = N / 64, items = (K / 64) * nb;
    for (int it = gw; it < items; it += NGW) transpose_item(W, K, N, WT, scr, 64 * (it / nb), 64 * (it % nb), F.lane, MAP);
}
__device__ __forceinline__ void cvt_array(Frame& F, const float* src, bf16* dst, int n8) {
    for (int i = F.bid * NTHR + F.tid; i < n8; i += F.G * NTHR) {
        const f32x4 a = *(const GAS f32x4*)(src + (size_t)i * 8), b = *(const GAS f32x4*)(src + (size_t)i * 8 + 4);
        v4u o; o.x = pk2(a.x, a.y); o.y = pk2(a.z, a.w); o.z = pk2(b.x, b.y); o.w = pk2(b.z, b.w);
        *(GAS v4u*)(dst + (size_t)i * 8) = o;
    }
}
__device__ __forceinline__ void mods_phase(Frame& F) {
    LAS float* sv = (LAS float*)F.lds;
    LAS f32x4* red = (LAS f32x4*)(F.lds + 24576);
    const float* c_lat = in_ptr(8); const float* c_ctx = in_ptr(9); const float* w_mod = in_ptr(10); const float* b_mod = in_ptr(11);
    float* mods = (float*)(F.ws + WS_MODS);
    for (int i = F.tid; i < 3 * 2048; i += NTHR) { const int g = i >> 11, k = i & 2047; const float c = (g == 0) ? c_ctx[k] : c_lat[(g - 1) * 2048 + k]; sv[i] = c / (1.f + __expf(-c)); }
    __syncthreads();
    for (int cb = F.bid; cb < 256; cb += F.G) {
        const int l = cb >> 7, col0 = (cb & 127) * 144;
        if (F.tid < 504) {
            const int c4 = F.tid % 36, kg = F.tid / 36;
            const GAS f32x4* wp = (const GAS f32x4*)(w_mod + (size_t)l * 2048 * 18432 + col0 + 4 * c4);
            f32x4 a0 = {0.f, 0.f, 0.f, 0.f}, a1 = a0, a2 = a0;
#pragma unroll 4
            for (int k = kg; k < 2048; k += 14) { const f32x4 w = wp[(size_t)k * 4608]; a0 += sv[k] * w; a1 += sv[2048 + k] * w; a2 += sv[4096 + k] * w; }
            red[(kg * 3 + 0) * 36 + c4] = a0; red[(kg * 3 + 1) * 36 + c4] = a1; red[(kg * 3 + 2) * 36 + c4] = a2;
        }
        __syncthreads();
        if (F.tid < 108) {
            const int g = F.tid / 36, c4 = F.tid % 36; f32x4 s = *(const GAS f32x4*)(b_mod + (size_t)l * 18432 + col0 + 4 * c4);
            for (int kg = 0; kg < 14; ++kg) s += red[(kg * 3 + g) * 36 + c4];
            *(GAS f32x4*)(mods + (size_t)(l * 3 + g) * 18432 + col0 + 4 * c4) = s;
        }
        __syncthreads();
    }
}
__device__ __forceinline__ void prologue(Frame& F) {
    unsigned char* ws = F.ws;
    for (int l = 0; l < 2; ++l) {
        unsigned char* wl = ws + WS_W + (size_t)l * W_LAYER;
        transpose_matrix(F, in_ptr(13) + (size_t)l * DM * NGU, DM, NGU, (bf16*)(wl + W_GU1), MAP_GU);
        transpose_matrix(F, in_ptr(14) + (size_t)l * FF * DM, FF, DM, (bf16*)(wl + W_D1), 0);
        transpose_matrix(F, in_ptr(15) + (size_t)l * DM * DIN, DM, DIN, (bf16*)(wl + W_IN), MAP_IN);
        for (int i = 0; i < 3; ++i) transpose_matrix(F, in_ptr(20) + (size_t)(l * 3 + i) * 1024 * DM, 1024, DM, (bf16*)(wl + W_B) + (size_t)i * DM * 1024, 0);
        transpose_matrix(F, in_ptr(21) + (size_t)l * DM * DM, DM, DM, (bf16*)(wl + W_O), 0);
        transpose_matrix(F, in_ptr(22) + (size_t)l * DM * NGU, DM, NGU, (bf16*)(wl + W_GU2), MAP_GU);
        transpose_matrix(F, in_ptr(23) + (size_t)l * FF * DM, FF, DM, (bf16*)(wl + W_D2), 0);
    }
    cvt_array(F, in_ptr(2), (bf16*)(ws + WS_CACHE), 524288 / 8);
    cvt_array(F, in_ptr(3), (bf16*)(ws + WS_CACHE + 1 * MiB), 524288 / 8);
    cvt_array(F, in_ptr(6), (bf16*)(ws + WS_CACHE + 2 * MiB), 524288 / 8);
    cvt_array(F, in_ptr(7), (bf16*)(ws + WS_CACHE + 3 * MiB), 524288 / 8);
    cvt_array(F, in_ptr(4), (bf16*)(ws + WS_CACHE + 4 * MiB), 2097152 / 8);
    cvt_array(F, in_ptr(5), (bf16*)(ws + WS_CACHE + 8 * MiB), 2097152 / 8);
    { float* ct = (float*)(ws + WS_ROPE); float* st = ct + 2048;
      for (int i = F.bid * NTHR + F.tid; i < 2048; i += F.G * NTHR) { const int pos = i >> 5, f = i & 31;
          const float inv = exp2f(-(float)f * (13.287712379549449f / 32.0f)); const float ang = (float)pos * inv;
          const float kf = rintf(ang * 0.6366197723675814f); float r = fmaf(-kf, 1.5707962512969971f, ang); r = fmaf(-kf, 7.5497894158615964e-08f, r); r = fmaf(-kf, 5.3903029534742384e-15f, r);
          const float r2 = r * r;
          const float sn = r + r * r2 * (-1.6666667e-1f + r2 * (8.3333338e-3f + r2 * (-1.9841270e-4f + r2 * 2.7557319e-6f)));
          const float cs = 1.0f + r2 * (-0.5f + r2 * (4.1666668e-2f + r2 * (-1.3888889e-3f + r2 * (2.4801587e-5f + r2 * -2.7557319e-7f))));
          const int q = ((int)kf) & 3; const float sv_ = (q == 0) ? sn : (q == 1) ? cs : (q == 2) ? -sn : -cs, cv_ = (q == 0) ? cs : (q == 1) ? -sn : (q == 2) ? -cs : sn;
          ct[i] = cv_; st[i] = sv_; } }
    __syncthreads();
    mods_phase(F);
}

__device__ __forceinline__ void adaln_phase(Frame& F, int l, int which, bool from_inputs) {
    const float* X = F.out; bf16* H = (bf16*)(F.ws + WS_H); const float* mods = (const float*)(F.ws + WS_MODS);
    const float* gn = in_ptr(12) + (size_t)(l * 3 + which) * DM; const float* xin0 = in_ptr(0); const float* xin1 = in_ptr(1);
    const int gw = F.bid * NWAVES + F.wave, NGW = F.G * NWAVES, lane = F.lane;
#define ADALN_SRC(row) (from_inputs ? ((row) < R_CTX ? xin0 + (size_t)(row) * DM : xin1 + (size_t)((row) - R_CTX) * DM) : X + (size_t)(row) * DM)
    f32x4 v[8], vn[8];
    if (gw < RT) { const float* src = ADALN_SRC(gw);
#pragma unroll
        for (int j = 0; j < 8; ++j) v[j] = ((const GAS f32x4*)src)[64 * j + lane]; }
    for (int row = gw; row < RT; row += NGW) {
        const int g = row < R_CTX ? 0 : 1 + ((row - R_CTX) >> 12);
        const int nrow = row + NGW;
        if (nrow < RT) { const float* src = ADALN_SRC(nrow);
#pragma unroll
            for (int j = 0; j < 8; ++j) vn[j] = ((const GAS f32x4*)src)[64 * j + lane]; }
        float ss = 0.f;
#pragma unroll
        for (int j = 0; j < 8; ++j) ss += (v[j].x * v[j].x + v[j].y * v[j].y) + (v[j].z * v[j].z + v[j].w * v[j].w);
        const float rstd = 1.0f / sqrtf(wave_sum(ss, lane) * (1.0f / DM) + EPS_N);
        const GAS f32x4* gnp = (const GAS f32x4*)gn; const float* mg = mods + (size_t)(l * 3 + g) * 18432 + (size_t)which * 3 * DM;
        const GAS f32x4* shp = (const GAS f32x4*)mg; const GAS f32x4* scp = (const GAS f32x4*)(mg + DM);
        GAS unsigned long long* o8 = (GAS unsigned long long*)(H + (size_t)row * DM);
#pragma unroll
        for (int j = 0; j < 8; ++j) {
            const f32x4 a = gnp[64 * j + lane] * (1.0f + scp[64 * j + lane]) * rstd, b = shp[64 * j + lane]; const f32x4 h = v[j] * a + b;
            o8[64 * j + lane] = (unsigned long long)pk2(h.x, h.y) | ((unsigned long long)pk2(h.z, h.w) << 32);
        }
#pragma unroll
        for (int j = 0; j < 8; ++j) v[j] = vn[j];
    }
#undef ADALN_SRC
}
__device__ __forceinline__ void final_phase(Frame& F) {
    float* X = F.out; const GAS f32x4* gf = (const GAS f32x4*)in_ptr(24);
    const int gw = F.bid * NWAVES + F.wave, NGW = F.G * NWAVES, lane = F.lane;
    for (int row = gw; row < RT; row += NGW) {
        GAS f32x4* xr = (GAS f32x4*)(X + (size_t)row * DM);
        f32x4 v[8];
#pragma unroll
        for (int j = 0; j < 8; ++j) v[j] = xr[64 * j + lane];
        float ss = 0.f;
#pragma unroll
        for (int j = 0; j < 8; ++j) ss += (v[j].x * v[j].x + v[j].y * v[j].y) + (v[j].z * v[j].z + v[j].w * v[j].w);
        const float rstd = 1.0f / sqrtf(wave_sum(ss, lane) * (1.0f / DM) + EPS_N);
#pragma unroll
        for (int j = 0; j < 8; ++j) xr[64 * j + lane] = v[j] * rstd * gf[64 * j + lane];
    }
}
__device__ __forceinline__ bool make_unit(Frame& F, int l, int id, att::Unit& U) {
    if (id >= 1152) return false;
    unsigned char* qb = F.ws + WS_QKVG;
    const bf16* QA = (const bf16*)qb; const bf16* QB = (const bf16*)(qb + 24 * MiB); const bf16* QC = (const bf16*)(qb + 48 * MiB); const bf16* KB = (const bf16*)(qb + 72 * MiB); const bf16* VB = (const bf16*)(qb + 96 * MiB);
    const bf16* KA = (const bf16*)(qb + 120 * MiB); const bf16* VA = (const bf16*)(qb + 126 * MiB); const bf16* KC = (const bf16*)(qb + 132 * MiB); const bf16* VC = (const bf16*)(qb + 138 * MiB);
    const bf16* CKA = (const bf16*)(F.ws + WS_CACHE); const bf16* CVA = (const bf16*)(F.ws + WS_CACHE + 1 * MiB); const bf16* CKC = (const bf16*)(F.ws + WS_CACHE + 2 * MiB); const bf16* CVC = (const bf16*)(F.ws + WS_CACHE + 3 * MiB);
    const bf16* CKB = (const bf16*)(F.ws + WS_CACHE + 4 * MiB); const bf16* CVB = (const bf16*)(F.ws + WS_CACHE + 8 * MiB);
    bf16* O = (bf16*)(F.ws + WS_ACT);
    const float LOG2E = 1.4426950408889634f;
    U.mode = 0; U.a = 0; U.b = 0; U.sink2 = -__builtin_inff(); U.tab = in_ptr(18); U.n0 = 0;
    if (id < 768) {
        const int type = id >> 8, v = id & 255, xcd = v & 7, j = v >> 3; int b, h, q;
        if (type != 1) { const int combo = xcd >> 1, idx = (xcd & 1) * 32 + j; b = combo >> 1; h = (combo & 1) * 4 + (idx >> 4); q = idx & 15; }
        else { const int combo = xcd * 2 + (j >> 4); b = combo >> 3; h = combo & 7; q = j & 15; }
        const size_t lat0 = R_CTX + (size_t)b * 4096, row0 = lat0 + (size_t)q * 256, cb = (size_t)(b * 2 + l) * 512;
        U.n0 = 8;
        if (type == 0) { const int kvh = h >> 2; U.ldk = 256;
            U.Q = QA + row0 * 1024 + h * 128; U.O = O + row0 * 1024 + h * 128;
            U.K0 = CKA + cb * 256 + kvh * 128; U.V0 = CVA + cb * 256 + kvh * 128; U.K1 = KA + lat0 * 256 + kvh * 128; U.V1 = VA + lat0 * 256 + kvh * 128; U.n1 = 64; }
        else if (type == 1) { U.ldk = 1024; const int R0 = q * 4, kr0 = min(max(R0 - 4, 0), 52);
            U.Q = QB + row0 * 1024 + h * 128; U.O = O + (size_t)RT * 1024 + row0 * 1024 + h * 128;
            U.K0 = CKB + cb * 1024 + h * 128; U.V0 = CVB + cb * 1024 + h * 128; U.K1 = KB + (lat0 + (size_t)kr0 * 64) * 1024 + h * 128; U.V1 = VB + (lat0 + (size_t)kr0 * 64) * 1024 + h * 128; U.n1 = 12;
            U.mode = 1; U.a = R0; U.b = kr0; U.tab = in_ptr(18) + (size_t)(l * 8 + h) * 465; }
        else { const int kvh = h >> 2; U.ldk = 256; const int kp0 = max(q * 256 - 128, 0), kp1 = min(q * 256 + 384, 4096);
            U.Q = QC + row0 * 1024 + h * 128; U.O = O + (size_t)2 * RT * 1024 + row0 * 1024 + h * 128;
            U.K0 = CKC + cb * 256 + kvh * 128; U.V0 = CVC + cb * 256 + kvh * 128; U.K1 = KC + (lat0 + kp0) * 256 + kvh * 128; U.V1 = VC + (lat0 + kp0) * 256 + kvh * 128; U.n1 = (kp1 - kp0) >> 6;
            U.mode = 2; U.a = q * 256; U.b = kp0; U.sink2 = in_ptr(19)[l * 8 + h] * LOG2E; }
    } else {
        const int v = id - 768, b = v / 24, rem = v - 24 * b, br = rem >> 3, h = rem & 7; const size_t row0 = (size_t)b * 256;
        const int kvh = br == 1 ? h : (h >> 2); U.ldk = br == 1 ? 1024 : 256;
        const bf16* Qx = br == 0 ? QA : br == 1 ? QB : QC; const bf16* Kx = br == 0 ? KA : br == 1 ? KB : KC; const bf16* Vx = br == 0 ? VA : br == 1 ? VB : VC;
        U.Q = Qx + row0 * 1024 + h * 128; U.O = O + (size_t)br * RT * 1024 + row0 * 1024 + h * 128;
        U.K1 = Kx + row0 * U.ldk + kvh * 128; U.V1 = Vx + row0 * U.ldk + kvh * 128; U.K0 = U.K1; U.V0 = U.V1; U.n1 = 4;
        if (br == 2) U.sink2 = in_ptr(19)[l * 8 + h] * LOG2E;
    }
    return true;
}
__device__ __forceinline__ void attn_phase(Frame& F, int l, char* lds) {
    for (int id = F.bid; ; id += F.G) { att::Unit U; if (!make_unit(F, l, id, U)) break; att::attn_unit(U, lds, F.tid); }
}

namespace pg8 {
struct EpiSwiglu {
    static constexpr bool PERM = false, AFTER_DRAIN = false, CHAIN = false;
    bf16_t* ACT;
    __device__ __forceinline__ void operator()(const f32x4 (&acc)[2][2][4][2], const Unit& u, int wr, int wc, int fr, int fq) const {
        { int ln_; asm volatile("v_mbcnt_lo_u32_b32 %0, -1, 0\n\tv_mbcnt_hi_u32_b32 %0, -1, %0" : "=v"(ln_)); fr = ln_ & 15; fq = ln_ >> 4; }
        const int row0 = u.pm * BM + wr * 64 + fr, col0 = u.pn * 128 + wc * 32 + 8 * fq;
#pragma unroll
        for (int ai = 0; ai < 2; ++ai)
#pragma unroll
            for (int m = 0; m < 4; ++m) { u32x4 w;
#pragma unroll
                for (int bj = 0; bj < 2; ++bj) { const f32x4 a = acc[ai][bj][m][0], b = acc[ai][bj][m][1]; f32x4 r;
#pragma unroll
                    for (int e = 0; e < 4; ++e) r[e] = a[e] * __builtin_amdgcn_rcpf(1.0f + __expf(-a[e])) * b[e];
                    w[2 * bj] = cvt_pk_bf16(r[0], r[1]); w[2 * bj + 1] = cvt_pk_bf16(r[2], r[3]); }
                *(u32x4*)(ACT + (size_t)(row0 + ai * HALF + m * 16) * 5632 + col0) = w; }
    }
};
struct EpiResid {
    static constexpr bool PERM = false, AFTER_DRAIN = false, CHAIN = false;
    float* X; const float* base_ctx; const float* base_lat; const float* gate; float coef;
    __device__ __forceinline__ void operator()(const f32x4 (&acc)[2][2][4][2], const Unit& u, int wr, int wc, int fr, int fq) const {
        { int ln_; asm volatile("v_mbcnt_lo_u32_b32 %0, -1, 0\n\tv_mbcnt_hi_u32_b32 %0, -1, %0" : "=v"(ln_)); fr = ln_ & 15; fq = ln_ >> 4; }
        const int col0 = u.pn * BM + wc * 32 + 4 * fq;
        const int grp = u.pm < 16 ? 0 : (u.pm < 32 ? 1 : 2);
        const float* bs = u.pm < 16 ? base_ctx + (size_t)u.pm * BM * 2048 : base_lat + (size_t)(u.pm - 16) * BM * 2048;
        f32x4 gv[2][2];
#pragma unroll
        for (int bj = 0; bj < 2; ++bj)
#pragma unroll
            for (int n = 0; n < 2; ++n) gv[bj][n] = *(const f32x4*)(gate + (size_t)grp * 18432 + col0 + bj * HALF + n * 16) * coef;
#pragma unroll
        for (int ai = 0; ai < 2; ++ai) {
            f32x4 bv[4][2][2];
#pragma unroll
            for (int m = 0; m < 4; ++m) { const size_t off = (size_t)(wr * 64 + fr + ai * HALF + m * 16) * 2048 + col0;
#pragma unroll
                for (int bj = 0; bj < 2; ++bj)
#pragma unroll
                    for (int n = 0; n < 2; ++n) bv[m][bj][n] = *(const f32x4*)(bs + off + bj * HALF + n * 16); }
#pragma unroll
            for (int m = 0; m < 4; ++m) { const size_t off = (size_t)(wr * 64 + fr + ai * HALF + m * 16) * 2048 + col0;
#pragma unroll
                for (int bj = 0; bj < 2; ++bj)
#pragma unroll
                    for (int n = 0; n < 2; ++n) *(f32x4*)(X + (size_t)u.pm * BM * 2048 + off + bj * HALF + n * 16) = bv[m][bj][n] + gv[bj][n] * acc[ai][bj][m][n]; } }
    }
};
struct EpiBranch {
    static constexpr bool PERM = false, AFTER_DRAIN = false, CHAIN = true;
    bf16_t* Mb; const bf16_t* GT;
    __device__ __forceinline__ void operator()(f32x4 (&acc)[2][2][4][2], const Unit& u, int wr, int wc, int fr, int fq) const {
        { int ln_; asm volatile("v_mbcnt_lo_u32_b32 %0, -1, 0\n\tv_mbcnt_hi_u32_b32 %0, -1, %0" : "=v"(ln_)); fr = ln_ & 15; fq = ln_ >> 4; }
        const int br = u.pm / 48, pm = u.pm - 48 * br, pn = u.pn & 7;
        const int row0 = pm * BM + wr * 64 + fr, col0 = pn * BM + wc * 32 + 4 * fq;
        const int o2 = br < 2 ? 2048 : 0;
        const float keep = br < 2 ? 1.0f : 0.0f;
#pragma unroll
        for (int aq = 0; aq < 4; ++aq) { const int ai = aq >> 1, m0 = (aq & 1) * 2;
            unsigned long long ga[2][2][2], gb[2][2][2];
#pragma unroll
            for (int mm = 0; mm < 2; ++mm) { const size_t row = (size_t)(row0 + ai * HALF + (m0 + mm) * 16);
#pragma unroll
                for (int bj = 0; bj < 2; ++bj)
#pragma unroll
                    for (int n = 0; n < 2; ++n) { const bf16_t* gp = GT + row * 6144 + br * 2048 + col0 + bj * HALF + n * 16; ga[mm][bj][n] = *(const unsigned long long*)gp; gb[mm][bj][n] = *(const unsigned long long*)(gp + o2); } }
#pragma unroll
            for (int mm = 0; mm < 2; ++mm) { const size_t row = (size_t)(row0 + ai * HALF + (m0 + mm) * 16);
#pragma unroll
                for (int bj = 0; bj < 2; ++bj)
#pragma unroll
                    for (int n = 0; n < 2; ++n) { const unsigned a0 = (unsigned)ga[mm][bj][n], a1 = (unsigned)(ga[mm][bj][n] >> 32), b0 = (unsigned)gb[mm][bj][n], b1 = (unsigned)(gb[mm][bj][n] >> 32);
                        const f32x4 num = {__uint_as_float(a0 << 16), __uint_as_float(a0 & 0xffff0000u), __uint_as_float(a1 << 16), __uint_as_float(a1 & 0xffff0000u)};
                        const f32x4 den = {__uint_as_float(b0 << 16), __uint_as_float(b0 & 0xffff0000u), __uint_as_float(b1 << 16), __uint_as_float(b1 & 0xffff0000u)};
                        f32x4 r;
#pragma unroll
                        for (int e = 0; e < 4; ++e) { const float nu = fmaxf(num[e], 1e-20f), de = fmaxf(den[e], 1e-20f); r[e] = br < 2 ? nu * __builtin_amdgcn_rcpf(de) : nu; }
                        if (br == 2) { const f32x4 t = acc[ai][bj][m0 + mm][n] * r;
                            *(unsigned long long*)(Mb + row * 2048 + col0 + bj * HALF + n * 16) = (unsigned long long)cvt_pk_bf16(t[0], t[1]) | ((unsigned long long)cvt_pk_bf16(t[2], t[3]) << 32); }
                        acc[ai][bj][m0 + mm][n] *= r * keep;
                        asm volatile("" : "+v"(acc[ai][bj][m0 + mm][n])); } }
            __builtin_amdgcn_sched_barrier(0); }
    }
};
struct EpiInproj {
    static constexpr bool PERM = false, AFTER_DRAIN = false, CHAIN = false;
    unsigned char* qkvg; float* out; const float* gq; const float* gk; const float* ropec; int l; PG8_LAS float* P;
    __device__ __forceinline__ void operator()(const f32x4 (&acc)[2][2][4][2], const Unit& u, int wr, int wc, int fr, int fq) const {
        { int ln_; asm volatile("v_mbcnt_lo_u32_b32 %0, -1, 0\n\tv_mbcnt_hi_u32_b32 %0, -1, %0" : "=v"(ln_)); fr = ln_ & 15; fq = ln_ >> 4; }
        constexpr size_t MiB_ = 1u << 20;
        const int pn = u.pn; const bool isctx = u.pm < 16;
        bf16_t* dst; int dld; float* fo = nullptr; int fld = 0; int kind = 0, norm = 0;
        if (pn < 4)        { dst = (bf16_t*)qkvg + pn * 256; dld = 1024; kind = 1; norm = 1; }
        else if (pn == 4)  { dst = (bf16_t*)(qkvg + 120 * MiB_); dld = 256; kind = 1; norm = 2; fo = out + 25165824; fld = 256; }
        else if (pn == 5)  { dst = (bf16_t*)(qkvg + 126 * MiB_); dld = 256; fo = out + 27262976; fld = 256; }
        else if (pn < 10)  { dst = (bf16_t*)(qkvg + 24 * MiB_) + (pn - 6) * 256; dld = 1024; }
        else if (pn < 14)  { dst = (bf16_t*)(qkvg + 72 * MiB_) + (pn - 10) * 256; dld = 1024; fo = out + 29360128 + (pn - 10) * 256; fld = 1024; }
        else if (pn < 18)  { dst = (bf16_t*)(qkvg + 96 * MiB_) + (pn - 14) * 256; dld = 1024; fo = out + 37748736 + (pn - 14) * 256; fld = 1024; }
        else if (pn < 22)  { dst = (bf16_t*)(qkvg + 48 * MiB_) + (pn - 18) * 256; dld = 1024; kind = 1; }
        else if (pn == 22) { dst = (bf16_t*)(qkvg + 132 * MiB_); dld = 256; kind = 1; fo = out + 46137344; fld = 256; }
        else if (pn == 23) { dst = (bf16_t*)(qkvg + 138 * MiB_); dld = 256; fo = out + 48234496; fld = 256; }
        else               { dst = (bf16_t*)(qkvg + 144 * MiB_) + (pn - 24) * 256; dld = 6144; kind = 2; }
        if (!isctx) fo = nullptr;
        const int rl0 = wr * 64 + fr;
        const size_t grow0 = (size_t)u.pm * BM;
        const size_t frow0 = ((size_t)(u.pm * 2 + l)) * 256;
        if (kind != 1) {
            const int c0 = 32 * wc + 8 * fq;
#pragma unroll
            for (int ai = 0; ai < 2; ++ai)
#pragma unroll
                for (int m = 0; m < 4; ++m) { const int rl = rl0 + ai * HALF + m * 16;
#pragma unroll
                    for (int bj = 0; bj < 2; ++bj) { f32x4 a = acc[ai][bj][m][0], b = acc[ai][bj][m][1];
                        if (kind == 2) {
#pragma unroll
                            for (int e = 0; e < 4; ++e) { a[e] = __builtin_amdgcn_rcpf(1.0f + __expf(-a[e])); b[e] = __builtin_amdgcn_rcpf(1.0f + __expf(-b[e])); } }
                        u32x4 w; w.x = cvt_pk_bf16(a[0], a[1]); w.y = cvt_pk_bf16(a[2], a[3]); w.z = cvt_pk_bf16(b[0], b[1]); w.w = cvt_pk_bf16(b[2], b[3]);
                        *(u32x4*)(dst + (grow0 + rl) * dld + bj * HALF + c0) = w;
                        if (fo) { float* fp = fo + (frow0 + rl) * fld + bj * HALF + c0; *(f32x4*)fp = a; *(f32x4*)(fp + 4) = b; } } }
            return;
        }
        const int db = 64 * (wc >> 1) + 16 * (wc & 1) + 4 * fq;
        if (norm) {
#pragma unroll
            for (int ai = 0; ai < 2; ++ai)
#pragma unroll
                for (int m = 0; m < 4; ++m)
#pragma unroll
                    for (int bj = 0; bj < 2; ++bj) { const f32x4 a = acc[ai][bj][m][0], b = acc[ai][bj][m][1];
                        float ss = (a[0] * a[0] + a[1] * a[1]) + (a[2] * a[2] + a[3] * a[3]) + (b[0] * b[0] + b[1] * b[1]) + (b[2] * b[2] + b[3] * b[3]);
                        ss += shx(ss, 16, 16 * fq + fr); ss += shx(ss, 32, 16 * fq + fr);
                        if (fq == 0) P[((rl0 + ai * HALF + m * 16) * 2 + bj) * 4 + wc] = ss; }
            asm volatile("s_waitcnt lgkmcnt(0)" ::: "memory"); __builtin_amdgcn_s_barrier(); asm volatile("" ::: "memory");
        }
        f32x4 g0 = {1.f, 1.f, 1.f, 1.f}, g1 = g0;
        if (norm) { const float* gg = norm == 1 ? gq : gk; g0 = *(const f32x4*)(gg + db); g1 = *(const f32x4*)(gg + db + 32); }
        const int fi = 16 * (wc & 1) + 4 * fq;
#pragma unroll
        for (int ai = 0; ai < 2; ++ai) { f32x4 csv[4], snv[4];
#pragma unroll
            for (int m = 0; m < 4; ++m) { csv[m] = (f32x4){1.f, 1.f, 1.f, 1.f}; snv[m] = (f32x4){0.f, 0.f, 0.f, 0.f};
                if (!isctx) { const int nl = (int)((grow0 + rl0 + ai * HALF + m * 16 - 4096) & 4095); const int pos = (wc >> 1) ? (nl & 63) : (nl >> 6);
                    csv[m] = *(const f32x4*)(ropec + pos * 32 + fi); snv[m] = *(const f32x4*)(ropec + 2048 + pos * 32 + fi); } }
#pragma unroll
            for (int m = 0; m < 4; ++m) { const int rl = rl0 + ai * HALF + m * 16;
                const f32x4 cs = csv[m], sn = snv[m];
#pragma unroll
                for (int bj = 0; bj < 2; ++bj) { f32x4 a = acc[ai][bj][m][0], b = acc[ai][bj][m][1];
                    if (norm) { const f32x4 pp = *(const PG8_LAS f32x4*)(P + (rl * 2 + bj) * 4); const float rstd = 1.0f / sqrtf(((pp[0] + pp[1]) + (pp[2] + pp[3])) * (1.0f / 128.0f) + 1e-6f);
                        a = a * rstd * g0; b = b * rstd * g1; }
                    const f32x4 y1 = a * cs - b * sn, y2 = b * cs + a * sn;
                    bf16_t* dp = dst + (grow0 + rl) * dld + bj * HALF + db;
                    *(unsigned long long*)dp = (unsigned long long)cvt_pk_bf16(y1[0], y1[1]) | ((unsigned long long)cvt_pk_bf16(y1[2], y1[3]) << 32);
                    *(unsigned long long*)(dp + 32) = (unsigned long long)cvt_pk_bf16(y2[0], y2[1]) | ((unsigned long long)cvt_pk_bf16(y2[2], y2[3]) << 32);
                    if (fo) { float* fp = fo + (frow0 + rl) * fld + bj * HALF + db; *(f32x4*)fp = y1; *(f32x4*)(fp + 32) = y2; } } } }
    }
};
struct BranchOrder {
    int G, c;
    __device__ __forceinline__ bool next(int i, Unit& u) const { const int j = i / 3, br = i - 3 * j; const int tile = j * G + c; if (tile >= 384) return false;
        u.pm = br * 48 + (tile >> 3); u.pn = br * 8 + (tile & 7); return true; }
    __device__ __forceinline__ void a_ready(const Unit&) const {}
    __device__ __forceinline__ void done(const Unit&) const {}
};
}

__global__ void __launch_bounds__(NTHR, 2) mega_fwd(Args args) {
    extern __shared__ __attribute__((aligned(16))) unsigned char lds[];
    Frame F;
    F.lds = (LAS unsigned char*)lds; F.tid = threadIdx.x; F.lane = F.tid & 63; F.wave = __builtin_amdgcn_readfirstlane(F.tid >> 6); F.G = gridDim.x; F.bid = blockIdx.x;
    F.out = (float*)in_ptr(25); F.ws = (unsigned char*)in_ptr(26);
    for (int u = F.tid; u < (LDS_BYTES - LDSCTL_OFF) / 4; u += NTHR) ((LAS unsigned*)(F.lds + LDSCTL_OFF))[u] = 0u;
    __syncthreads();
    volatile LAS unsigned* MISC = (volatile LAS unsigned*)(F.lds + MISC_OFF);
    XcdBarrier bar = xcd_barrier_post((unsigned*)(F.ws + WS_CTL) + CW_BAR, MISC + 8, F.tid);
#define RELAUNDER() do { asm volatile("v_mbcnt_lo_u32_b32 %0, -1, 0\n\tv_mbcnt_hi_u32_b32 %0, -1, %0" : "=v"(F.lane)); \
    asm volatile("" : "+s"(F.wave), "+s"(F.bid), "+s"(F.G), "+s"(F.ws), "+s"(F.out), "+s"(bar.bar), "+s"(bar.x)); F.tid = F.wave * 64 + F.lane; } while (0)
#define GRID_BAR() do { RELAUNDER(); xcd_barrier(bar, F.tid); RELAUNDER(); } while (0)

    prologue(F); GRID_BAR();

    for (int l = 0; l < 2; ++l) {
        unsigned char* wl = F.ws + WS_W + (size_t)l * W_LAYER;
        const float* modl = (const float*)(F.ws + WS_MODS) + (size_t)l * 3 * 18432;
        adaln_phase(F, l, 0, l == 0); GRID_BAR();
        { pg8::Gemm g{(const bf16*)(F.ws + WS_H), (const bf16*)(wl + W_GU1), RT, NGU, DM}; pg8::StaticOrder S; S.init(RT, NGU, F.G, F.bid);
          pg8::EpiSwiglu E{(bf16*)(F.ws + WS_ACT)};
          pg8::gemm_phase<pg8::EpiSwiglu, pg8::StaticOrder, true, true>(F.lds, g, S, E, F.tid); }
        GRID_BAR();
        { pg8::Gemm g{(const bf16*)(F.ws + WS_ACT), (const bf16*)(wl + W_D1), RT, DM, FF}; pg8::StaticOrder S; S.init(RT, DM, F.G, F.bid);
          pg8::EpiResid E{F.out, l == 0 ? in_ptr(0) : F.out, l == 0 ? in_ptr(1) : F.out + (size_t)R_CTX * DM, modl + 2 * DM, 0.5f};
          pg8::gemm_phase<pg8::EpiResid, pg8::StaticOrder, true, true>(F.lds, g, S, E, F.tid); }
        GRID_BAR();
        adaln_phase(F, l, 1, false); GRID_BAR();
        { pg8::Gemm g{(const bf16*)(F.ws + WS_H), (const bf16*)(wl + W_IN), RT, DIN, DM}; pg8::StaticOrder S; S.init(RT, DIN, F.G, F.bid);
          pg8::EpiInproj E{F.ws + WS_QKVG, F.out, in_ptr(16) + l * HD, in_ptr(17) + l * HD, (const float*)(F.ws + WS_ROPE), l, (LAS float*)(F.lds + EXCH_OFF)};
          pg8::gemm_phase<pg8::EpiInproj, pg8::StaticOrder, true, true>(F.lds, g, S, E, F.tid); }
        GRID_BAR();
        attn_phase(F, l, (char*)lds); GRID_BAR();
        { pg8::Gemm g{(const bf16*)(F.ws + WS_ACT)  , (const bf16*)(wl + W_B), 3 * RT, 3 * DM, 1024}; pg8::BranchOrder S{F.G, F.bid};
          pg8::EpiBranch E{(bf16*)(F.ws + WS_H), (const bf16*)(F.ws + WS_QKVG + 144 * MiB)};
          pg8::gemm_phase<pg8::EpiBranch, pg8::BranchOrder, true, true>(F.lds, g, S, E, F.tid); }
        GRID_BAR();
        { pg8::Gemm g{(const bf16*)(F.ws + WS_H)  , (const bf16*)(wl + W_O), RT, DM, DM}; pg8::StaticOrder S; S.init(RT, DM, F.G, F.bid);
          pg8::EpiResid E{F.out, F.out, F.out + (size_t)R_CTX * DM, modl + 5 * DM, 1.0f};
          pg8::gemm_phase<pg8::EpiResid, pg8::StaticOrder, true, true>(F.lds, g, S, E, F.tid); }
        GRID_BAR();
        adaln_phase(F, l, 2, false); GRID_BAR();
        { pg8::Gemm g{(const bf16*)(F.ws + WS_H), (const bf16*)(wl + W_GU2), RT, NGU, DM}; pg8::StaticOrder S; S.init(RT, NGU, F.G, F.bid);
          pg8::EpiSwiglu E{(bf16*)(F.ws + WS_ACT)};
          pg8::gemm_phase<pg8::EpiSwiglu, pg8::StaticOrder, true, true>(F.lds, g, S, E, F.tid); }
        GRID_BAR();
        { pg8::Gemm g{(const bf16*)(F.ws + WS_ACT), (const bf16*)(wl + W_D2), RT, DM, FF}; pg8::StaticOrder S; S.init(RT, DM, F.G, F.bid);
          pg8::EpiResid E{F.out, F.out, F.out + (size_t)R_CTX * DM, modl + 8 * DM, 0.5f};
          pg8::gemm_phase<pg8::EpiResid, pg8::StaticOrder, true, true>(F.lds, g, S, E, F.tid); }
        GRID_BAR();
    }
    final_phase(F);
#undef GRID_BAR
}

extern "C" void kernel_launch(void* const* d_in, const int* in_sizes, int n_in, void* d_out, int out_size, void* d_ws, size_t ws_size, hipStream_t stream) {
    static int grid = 0;
    if (grid == 0) {
        if (n_in != 25 || out_size != (int)OUT_TOTAL || ws_size < WS_END) { fprintf(stderr, "kernel_launch: unexpected shapes: n_in %d out %d ws %zu (need %zu)\n", n_in, out_size, ws_size, (size_t)WS_END); grid = -1; return; }
        int dev = 0, cus = 0, per_cu = 0;
        if (hipGetDevice(&dev) != hipSuccess || hipDeviceGetAttribute(&cus, hipDeviceAttributeMultiprocessorCount, dev) != hipSuccess) { grid = -1; return; }
        if (hipFuncSetAttribute((const void*)mega_fwd, hipFuncAttributeMaxDynamicSharedMemorySize, LDS_BYTES) != hipSuccess) { fprintf(stderr, "kernel_launch: hipFuncSetAttribute failed\n"); grid = -1; return; }
        if (hipOccupancyMaxActiveBlocksPerMultiprocessor(&per_cu, (const void*)mega_fwd, NTHR, LDS_BYTES) != hipSuccess || per_cu < 1) { fprintf(stderr, "kernel_launch: occupancy query says %d\n", per_cu); (void)hipGetLastError(); grid = -1; return; }
        grid = cus;
    }
    if (grid < 0) return;
    if (hipMemsetAsync((char*)d_ws + WS_CTL, 0, CTL_ZERO_BYTES, stream) != hipSuccess) return;
    Args a{};
    for (int i = 0; i < 25; ++i) a.in[i] = (const float*)d_in[i];
    a.out = (float*)d_out; a.ws = (unsigned char*)d_ws;
    hipLaunchKernelGGL(mega_fwd, dim3(grid), dim3(NTHR), LDS_BYTES, stream, a);
}
```

```cpp
#include <hip/hip_runtime.h>
#include <cstdio>
#include <cstdint>
namespace pg8 {
#define PG8_LAS __attribute__((address_space(3)))
typedef unsigned short bf16_t;
typedef short bf16x8 __attribute__((ext_vector_type(8)));
typedef float f32x4 __attribute__((ext_vector_type(4)));
typedef unsigned u32x4 __attribute__((ext_vector_type(4)));
constexpr int BM = 256, BK = 64, HALF = 128, HTB = HALF * BK * 2  , STAGE_BYTES = 8 * HTB, NXCD = 8, WGM = 8;

__host__ __device__ __forceinline__ int lds_byte(int r, int c) { const int st = (r >> 4) * 2 + (c >> 5), rr = r & 15, cc = c & 31, ob = rr * 64 + cc * 2; return st * 1024 + (ob ^ (((ob >> 9) & 1) << 5)); }
__host__ __device__ __forceinline__ void stage_rc(int b, int& R, int& C) { const int st = b / 1024, sb = b % 1024, swz = sb ^ (((sb >> 9) & 1) << 5); R = (st >> 1) * 16 + swz / 64; C = (st & 1) * 32 + (swz % 64) / 2; }
__host__ __device__ __forceinline__ int perm32(int rho) { const int n = rho >> 4, i = rho & 15; return 8 * (i >> 2) + 4 * n + (i & 3); }

struct Unit { int pm, pn; };
struct Gemm { const bf16_t* A; const bf16_t* Bt; int M, N, K; };

struct StaticOrder {
    int nM, nN, nwg, G, c;
    __host__ __device__ void init(int M, int N, int G_, int c_) { nM = M / BM; nN = N / BM; nwg = nM * nN; G = G_; c = c_; }
    __host__ __device__ bool next(int i, Unit& u) const {
        const long L = (long)i * G + c; if (L >= nwg) return false;
        int wgid = (int)L; { const int q = nwg / NXCD, r = nwg % NXCD, xcd = wgid % NXCD, off = wgid / NXCD; wgid = (xcd < r ? xcd * (q + 1) : r * (q + 1) + (xcd - r) * q) + off; }
        const int nig = WGM * nN, gid = wgid / nig, fm = gid * WGM, gsz = (nM - fm) < WGM ? (nM - fm) : WGM;
        u.pm = fm + ((wgid % nig) % gsz); u.pn = (wgid % nig) / gsz; return true;
    }
    __device__ __forceinline__ void a_ready(const Unit&) const {}
    __device__ __forceinline__ void done(const Unit&) const {}
};

__device__ __forceinline__ unsigned cvt_pk_bf16(float lo, float hi) { unsigned r; asm volatile("v_cvt_pk_bf16_f32 %0, %1, %2" : "=v"(r) : "v"(lo), "v"(hi)); return r; }
typedef float f32x2 __attribute__((ext_vector_type(2)));
__device__ __forceinline__ f32x2 gelu_pk(f32x2 v) {
    const f32x2 av = __builtin_elementwise_abs(v), d = av * 0.2316418882f + 1.0f;
    f32x2 t; t.x = __builtin_amdgcn_rcpf(d.x); t.y = __builtin_amdgcn_rcpf(d.y);
    f32x2 q = t * 0.5307027145f + (-0.7265760135f); q = q * t + 0.7107068705f; q = q * t + (-0.142248368f); q = q * t + 0.127414796f; q = q * t;
    const f32x2 s = (v * v) * (-0.72134752044f);
    f32x2 e; e.x = __builtin_amdgcn_exp2f(s.x); e.y = __builtin_amdgcn_exp2f(s.y);
    const f32x2 m = v * (q * e), r = v - m;
    f32x2 o; o.x = v.x < 0.f ? m.x : r.x; o.y = v.y < 0.f ? m.y : r.y; return o;
}

template <int ACT  > struct EpiBf16 {
    static constexpr bool PERM = true, AFTER_DRAIN = false, CHAIN = false; static_assert(ACT == 0 || ACT == 1, "EpiBf16: ACT is 0 (none) or 1 (gelu_pk)");
    bf16_t* O; int ldc; const float* bias; int split_cols; size_t split_stride; float scale0;
    __device__ __forceinline__ void operator()(const f32x4 (&acc)[2][2][4][2], const Unit& u, int wr, int wc, int fr, int fq) const {
        const int row0 = u.pm * BM + wr * 64 + fr; int colt = u.pn * BM; bf16_t* base = O;
        float sc = 1.f; if (split_cols) { const int t = colt / split_cols; base += (size_t)t * split_stride; colt -= t * split_cols; if (t == 0) sc = scale0; }
        const int col0 = colt + wc * 32 + 8 * fq, bcol0 = u.pn * BM + wc * 32 + 8 * fq;
        f32x4 bv[2][2];
#pragma unroll
        for (int bj = 0; bj < 2; ++bj)
#pragma unroll
            for (int n = 0; n < 2; ++n) bv[bj][n] = bias ? *(const f32x4*)(bias + bcol0 + bj * HALF + 4 * n) : (f32x4){0.f, 0.f, 0.f, 0.f};
#pragma unroll
        for (int ai = 0; ai < 2; ++ai)
#pragma unroll
            for (int m = 0; m < 4; ++m) { bf16_t* rowp = base + (size_t)(row0 + ai * HALF + m * 16) * ldc + col0;
#pragma unroll
                for (int bj = 0; bj < 2; ++bj) { f32x4 v0 = acc[ai][bj][m][0] + bv[bj][0], v1 = acc[ai][bj][m][1] + bv[bj][1];
                    if (ACT == 1) { f32x2 a = gelu_pk((f32x2){v0[0], v0[1]}), b = gelu_pk((f32x2){v0[2], v0[3]}), c = gelu_pk((f32x2){v1[0], v1[1]}), d = gelu_pk((f32x2){v1[2], v1[3]});
                        v0 = (f32x4){a.x, a.y, b.x, b.y}; v1 = (f32x4){c.x, c.y, d.x, d.y}; }
                    v0 = v0 * sc; v1 = v1 * sc; u32x4 w; w.x = cvt_pk_bf16(v0[0], v0[1]); w.y = cvt_pk_bf16(v0[2], v0[3]); w.z = cvt_pk_bf16(v1[0], v1[1]); w.w = cvt_pk_bf16(v1[2], v1[3]);
                    *(u32x4*)(rowp + bj * HALF) = w; } }
    }
};

template <class Epi, class Sched, bool ALIGN_EPI = false, bool SP2 = false>
__device__ __forceinline__ void gemm_phase(PG8_LAS unsigned char* lds, const Gemm g, const Sched& S, const Epi& E, const int tid_in) {
    int tid_l = tid_in; asm volatile("" : "+v"(tid_l));
    const int tid = tid_l, wid = __builtin_amdgcn_readfirstlane(tid >> 6), lane = tid & 63, wr = wid >> 2, wc = wid & 3, fr = lane & 15, fq = lane >> 4;
    const int K = g.K, nt = K / BK;
    unsigned voffA[2], voffB[2];
#pragma unroll
    for (int i = 0; i < 2; ++i) { int R, C; stage_rc(tid * 16 + i * 8192, R, C); const int Rb = Epi::PERM ? ((R & ~31) + perm32(R & 31)) : R;
        voffA[i] = (unsigned)(R * K + C) * 2u; voffB[i] = (unsigned)(Rb * K + C) * 2u; }
    const size_t kstep = (size_t)(BK * 2);
    const size_t hstep = (size_t)HALF * K * 2;
    const size_t tstep = 2 * hstep;
    const unsigned ldsw = (unsigned)wid * 1024u;
    const int aoff = lds_byte(wr * 64 + fr, fq * 8), boff = lds_byte(wc * 32 + fr, fq * 8);
#define PG8_SA(b, h) (((b) * 2 + (h)) * HTB)
#define PG8_SB(b, h) ((4 + (b) * 2 + (h)) * HTB)
#define PG8_STAGE(bufoff, gbase, voff) do { _Pragma("unroll") for (int _i = 0; _i < 2; ++_i) \
        __builtin_amdgcn_global_load_lds((const unsigned*)((const char*)(gbase) + (voff)[_i]), (PG8_LAS unsigned*)(lds + (bufoff) + ldsw + _i * 8192), 16, 0, 0); } while (0)
#define PG8_LDA(dst, b, h) do { _Pragma("unroll") for (int m = 0; m < 4; ++m) _Pragma("unroll") for (int k = 0; k < 2; ++k) dst[m][k] = *(const PG8_LAS bf16x8*)(lds + PG8_SA(b, h) + aoff + m * 2048 + k * 1024); } while (0)
#define PG8_LDB(dst, b, h) do { _Pragma("unroll") for (int n = 0; n < 2; ++n) _Pragma("unroll") for (int k = 0; k < 2; ++k) dst[n][k] = *(const PG8_LAS bf16x8*)(lds + PG8_SB(b, h) + boff + n * 2048 + k * 1024); } while (0)
#define PG8_MMA(ai, bj, At, Bt) do { __builtin_amdgcn_s_setprio(1); _Pragma("unroll") for (int m = 0; m < 4; ++m) _Pragma("unroll") for (int n = 0; n < 2; ++n) _Pragma("unroll") for (int k = 0; k < 2; ++k) \
        acc[ai][bj][m][n] = __builtin_amdgcn_mfma_f32_16x16x32_bf16(Bt[n][k], At[m][k], acc[ai][bj][m][n], 0, 0, 0); __builtin_amdgcn_s_setprio(0); } while (0)
#define PG8_WAIT_V(n) asm volatile("s_waitcnt vmcnt(" #n ")" ::: "memory")
#define PG8_WAIT_L(n) asm volatile("s_waitcnt lgkmcnt(" #n ")" ::: "memory")
#define PG8_BAR __builtin_amdgcn_s_barrier()
#define PG8_SCHED __builtin_amdgcn_sched_barrier(0)
    Unit cur, nxt; int ui = 0;
    if (!S.next(0, cur)) return;
    f32x4 acc[2][2][4][2];
#pragma unroll
    for (int a = 0; a < 2; ++a)
#pragma unroll
        for (int b = 0; b < 2; ++b)
#pragma unroll
            for (int m = 0; m < 4; ++m)
#pragma unroll
                for (int n = 0; n < 2; ++n) acc[a][b][m][n] = (f32x4){0.f, 0.f, 0.f, 0.f};
    bf16x8 At[4][2], B0[2][2], B1[2][2];
    const char* cA = (const char*)g.A + (size_t)cur.pm * tstep; const char* cB = (const char*)g.Bt + (size_t)cur.pn * tstep;
    S.a_ready(cur);
    if constexpr (SP2) {
        PG8_STAGE(PG8_SB(0, 0), cB, voffB); PG8_STAGE(PG8_SB(0, 1), cB + hstep, voffB); PG8_STAGE(PG8_SA(0, 0), cA, voffA); PG8_STAGE(PG8_SA(0, 1), cA + hstep, voffA);
        if (wr == 1) PG8_BAR;
        PG8_WAIT_V(2); PG8_BAR;
        PG8_STAGE(PG8_SB(1, 0), cB + kstep, voffB); PG8_STAGE(PG8_SA(1, 0), cA + kstep, voffA); PG8_STAGE(PG8_SB(1, 1), cB + hstep + kstep, voffB);
        PG8_WAIT_V(6); PG8_BAR;
    } else {
        PG8_STAGE(PG8_SB(0, 0), cB, voffB); PG8_STAGE(PG8_SA(0, 0), cA, voffA); PG8_STAGE(PG8_SB(0, 1), cB + hstep, voffB); PG8_STAGE(PG8_SA(0, 1), cA + hstep, voffA);
        if (wr == 1) PG8_BAR;
        PG8_WAIT_V(4); PG8_BAR;
        PG8_STAGE(PG8_SB(1, 0), cB + kstep, voffB); PG8_STAGE(PG8_SA(1, 0), cA + kstep, voffA); PG8_STAGE(PG8_SB(1, 1), cB + hstep + kstep, voffB);
        PG8_WAIT_V(6); PG8_BAR;
    }
    for (;;) {
        const bool has_next = S.next(ui + 1, nxt);
        const char* nA = has_next ? (const char*)g.A + (size_t)nxt.pm * tstep : cA; const char* nB = has_next ? (const char*)g.Bt + (size_t)nxt.pn * tstep : cB;
        for (int t = 0; t < nt; t += 2) {
            const bool last = (t == nt - 2);
            const char* a1 = cA + (size_t)(t + 1) * kstep;
            const char* a2 = last ? nA : cA + (size_t)(t + 2) * kstep; const char* b2 = last ? nB : cB + (size_t)(t + 2) * kstep;
            const char* a3 = a2 + kstep; const char* b3 = b2 + kstep;
            if (last && has_next) S.a_ready(nxt);
            if constexpr (SP2) {
            PG8_LDB(B0, 0, 0); PG8_LDB(B1, 0, 1); PG8_SCHED; PG8_LDA(At, 0, 0); PG8_STAGE(PG8_SA(1, 1), a1 + hstep, voffA);
            PG8_WAIT_V(8); PG8_WAIT_L(0); PG8_BAR; PG8_MMA(0, 0, At, B0); PG8_MMA(0, 1, At, B1); PG8_BAR; PG8_SCHED;
            PG8_LDA(At, 0, 1); PG8_STAGE(PG8_SB(0, 0), b2, voffB); PG8_STAGE(PG8_SB(0, 1), b2 + hstep, voffB); PG8_STAGE(PG8_SA(0, 0), a2, voffA);
            PG8_WAIT_V(8); PG8_WAIT_L(0); PG8_BAR; PG8_MMA(1, 0, At, B0); PG8_MMA(1, 1, At, B1); PG8_BAR; PG8_SCHED;
            PG8_LDB(B0, 1, 0); PG8_LDB(B1, 1, 1); PG8_SCHED; PG8_LDA(At, 1, 0); PG8_STAGE(PG8_SA(0, 1), a2 + hstep, voffA);
            PG8_WAIT_V(8); PG8_WAIT_L(0); PG8_BAR; PG8_MMA(0, 0, At, B0); PG8_MMA(0, 1, At, B1); PG8_BAR; PG8_SCHED;
            PG8_LDA(At, 1, 1); PG8_STAGE(PG8_SB(1, 0), b3, voffB); PG8_STAGE(PG8_SB(1, 1), b3 + hstep, voffB); PG8_STAGE(PG8_SA(1, 0), a3, voffA);
            PG8_WAIT_V(8); PG8_WAIT_L(0); PG8_BAR; PG8_MMA(1, 0, At, B0); PG8_MMA(1, 1, At, B1); PG8_BAR; PG8_SCHED;
            } else {
            PG8_LDB(B0, 0, 0); PG8_SCHED; PG8_LDA(At, 0, 0); PG8_STAGE(PG8_SA(1, 1), a1 + hstep, voffA);
            PG8_WAIT_L(8); PG8_BAR; PG8_WAIT_L(0); PG8_MMA(0, 0, At, B0); PG8_BAR; PG8_SCHED;
            PG8_LDB(B1, 0, 1); PG8_STAGE(PG8_SB(0, 0), b2, voffB);
            PG8_BAR; PG8_WAIT_L(0); PG8_MMA(0, 1, At, B1); PG8_BAR;
            PG8_LDA(At, 0, 1); PG8_STAGE(PG8_SA(0, 0), a2, voffA);
            PG8_BAR; PG8_WAIT_L(0); PG8_MMA(1, 0, At, B0); PG8_BAR; PG8_SCHED;
            PG8_STAGE(PG8_SB(0, 1), b2 + hstep, voffB);
            PG8_WAIT_V(6); PG8_BAR; PG8_MMA(1, 1, At, B1); PG8_BAR;
            PG8_LDB(B0, 1, 0); PG8_SCHED; PG8_LDA(At, 1, 0); PG8_STAGE(PG8_SA(0, 1), a2 + hstep, voffA);
            PG8_WAIT_L(8); PG8_BAR; PG8_WAIT_L(0); PG8_MMA(0, 0, At, B0); PG8_BAR; PG8_SCHED;
            PG8_LDB(B1, 1, 1); PG8_STAGE(PG8_SB(1, 0), b3, voffB);
            PG8_BAR; PG8_WAIT_L(0); PG8_MMA(0, 1, At, B1); PG8_BAR;
            PG8_LDA(At, 1, 1); PG8_STAGE(PG8_SA(1, 0), a3, voffA);
            PG8_BAR; PG8_WAIT_L(0); PG8_MMA(1, 0, At, B0); PG8_BAR; PG8_SCHED;
            PG8_STAGE(PG8_SB(1, 1), b3 + hstep, voffB);
            PG8_WAIT_V(6); PG8_BAR; PG8_MMA(1, 1, At, B1); PG8_BAR;
            }
        }
        if constexpr (ALIGN_EPI) { if (wr == 0) PG8_BAR; }
        if constexpr (!Epi::AFTER_DRAIN) { E(acc, cur, wr, wc, fr, fq); S.done(cur); }
        if (!has_next) break;
        if constexpr (!Epi::CHAIN) {
#pragma unroll
        for (int a = 0; a < 2; ++a)
#pragma unroll
            for (int b = 0; b < 2; ++b)
#pragma unroll
                for (int m = 0; m < 4; ++m)
#pragma unroll
                    for (int n = 0; n < 2; ++n) acc[a][b][m][n] = (f32x4){0.f, 0.f, 0.f, 0.f};
        }
        cur = nxt; cA = nA; cB = nB; ++ui;
        if constexpr (ALIGN_EPI) { if (wr == 1) PG8_BAR; }
    }
    PG8_WAIT_V(0);
    if constexpr (!ALIGN_EPI) { if (wr == 0) PG8_BAR; }
    PG8_BAR;
    if constexpr (Epi::AFTER_DRAIN) { E.fused(acc, cur, wr, wc, fr, fq, lds, wid, lane); S.done(cur); }
#undef PG8_SA
#undef PG8_SB
#undef PG8_STAGE
#undef PG8_LDA
#undef PG8_LDB
#undef PG8_MMA
#undef PG8_WAIT_V
#undef PG8_WAIT_L
#undef PG8_BAR
#undef PG8_SCHED
}
}
#define GAS __attribute__((address_space(1)))
#define LAS __attribute__((address_space(3)))
typedef unsigned short bf16;
typedef unsigned v4u __attribute__((ext_vector_type(4)));
typedef float f32x4 __attribute__((ext_vector_type(4)));
typedef short bf16x8 __attribute__((ext_vector_type(8)));
typedef GAS unsigned gu32;
typedef GAS unsigned long long gu64;
#define RLX_AGENT __ATOMIC_RELAXED, __HIP_MEMORY_SCOPE_AGENT
#define LDS_WAIT() asm volatile("s_waitcnt lgkmcnt(0)" ::: "memory")
#define VM_WAIT() asm volatile("s_waitcnt vmcnt(0)" ::: "memory")
__device__ __forceinline__ unsigned long long rt() { return __builtin_amdgcn_s_memrealtime(); }
__device__ __forceinline__ unsigned f2bf(float f) { unsigned u = __builtin_bit_cast(unsigned, f); return (u + 0x7fffu + ((u >> 16) & 1u)) >> 16; }
__device__ __forceinline__ unsigned pk2(float lo, float hi) { return f2bf(lo) | (f2bf(hi) << 16); }

#define XB_TMO      128
#define XB_XCNT(j)  (256  + 64 * (j))
#define XB_XSUB(j)  (1280 + 64 * (j))
#define XB_XGEN(j)  (2304 + 64 * (j))
#define XB_TOP      3328
#define XB_TOPGEN   3392
#define XCD_BAR_WORDS 3456
#define XB_SPIN_CAP (1u << 18)

__device__ __forceinline__ unsigned xb_ld(unsigned* p)              { return __hip_atomic_load(p, __ATOMIC_RELAXED, __HIP_MEMORY_SCOPE_AGENT); }
__device__ __forceinline__ unsigned xb_add(unsigned* p, unsigned v) { return __hip_atomic_fetch_add(p, v, __ATOMIC_RELAXED, __HIP_MEMORY_SCOPE_AGENT); }
__device__ __forceinline__ unsigned xb_xcc_id() { return (unsigned)__builtin_amdgcn_s_getreg((3 << 11) | 20) & 0xFu; }
#define XB_SPIN(cond, bar) do { unsigned _sp = 0; while (cond) { __builtin_amdgcn_s_sleep(1); \
    if ((++_sp & 255u) == 0u) { if (xb_ld(&(bar)[XB_TMO])) break; if (_sp > XB_SPIN_CAP) { atomicAdd(&(bar)[XB_TMO], 1u); break; } } } } while (0)

struct XcdBarrier {
    unsigned* bar; unsigned x;
    volatile LAS unsigned* st;
};

__device__ __forceinline__ XcdBarrier xcd_barrier_post(unsigned* bar, volatile LAS unsigned* st, const int tid) {
    XcdBarrier b; b.bar = bar; b.x = xb_xcc_id(); b.st = st;
    if (tid == 0) (void)xb_add(&bar[XB_XCNT(b.x)], 1u);
    return b;
}
__device__ __forceinline__ void xcd_barrier_complete(unsigned* bar, unsigned x, unsigned& nloc, unsigned& nx) {
    const unsigned G = gridDim.x * gridDim.y * gridDim.z;
    unsigned sum, cnt, mine, sp = 0u;
    for (;;) {
        sum = 0u; cnt = 0u; mine = 0u;
#pragma unroll
        for (unsigned j = 0; j < 16; ++j) { const unsigned c = xb_ld(&bar[XB_XCNT(j)]); sum += c; cnt += (c > 0u) ? 1u : 0u; mine = (j == x) ? c : mine; }
        if (sum == G) break;
        __builtin_amdgcn_s_sleep(1);
        if ((++sp & 255u) == 0u) { if (xb_ld(&bar[XB_TMO])) break; if (sp > XB_SPIN_CAP) { atomicAdd(&bar[XB_TMO], 1u); break; } }
    }
    nloc = mine > 0u ? mine : 1u; nx = cnt > 0u ? cnt : 1u;
}

__device__ __forceinline__ void xcd_barrier(const XcdBarrier& b, const int tid) {
    asm volatile("s_waitcnt vmcnt(0)" ::: "memory");
    __syncthreads();
    if (tid == 0) {
        unsigned* bar = b.bar;
        __builtin_amdgcn_s_waitcnt(0);
        unsigned nloc = b.st[0], nx = b.st[1];
        if (nloc == 0u) { xcd_barrier_complete(bar, b.x, nloc, nx); b.st[0] = nloc; b.st[1] = nx; }
        const unsigned old = xb_add(&bar[XB_XSUB(b.x)], 1u);
        const unsigned gen = old / nloc;
        if (old + 1u == (gen + 1u) * nloc) {
            __builtin_amdgcn_fence(__ATOMIC_RELEASE, "agent");
            asm volatile("s_waitcnt vmcnt(0)" ::: "memory");
            const unsigned og = xb_add(&bar[XB_TOP], 1u);
            const unsigned tg = og / nx;
            if (og + 1u == (tg + 1u) * nx) xb_add(&bar[XB_TOPGEN], 1u);
            else XB_SPIN(xb_ld(&bar[XB_TOPGEN]) == tg, bar);
            __builtin_amdgcn_fence(__ATOMIC_ACQUIRE, "agent");
            xb_add(&bar[XB_XGEN(b.x)], 1u);
            asm volatile("s_waitcnt vmcnt(0)" ::: "memory");
        } else {
            XB_SPIN(xb_ld(&bar[XB_XGEN(b.x)]) == gen, bar);
            __builtin_amdgcn_fence(__ATOMIC_ACQUIRE, "agent");
            asm volatile("s_waitcnt vmcnt(0)" ::: "memory");
        }
    }
    __syncthreads();
}
namespace att {
typedef __attribute__((ext_vector_type(8))) short bf16x8;
typedef __attribute__((ext_vector_type(4))) short s16x4;
typedef __attribute__((ext_vector_type(16))) float f32x16;
typedef __attribute__((ext_vector_type(4))) unsigned u32x4;
typedef unsigned short bf16;
constexpr int D = 128, NW = 8, QBLK = 32, KVBLK = 64, LDQ = 1024;
constexpr float SCALE = 0.088388347648318440f, THR = 8.f;
constexpr int SHM_V = KVBLK * D * 2, SHM_K = KVBLK * D * 2;
constexpr int WS_OFF = 2 * SHM_V + 2 * SHM_K, TAB_OFF = WS_OFF + NW * 64 * 4, ATT_LDS_BYTES = TAB_OFF + 2048;
#define KSWZ(row, colB) ((row) * 256 + ((colB) ^ (((row) & 7) << 4)))
#define SBAR() __builtin_amdgcn_sched_barrier(0)
__device__ __forceinline__ int crow(int r, int hi) { return (r & 3) + 8 * (r >> 2) + 4 * hi; }
__device__ __forceinline__ unsigned cvtpk(float lo, float hi) { unsigned r; asm volatile("v_cvt_pk_bf16_f32 %0, %1, %2" : "=v"(r) : "v"(lo), "v"(hi)); return r; }
__device__ __forceinline__ bf16x8 ld8(const bf16* p) { return *reinterpret_cast<const bf16x8*>(p); }

__device__ __forceinline__ void partialSM(f32x16& p0, f32x16& p1, float& m_reg, float& mn, float& alpha) {
  constexpr float C = SCALE * 1.4426950408889634f;
  float pmax = p0[0]; for (int r = 1; r < 16; ++r) pmax = fmaxf(pmax, p0[r]); for (int r = 0; r < 16; ++r) pmax = fmaxf(pmax, p1[r]);
  { auto rr = __builtin_amdgcn_permlane32_swap(__float_as_uint(pmax), __float_as_uint(pmax), false, false);
    pmax = fmaxf(__uint_as_float(rr[0]), __uint_as_float(rr[1])); }
  if (__builtin_expect(__all(pmax - m_reg <= THR / SCALE), 1)) { mn = m_reg; alpha = 1.f; }
  else { mn = fmaxf(m_reg, pmax); alpha = __builtin_amdgcn_exp2f((m_reg - mn) * C); m_reg = mn; }
  float mnC = -mn * C;
  for (int r = 0; r < 16; ++r) p0[r] = fmaf(p0[r], C, mnC); for (int r = 0; r < 16; ++r) p1[r] = fmaf(p1[r], C, mnC);
  for (int r = 0; r < 16; ++r) p0[r] = __builtin_amdgcn_exp2f(p0[r]);
}
__device__ __forceinline__ void finishSM(f32x16& p0, f32x16& p1, float alpha, float& l_reg, bf16x8& pa0, bf16x8& pa1, bf16x8& pa2, bf16x8& pa3) {
  for (int r = 0; r < 16; ++r) p1[r] = __builtin_amdgcn_exp2f(p1[r]);
  float ps = 0; for (int r = 0; r < 16; ++r) ps += p0[r]; for (int r = 0; r < 16; ++r) ps += p1[r];
  { auto rr = __builtin_amdgcn_permlane32_swap(__float_as_uint(ps), __float_as_uint(ps), false, false);
    ps = __uint_as_float(rr[0]) + __uint_as_float(rr[1]); }
  l_reg = l_reg * alpha + ps;
#define PK4(P, BASE, OUT) do { unsigned a0 = cvtpk(P[BASE + 0], P[BASE + 1]), a1 = cvtpk(P[BASE + 2], P[BASE + 3]);   \
    unsigned b0 = cvtpk(P[BASE + 4], P[BASE + 5]), b1 = cvtpk(P[BASE + 6], P[BASE + 7]);                              \
    auto r0 = __builtin_amdgcn_permlane32_swap(a0, b0, false, false); auto r1 = __builtin_amdgcn_permlane32_swap(a1, b1, false, false); \
    u32x4 w = {r0[0], r1[0], r0[1], r1[1]}; OUT = *reinterpret_cast<bf16x8*>(&w); } while (0)
  PK4(p0, 0, pa0); PK4(p0, 8, pa1); PK4(p1, 0, pa2); PK4(p1, 8, pa3);
#undef PK4
}
__device__ __forceinline__ void qkt(f32x16& p0, f32x16& p1, const bf16* Ks, const bf16x8* qr, int r32, int hi) {
  p0 = f32x16{}; p1 = f32x16{};
  const char* kb[4];
#pragma unroll
  for (int dd = 0; dd < 4; ++dd) kb[dd] = (const char*)Ks + KSWZ(r32, (dd * 16 + hi * 8) * 2);
#pragma unroll
  for (int d0 = 0; d0 < 8; ++d0) { const char* a = kb[d0 & 3] + (d0 >> 2) * 128;
    bf16x8 b0 = *reinterpret_cast<const bf16x8*>(a);
    bf16x8 b1 = *reinterpret_cast<const bf16x8*>(a + 32 * 256);
    p0 = __builtin_amdgcn_mfma_f32_32x32x16_bf16(b0, qr[d0], p0, 0, 0, 0);
    p1 = __builtin_amdgcn_mfma_f32_32x32x16_bf16(b1, qr[d0], p1, 0, 0, 0); }
}
__device__ __forceinline__ int v_st(int k, int c) { const int kk = (k & ~0xC) | ((k & 4) << 1) | ((k & 8) >> 1); return ((kk >> 3) * 4 + (c >> 5)) * 512 + ((kk & 7) * 32 + (c & 31)) * 2; }
__device__ __forceinline__ int v_rd_base(int lane) { return ((lane & 3) << 3) | (((lane >> 2) & 3) << 6) | (((lane >> 4) & 1) << 5) | (((lane >> 5) & 1) << 8); }
constexpr int v_rd_off(int d0, int ks, int half) { return d0 * 512 + ks * 4096 + half * 2048; }
template <int OFF> __device__ __forceinline__ s16x4 tr_read(int vb) {
  s16x4 r; asm volatile("ds_read_b64_tr_b16 %0, %1 offset:%2" : "=&v"(r) : "v"(vb), "i"(OFF) : "memory"); return r;
}
template <int D0> __device__ __forceinline__ void pv_one(f32x16& od, int vb, bf16x8 pa0, bf16x8 pa1, bf16x8 pa2, bf16x8 pa3) {
  const s16x4 l0 = tr_read<v_rd_off(D0, 0, 0)>(vb), h0 = tr_read<v_rd_off(D0, 0, 1)>(vb), l1 = tr_read<v_rd_off(D0, 1, 0)>(vb), h1 = tr_read<v_rd_off(D0, 1, 1)>(vb);
  const s16x4 l2 = tr_read<v_rd_off(D0, 2, 0)>(vb), h2 = tr_read<v_rd_off(D0, 2, 1)>(vb), l3 = tr_read<v_rd_off(D0, 3, 0)>(vb), h3 = tr_read<v_rd_off(D0, 3, 1)>(vb);
  asm volatile("s_waitcnt lgkmcnt(0)" ::: "memory"); SBAR();
#define PK(L, H) (bf16x8){L[0], L[1], L[2], L[3], H[0], H[1], H[2], H[3]}
  od = __builtin_amdgcn_mfma_f32_32x32x16_bf16(pa0, PK(l0, h0), od, 0, 0, 0);
  od = __builtin_amdgcn_mfma_f32_32x32x16_bf16(pa1, PK(l1, h1), od, 0, 0, 0);
  od = __builtin_amdgcn_mfma_f32_32x32x16_bf16(pa2, PK(l2, h2), od, 0, 0, 0);
  od = __builtin_amdgcn_mfma_f32_32x32x16_bf16(pa3, PK(l3, h3), od, 0, 0, 0);
#undef PK
}
__device__ __forceinline__ void pv_d0(f32x16* o, int vb, bf16x8 pa0, bf16x8 pa1, bf16x8 pa2, bf16x8 pa3) {
  pv_one<0>(o[0], vb, pa0, pa1, pa2, pa3); pv_one<1>(o[1], vb, pa0, pa1, pa2, pa3); pv_one<2>(o[2], vb, pa0, pa1, pa2, pa3); pv_one<3>(o[3], vb, pa0, pa1, pa2, pa3);
}

struct Unit {
  const bf16* Q; bf16* O;
  const bf16* K0; const bf16* V0;
  const bf16* K1; const bf16* V1;
  int n0, n1, ldk;
  int mode;
  int a, b;
  float sink2;
  const float* tab;
};
__device__ __forceinline__ void mask_nat(f32x16& p0, f32x16& p1, bool rowvis, int cs4, int cqb, const float* trow) {
  const float NEG = -__builtin_inff();
  if (!rowvis) {
#pragma unroll
    for (int r = 0; r < 16; ++r) { p0[r] = NEG; p1[r] = NEG; }
    return; }
#pragma unroll
  for (int r = 0; r < 16; ++r) { const int cc = (r & 3) + 8 * (r >> 2);
    { const int i0 = min(max(cc - cqb, 0), 30); const float bv = trow[i0]; p0[r] = ((unsigned)(cc - cs4) < 16u) ? p0[r] + bv : NEG; }
    { const int i1 = min(max(cc + 32 - cqb, 0), 30); const float bv = trow[i1]; p1[r] = ((unsigned)(cc + 32 - cs4) < 16u) ? p1[r] + bv : NEG; } }
}
__device__ __forceinline__ void mask_win(f32x16& p0, f32x16& p1, int dq) {
  const float NEG = -__builtin_inff();
#pragma unroll
  for (int r = 0; r < 16; ++r) { const int cc = (r & 3) + 8 * (r >> 2);
    if ((unsigned)(dq + cc) > 256u) p0[r] = NEG;
    if ((unsigned)(dq + cc + 32) > 256u) p1[r] = NEG; }
}

__device__ __forceinline__ void attn_unit(const Unit& U, char* lds, const int tid_in) {
  int tid_l = tid_in; asm volatile("" : "+v"(tid_l));
  const int tid = tid_l, wid = __builtin_amdgcn_readfirstlane(tid >> 6), lane = tid & 63, r32 = lane & 31, hi = lane >> 5;
  bf16* V_lds = (bf16*)lds; bf16* K_lds = (bf16*)(lds + 2 * SHM_V);
  float* ws = (float*)(lds + WS_OFF) + wid * 64; float* li_l = ws; float* al_l = ws + 32;
  float* tabL = (float*)(lds + TAB_OFF);
  if (U.mode == 1) { for (int i = tid; i < 465; i += 512) tabL[i] = U.tab[i] * (1.0f / SCALE); }
  float m_reg = -1e30f, l_reg = 0; f32x16 o[4] = {}; bf16x8 qr[8];
  const bf16* Qw = U.Q + (long)(wid * QBLK + r32) * LDQ + hi * 8;
#pragma unroll
  for (int d0 = 0; d0 < 8; ++d0) qr[d0] = ld8(Qw + d0 * 16);
  const int ldk = U.ldk, n0 = U.n0, NT = U.n0 + U.n1;
  const int sr = tid >> 4, sc = (tid & 15) * 8, vst0 = v_st(sr, sc), vst1 = v_st(32 + sr, sc);
  const int vb0 = (int)(uintptr_t)V_lds + v_rd_base(lane);
  struct { bf16x8 vs0, vs1, ks0, ks1; } sr_[1];
  const int maskA = U.a, maskB = U.b;
#define SLOAD(i, t) do { const int t_ = (t); const bf16* Kp_ = t_ < n0 ? U.K0 + (long)t_ * KVBLK * ldk : U.K1 + (long)(t_ - n0) * KVBLK * ldk;  \
    const bf16* Vp_ = t_ < n0 ? U.V0 + (long)t_ * KVBLK * ldk : U.V1 + (long)(t_ - n0) * KVBLK * ldk;                                         \
    sr_[i].vs0 = ld8(&Vp_[(long)sr * ldk + sc]); sr_[i].vs1 = ld8(&Vp_[(long)(32 + sr) * ldk + sc]);                                           \
    sr_[i].ks0 = ld8(&Kp_[(long)sr * ldk + sc]); sr_[i].ks1 = ld8(&Kp_[(long)(32 + sr) * ldk + sc]); } while (0)
#define SWRITE(b, i) do { *(bf16x8*)((char*)V_lds + (b) * SHM_V + vst0) = sr_[i].vs0;          \
    *(bf16x8*)((char*)V_lds + (b) * SHM_V + vst1) = sr_[i].vs1; int kc = sc * 2;               \
    *(bf16x8*)((char*)K_lds + (b) * SHM_K + KSWZ(sr, kc)) = sr_[i].ks0;                       \
    *(bf16x8*)((char*)K_lds + (b) * SHM_K + KSWZ(32 + sr, kc)) = sr_[i].ks1; } while (0)
#define SWAIT() asm volatile("s_waitcnt vmcnt(0)" ::: "memory")
#define RESC(a) do { if (__any((a) < 1.f)) { if (hi == 0) al_l[r32] = (a); asm volatile("s_waitcnt lgkmcnt(0)" ::: "memory"); \
    for (int d = 0; d < 4; ++d) for (int r = 0; r < 16; ++r) o[d][r] *= al_l[crow(r, hi)]; } } while (0)
#define MASK(P0, P1, t) do { if (U.mode != 0 && (t) >= n0) { const int tl_ = (t) - n0; int ln_ = lane; asm volatile("" : "+v"(ln_));     \
    const int r32_ = ln_ & 31, hi_ = ln_ >> 5;                                                                                                  \
    if (U.mode == 1) { const int rq_ = maskA + (wid >> 1), rsq_ = min(max(rq_ - 4, 0), 56), kr_ = maskB + tl_; const bool rv_ = (unsigned)(kr_ - rsq_) < 8u; const int dr_ = rv_ ? kr_ - rq_ + 7 : 0; \
        const int cq_ = 32 * (wid & 1) + r32_, cs_ = min(max(cq_ - 8, 0), 48);                                                                   \
        mask_nat(P0, P1, rv_, cs_ - 4 * hi_, cq_ - 15 - 4 * hi_, tabL + dr_ * 31); }                                                             \
    else { mask_win(P0, P1, maskB + tl_ * KVBLK - (maskA + 32 * wid + r32_) + 4 * hi_ + 128); } } } while (0)
  f32x16 pA0, pA1, pB0, pB1; float mnA, mnB, alA, alB; bf16x8 pa0, pa1, pa2, pa3;
  constexpr int SE = 0, SO = 0;
  SLOAD(SE, 0); asm volatile("s_waitcnt vmcnt(0)" ::: "memory"); SWRITE(0, SE); __syncthreads();
  qkt(pA0, pA1, K_lds, qr, r32, hi); MASK(pA0, pA1, 0); partialSM(pA0, pA1, m_reg, mnA, alA);
  SLOAD(SO, 1);
  SWAIT(); SWRITE(1, SO); __syncthreads();
  for (int j = 1; j + 1 < NT; j += 2) {
    SBAR(); SLOAD(SO, j + 1); SBAR();
    qkt(pB0, pB1, (bf16*)((char*)K_lds + SHM_K), qr, r32, hi);
    finishSM(pA0, pA1, alA, l_reg, pa0, pa1, pa2, pa3); SBAR();
    pv_d0(o, vb0, pa0, pa1, pa2, pa3); MASK(pB0, pB1, j); partialSM(pB0, pB1, m_reg, mnB, alB);
    __syncthreads(); SWAIT(); SWRITE(0, SE);
    RESC(alB); __syncthreads();
    SBAR(); SLOAD(SE, j + 2); SBAR();
    qkt(pA0, pA1, K_lds, qr, r32, hi);
    finishSM(pB0, pB1, alB, l_reg, pa0, pa1, pa2, pa3); SBAR();
    pv_d0(o, vb0 + (int)SHM_V, pa0, pa1, pa2, pa3); MASK(pA0, pA1, j + 1); partialSM(pA0, pA1, m_reg, mnA, alA);
    __syncthreads(); SWAIT(); SWRITE(1, SO);
    RESC(alA); __syncthreads();
  }
  SBAR(); qkt(pB0, pB1, (bf16*)((char*)K_lds + SHM_K), qr, r32, hi);
  finishSM(pA0, pA1, alA, l_reg, pa0, pa1, pa2, pa3); SBAR();
  pv_d0(o, vb0, pa0, pa1, pa2, pa3); MASK(pB0, pB1, NT - 1); partialSM(pB0, pB1, m_reg, mnB, alB);
  __syncthreads(); RESC(alB);
  finishSM(pB0, pB1, alB, l_reg, pa0, pa1, pa2, pa3); SBAR();
  pv_d0(o, vb0 + (int)SHM_V, pa0, pa1, pa2, pa3);
  l_reg += __builtin_amdgcn_exp2f(U.sink2 - m_reg * (SCALE * 1.4426950408889634f));
  if (hi == 0) li_l[r32] = l_reg; asm volatile("s_waitcnt lgkmcnt(0)" ::: "memory");
  float rli[16];
#pragma unroll
  for (int r = 0; r < 16; ++r) rli[r] = __builtin_amdgcn_rcpf(li_l[crow(r, hi)]);
  __syncthreads();
  { bf16* stg = (bf16*)(lds + wid * 8192);
#pragma unroll
    for (int r = 0; r < 16; ++r) { const int orow = crow(r, hi);
#pragma unroll
      for (int d0 = 0; d0 < 4; ++d0) stg[orow * 128 + d0 * 32 + r32] = (bf16)(cvtpk(o[d0][r] * rli[r], 0.f) & 0xffffu); }
    asm volatile("s_waitcnt lgkmcnt(0)" ::: "memory");
    bf16* Ow = U.O + (long)(wid * QBLK) * LDQ;
#pragma unroll
    for (int i = 0; i < 8; ++i) { const int row = 4 * i + (lane >> 4), ch = lane & 15; const u32x4 v = *(const u32x4*)(stg + row * 128 + ch * 8);
      *(u32x4*)(Ow + (long)row * LDQ + ch * 8) = v; } }
  __syncthreads();
#undef SLOAD
#undef SWRITE
#undef SWAIT
#undef RESC
#undef MASK
}
#undef KSWZ
#undef SBAR
}
constexpr int DM = 2048, R_CTX = 4096, R_LAT = 8192, RT = 12288, FF = 5632, NGU = 11264, DIN = 12288, HD = 128;
constexpr int NWAVES = 8, NTHR = 512;
constexpr float EPS_N = 1e-6f, SM_SCALE = 0.08838834764831845f;
constexpr size_t MiB = 1u << 20;
constexpr size_t WS_CTL = 0, CTL_ZERO_BYTES = 1 * MiB;
constexpr size_t WS_MODS = 1 * MiB;
constexpr size_t WS_ROPE = 2 * MiB;
constexpr size_t WS_CACHE = 4 * MiB;
constexpr size_t WS_W = 16 * MiB, W_LAYER = 200 * MiB;
constexpr size_t W_GU1 = 0, W_D1 = 44 * MiB, W_IN = 66 * MiB, W_B = 114 * MiB, W_O = 126 * MiB, W_GU2 = 134 * MiB, W_D2 = 178 * MiB;
constexpr size_t WS_H = 416 * MiB;
constexpr size_t WS_ACT = 464 * MiB;
constexpr size_t WS_Z = 596 * MiB;
constexpr size_t WS_QKVG = 884 * MiB;
constexpr size_t WS_END = 1172 * MiB;
constexpr int CW_BAR = 4096;
constexpr int EXCH_OFF = 131072, LDSCTL_OFF = 139264, MISC_OFF = LDSCTL_OFF + 320, LDS_BYTES = 147456;
constexpr size_t OUT_YP = 0, OUT_YS = 8388608, OUT_KGQA = 25165824, OUT_VGQA = 27262976, OUT_KNAT = 29360128, OUT_VNAT = 37748736, OUT_KWIN = 46137344, OUT_VWIN = 48234496, OUT_TOTAL = 50331648;

constexpr int MAP_GU = 1, MAP_IN = 2;
struct Args { const float* in[25]; float* out; unsigned char* ws; };

struct Frame {
    LAS unsigned char* lds;
    int tid, lane, wave, G, bid;
    float* out; unsigned char* ws;
};
#define CAS __attribute__((address_space(4)))
__device__ __forceinline__ const float* in_ptr(int k) { const CAS char* p = (const CAS char*)__builtin_amdgcn_kernarg_segment_ptr(); asm volatile("" : "+s"(p)); return *(const float* const CAS*)(p + 8 * k); }

__device__ __forceinline__ float shx(float v, int mask, int lane) { return __uint_as_float((unsigned)__builtin_amdgcn_ds_bpermute((lane ^ mask) << 2, (int)__float_as_uint(v))); }
__device__ __forceinline__ float wave_sum(float v, int lane) {
#pragma unroll
    for (int o = 1; o < 64; o <<= 1) v += shx(v, o, lane);
    return v;
}
__device__ __forceinline__ float bf2f(unsigned b) { return __uint_as_float(b << 16); }
__device__ __forceinline__ float bflo(unsigned w) { return __uint_as_float(w << 16); }
__device__ __forceinline__ float bfhi(unsigned w) { return __uint_as_float(w & 0xffff0000u); }
__device__ __forceinline__ float sigm(float x) { return 1.f / (1.f + __expf(-x)); }

__device__ __forceinline__ int rowmap(int MAP, int s) {
    if (MAP == 1) { const int n = s >= FF ? 1 : 0, j = s - FF * n, pn = j >> 7, jj = j & 127, wc = jj >> 5, fq = (jj & 31) >> 3, bj = (jj & 7) >> 2, e = jj & 3;
        return 256 * pn + 128 * bj + 32 * wc + 16 * n + 4 * fq + e; }
    if (MAP == 2) { const int pn = s >> 8, c = s & 255, bj = c >> 7, d = c & 127; const bool ropet = pn < 5 || (pn >= 18 && pn < 23);
        if (ropet) { const int h2 = d >> 6, n = (d & 63) >> 5, w1 = (d & 31) >> 4, fq = (d & 15) >> 2, e = d & 3; return 256 * pn + 128 * bj + 32 * (2 * h2 + w1) + 16 * n + 4 * fq + e; }
        const int wc = d >> 5, fq = (d & 31) >> 3, n = (d & 7) >> 2, e = d & 3; return 256 * pn + 128 * bj + 32 * wc + 16 * n + 4 * fq + e; }
    return s;
}
constexpr int IT_D1 = 5632, IT_IN = 8448, IT_B = 14592, IT_WO = 16128, IT_GU2 = 17152, IT_D2 = 22784, IT_END = 25600;
struct ItemD { const float* W; bf16* WT; int K, N, MAP, k0, n0; };
__device__ __forceinline__ void item_desc(int l, int it, unsigned char* wl, ItemD& d) {
    int loc; d.MAP = 0;
    if (it < IT_D1)       { d.W = in_ptr(13) + (size_t)l * DM * NGU; d.K = DM; d.N = NGU; d.WT = (bf16*)(wl + W_GU1); d.MAP = MAP_GU; loc = it; }
    else if (it < IT_IN)  { d.W = in_ptr(14) + (size_t)l * FF * DM; d.K = FF; d.N = DM; d.WT = (bf16*)(wl + W_D1); loc = it - IT_D1; }
    else if (it < IT_B)   { d.W = in_ptr(15) + (size_t)l * DM * DIN; d.K = DM; d.N = DIN; d.WT = (bf16*)(wl + W_IN); d.MAP = MAP_IN; loc = it - IT_IN; }
    else if (it < IT_WO)  { const int i = (it - IT_B) >> 9; d.W = in_ptr(20) + (size_t)(l * 3 + i) * 1024 * DM; d.K = 1024; d.N = DM; d.WT = (bf16*)(wl + W_B) + (size_t)i * DM * 1024; loc = (it - IT_B) & 511; }
    else if (it < IT_GU2) { d.W = in_ptr(21) + (size_t)l * DM * DM; d.K = DM; d.N = DM; d.WT = (bf16*)(wl + W_O); loc = it - IT_WO; }
    else if (it < IT_D2)  { d.W = in_ptr(22) + (size_t)l * DM * NGU; d.K = DM; d.N = NGU; d.WT = (bf16*)(wl + W_GU2); d.MAP = MAP_GU; loc = it - IT_GU2; }
    else                  { d.W = in_ptr(23) + (size_t)l * FF * DM; d.K = FF; d.N = DM; d.WT = (bf16*)(wl + W_D2); loc = it - IT_D2; }
    const int nb = d.N >> 6; d.k0 = 64 * (loc / nb); d.n0 = 64 * (loc % nb);
}
__device__ __forceinline__ void item_load(const ItemD& d, int lane, f32x4 (&tv)[16]) {
#pragma unroll
    for (int i = 0; i < 16; ++i) tv[i] = *(const GAS f32x4*)(d.W + (size_t)(d.k0 + 4 * i + (lane >> 4)) * d.N + d.n0 + 4 * (lane & 15));
}
__device__ __forceinline__ void item_store(const ItemD& d, LAS float* scr, int lane, const f32x4 (&tv)[16]) {
#pragma unroll
    for (int i = 0; i < 16; ++i) { LAS float* s = scr + (4 * i + (lane >> 4)) * 65 + 4 * (lane & 15); s[0] = tv[i].x; s[1] = tv[i].y; s[2] = tv[i].z; s[3] = tv[i].w; }
    LDS_WAIT(); asm volatile("" ::: "memory");
    const int c = lane & 7;
#pragma unroll
    for (int j = 0; j < 8; ++j) {
        const int n = 8 * j + (lane >> 3); const LAS float* s = scr + (8 * c) * 65 + n;
        v4u o; o.x = pk2(s[0], s[65]); o.y = pk2(s[130], s[195]); o.z = pk2(s[260], s[325]); o.w = pk2(s[390], s[455]);
        *(GAS v4u*)(d.WT + (size_t)rowmap(d.MAP, d.n0 + n) * d.K + d.k0 + 8 * c) = o;
    }
    LDS_WAIT(); asm volatile("" ::: "memory");
}
__device__ __forceinline__ void convert_range(Frame& F, int l, int lo, int hi, int widx, int nw) {
    LAS float* scr = (LAS float*)(F.lds + F.wave * 16640);
    unsigned char* wl = F.ws + WS_W + (size_t)l * W_LAYER;
    int it = lo + widx; if (it >= hi) return;
    ItemD cur; item_desc(l, it, wl, cur); f32x4 tv[16]; item_load(cur, F.lane, tv);
    for (;;) {
        const int nx = it + nw; const bool has = nx < hi; ItemD nd = cur; f32x4 tn[16];
        if (has) { item_desc(l, nx, wl, nd); item_load(nd, F.lane, tn); }
        item_store(cur, scr, F.lane, tv);
        if (!has) break;
        cur = nd; it = nx;
#pragma unroll
        for (int i = 0; i < 16; ++i) tv[i] = tn[i];
    }
}
__device__ __forceinline__ void cvt_array(Frame& F, const float* src, bf16* dst, int n8) {
    for (int i = F.bid * NTHR + F.tid; i < n8; i += F.G * NTHR) {
        const f32x4 a = *(const GAS f32x4*)(src + (size_t)i * 8), b = *(const GAS f32x4*)(src + (size_t)i * 8 + 4);
        v4u o; o.x = pk2(a.x, a.y); o.y = pk2(a.z, a.w); o.z = pk2(b.x, b.y); o.w = pk2(b.z, b.w);
        *(GAS v4u*)(dst + (size_t)i * 8) = o;
    }
}
__device__ __forceinline__ void mods_phase(Frame& F) {
    LAS float* sv = (LAS float*)F.lds;
    LAS f32x4* red = (LAS f32x4*)(F.lds + 24576);
    const float* c_lat = in_ptr(8); const float* c_ctx = in_ptr(9); const float* w_mod = in_ptr(10); const float* b_mod = in_ptr(11);
    float* mods = (float*)(F.ws + WS_MODS);
    for (int i = F.tid; i < 3 * 2048; i += NTHR) { const int g = i >> 11, k = i & 2047; const float c = (g == 0) ? c_ctx[k] : c_lat[(g - 1) * 2048 + k]; sv[i] = c / (1.f + __expf(-c)); }
    __syncthreads();
    for (int cb = F.bid; cb < 256; cb += F.G) {
        const int l = cb >> 7, col0 = (cb & 127) * 144;
        if (F.tid < 504) {
            const int c4 = F.tid % 36, kg = F.tid / 36;
            const GAS f32x4* wp = (const GAS f32x4*)(w_mod + (size_t)l * 2048 * 18432 + col0 + 4 * c4);
            f32x4 a0 = {0.f, 0.f, 0.f, 0.f}, a1 = a0, a2 = a0;
#pragma unroll 4
            for (int k = kg; k < 2048; k += 14) { const f32x4 w = wp[(size_t)k * 4608]; a0 += sv[k] * w; a1 += sv[2048 + k] * w; a2 += sv[4096 + k] * w; }
            red[(kg * 3 + 0) * 36 + c4] = a0; red[(kg * 3 + 1) * 36 + c4] = a1; red[(kg * 3 + 2) * 36 + c4] = a2;
        }
        __syncthreads();
        if (F.tid < 108) {
            const int g = F.tid / 36, c4 = F.tid % 36; f32x4 s = *(const GAS f32x4*)(b_mod + (size_t)l * 18432 + col0 + 4 * c4);
            for (int kg = 0; kg < 14; ++kg) s += red[(kg * 3 + g) * 36 + c4];
            *(GAS f32x4*)(mods + (size_t)(l * 3 + g) * 18432 + col0 + 4 * c4) = s;
        }
        __syncthreads();
    }
}
__device__ __forceinline__ void prologue(Frame& F) {
    unsigned char* ws = F.ws;
    for (int l = 0; l < 2; ++l) convert_range(F, l, 0, IT_END, F.bid * NWAVES + F.wave, F.G * NWAVES);
    cvt_array(F, in_ptr(2), (bf16*)(ws + WS_CACHE), 524288 / 8);
    cvt_array(F, in_ptr(3), (bf16*)(ws + WS_CACHE + 1 * MiB), 524288 / 8);
    cvt_array(F, in_ptr(6), (bf16*)(ws + WS_CACHE + 2 * MiB), 524288 / 8);
    cvt_array(F, in_ptr(7), (bf16*)(ws + WS_CACHE + 3 * MiB), 524288 / 8);
    cvt_array(F, in_ptr(4), (bf16*)(ws + WS_CACHE + 4 * MiB), 2097152 / 8);
    cvt_array(F, in_ptr(5), (bf16*)(ws + WS_CACHE + 8 * MiB), 2097152 / 8);
    { float* ct = (float*)(ws + WS_ROPE); float* st = ct + 2048;
      for (int i = F.bid * NTHR + F.tid; i < 2048; i += F.G * NTHR) { const int pos = i >> 5, f = i & 31;
          const float inv = exp2f(-(float)f * (13.287712379549449f / 32.0f)); const float ang = (float)pos * inv;
          const float kf = rintf(ang * 0.6366197723675814f); float r = fmaf(-kf, 1.5707962512969971f, ang); r = fmaf(-kf, 7.5497894158615964e-08f, r); r = fmaf(-kf, 5.3903029534742384e-15f, r);
          const float r2 = r * r;
          const float sn = r + r * r2 * (-1.6666667e-1f + r2 * (8.3333338e-3f + r2 * (-1.9841270e-4f + r2 * 2.7557319e-6f)));
          const float cs = 1.0f + r2 * (-0.5f + r2 * (4.1666668e-2f + r2 * (-1.3888889e-3f + r2 * (2.4801587e-5f + r2 * -2.7557319e-7f))));
          const int q = ((int)kf) & 3; const float sv_ = (q == 0) ? sn : (q == 1) ? cs : (q == 2) ? -sn : -cs, cv_ = (q == 0) ? cs : (q == 1) ? -sn : (q == 2) ? -cs : sn;
          ct[i] = cv_; st[i] = sv_; } }
    __syncthreads();
    mods_phase(F);
}

__device__ __forceinline__ void adaln_phase(Frame& F, int l, int which, bool from_inputs) {
    const float* X = F.out; bf16* H = (bf16*)(F.ws + WS_H); const float* mods = (const float*)(F.ws + WS_MODS);
    const float* gn = in_ptr(12) + (size_t)(l * 3 + which) * DM; const float* xin0 = in_ptr(0); const float* xin1 = in_ptr(1);
    const int gw = F.bid * NWAVES + F.wave, NGW = F.G * NWAVES, lane = F.lane;
#define ADALN_SRC(row) (from_inputs ? ((row) < R_CTX ? xin0 + (size_t)(row) * DM : xin1 + (size_t)((row) - R_CTX) * DM) : X + (size_t)(row) * DM)
    f32x4 v[8], vn[8];
    if (gw < RT) { const float* src = ADALN_SRC(gw);
#pragma unroll
        for (int j = 0; j < 8; ++j) v[j] = ((const GAS f32x4*)src)[64 * j + lane]; }
    for (int row = gw; row < RT; row += NGW) {
        const int g = row < R_CTX ? 0 : 1 + ((row - R_CTX) >> 12);
        const int nrow = row + NGW;
        if (nrow < RT) { const float* src = ADALN_SRC(nrow);
#pragma unroll
            for (int j = 0; j < 8; ++j) vn[j] = ((const GAS f32x4*)src)[64 * j + lane]; }
        float ss = 0.f;
#pragma unroll
        for (int j = 0; j < 8; ++j) ss += (v[j].x * v[j].x + v[j].y * v[j].y) + (v[j].z * v[j].z + v[j].w * v[j].w);
        const float rstd = 1.0f / sqrtf(wave_sum(ss, lane) * (1.0f / DM) + EPS_N);
        const GAS f32x4* gnp = (const GAS f32x4*)gn; const float* mg = mods + (size_t)(l * 3 + g) * 18432 + (size_t)which * 3 * DM;
        const GAS f32x4* shp = (const GAS f32x4*)mg; const GAS f32x4* scp = (const GAS f32x4*)(mg + DM);
        GAS unsigned long long* o8 = (GAS unsigned long long*)(H + (size_t)row * DM);
#pragma unroll
        for (int j = 0; j < 8; ++j) {
            const f32x4 a = gnp[64 * j + lane] * (1.0f + scp[64 * j + lane]) * rstd, b = shp[64 * j + lane]; const f32x4 h = v[j] * a + b;
            o8[64 * j + lane] = (unsigned long long)pk2(h.x, h.y) | ((unsigned long long)pk2(h.z, h.w) << 32);
        }
#pragma unroll
        for (int j = 0; j < 8; ++j) v[j] = vn[j];
    }
#undef ADALN_SRC
}
__device__ __forceinline__ void final_phase(Frame& F) {
    float* X = F.out; const GAS f32x4* gf = (const GAS f32x4*)in_ptr(24);
    const int gw = F.bid * NWAVES + F.wave, NGW = F.G * NWAVES, lane = F.lane;
    for (int row = gw; row < RT; row += NGW) {
        GAS f32x4* xr = (GAS f32x4*)(X + (size_t)row * DM);
        f32x4 v[8];
#pragma unroll
        for (int j = 0; j < 8; ++j) v[j] = xr[64 * j + lane];
        float ss = 0.f;
#pragma unroll
        for (int j = 0; j < 8; ++j) ss += (v[j].x * v[j].x + v[j].y * v[j].y) + (v[j].z * v[j].z + v[j].w * v[j].w);
        const float rstd = 1.0f / sqrtf(wave_sum(ss, lane) * (1.0f / DM) + EPS_N);
#pragma unroll
        for (int j = 0; j < 8; ++j) xr[64 * j + lane] = v[j] * rstd * gf[64 * j + lane];
    }
}
__device__ __forceinline__ bool make_unit(Frame& F, int l, int id, att::Unit& U) {
    if (id >= 1152) return false;
    unsigned char* qb = F.ws + WS_QKVG;
    const bf16* QA = (const bf16*)qb; const bf16* QB = (const bf16*)(qb + 24 * MiB); const bf16* QC = (const bf16*)(qb + 48 * MiB); const bf16* KB = (const bf16*)(qb + 72 * MiB); const bf16* VB = (const bf16*)(qb + 96 * MiB);
    const bf16* KA = (const bf16*)(qb + 120 * MiB); const bf16* VA = (const bf16*)(qb + 126 * MiB); const bf16* KC = (const bf16*)(qb + 132 * MiB); const bf16* VC = (const bf16*)(qb + 138 * MiB);
    const bf16* CKA = (const bf16*)(F.ws + WS_CACHE); const bf16* CVA = (const bf16*)(F.ws + WS_CACHE + 1 * MiB); const bf16* CKC = (const bf16*)(F.ws + WS_CACHE + 2 * MiB); const bf16* CVC = (const bf16*)(F.ws + WS_CACHE + 3 * MiB);
    const bf16* CKB = (const bf16*)(F.ws + WS_CACHE + 4 * MiB); const bf16* CVB = (const bf16*)(F.ws + WS_CACHE + 8 * MiB);
    bf16* O = (bf16*)(F.ws + WS_ACT);
    const float LOG2E = 1.4426950408889634f;
    U.mode = 0; U.a = 0; U.b = 0; U.sink2 = -__builtin_inff(); U.tab = in_ptr(18); U.n0 = 0;
    if (id < 768) {
        const int type = id >> 8, v = id & 255, xcd = v & 7, j = v >> 3; int b, h, q;
        if (type != 1) { const int combo = xcd >> 1, idx = (xcd & 1) * 32 + j; b = combo >> 1; h = (combo & 1) * 4 + (idx >> 4); q = idx & 15; }
        else { const int combo = xcd * 2 + (j >> 4); b = combo >> 3; h = combo & 7; q = j & 15; }
        const size_t lat0 = R_CTX + (size_t)b * 4096, row0 = lat0 + (size_t)q * 256, cb = (size_t)(b * 2 + l) * 512;
        U.n0 = 8;
        if (type == 0) { const int kvh = h >> 2; U.ldk = 256;
            U.Q = QA + row0 * 1024 + h * 128; U.O = O + row0 * 1024 + h * 128;
            U.K0 = CKA + cb * 256 + kvh * 128; U.V0 = CVA + cb * 256 + kvh * 128; U.K1 = KA + lat0 * 256 + kvh * 128; U.V1 = VA + lat0 * 256 + kvh * 128; U.n1 = 64; }
        else if (type == 1) { U.ldk = 1024; const int R0 = q * 4, kr0 = min(max(R0 - 4, 0), 52);
            U.Q = QB + row0 * 1024 + h * 128; U.O = O + (size_t)RT * 1024 + row0 * 1024 + h * 128;
            U.K0 = CKB + cb * 1024 + h * 128; U.V0 = CVB + cb * 1024 + h * 128; U.K1 = KB + (lat0 + (size_t)kr0 * 64) * 1024 + h * 128; U.V1 = VB + (lat0 + (size_t)kr0 * 64) * 1024 + h * 128; U.n1 = 12;
            U.mode = 1; U.a = R0; U.b = kr0; U.tab = in_ptr(18) + (size_t)(l * 8 + h) * 465; }
        else { const int kvh = h >> 2; U.ldk = 256; const int kp0 = max(q * 256 - 128, 0), kp1 = min(q * 256 + 384, 4096);
            U.Q = QC + row0 * 1024 + h * 128; U.O = O + (size_t)2 * RT * 1024 + row0 * 1024 + h * 128;
            U.K0 = CKC + cb * 256 + kvh * 128; U.V0 = CVC + cb * 256 + kvh * 128; U.K1 = KC + (lat0 + kp0) * 256 + kvh * 128; U.V1 = VC + (lat0 + kp0) * 256 + kvh * 128; U.n1 = (kp1 - kp0) >> 6;
            U.mode = 2; U.a = q * 256; U.b = kp0; U.sink2 = in_ptr(19)[l * 8 + h] * LOG2E; }
    } else {
        const int v = id - 768, b = v / 24, rem = v - 24 * b, br = rem >> 3, h = rem & 7; const size_t row0 = (size_t)b * 256;
        const int kvh = br == 1 ? h : (h >> 2); U.ldk = br == 1 ? 1024 : 256;
        const bf16* Qx = br == 0 ? QA : br == 1 ? QB : QC; const bf16* Kx = br == 0 ? KA : br == 1 ? KB : KC; const bf16* Vx = br == 0 ? VA : br == 1 ? VB : VC;
        U.Q = Qx + row0 * 1024 + h * 128; U.O = O + (size_t)br * RT * 1024 + row0 * 1024 + h * 128;
        U.K1 = Kx + row0 * U.ldk + kvh * 128; U.V1 = Vx + row0 * U.ldk + kvh * 128; U.K0 = U.K1; U.V0 = U.V1; U.n1 = 4;
        if (br == 2) U.sink2 = in_ptr(19)[l * 8 + h] * LOG2E;
    }
    return true;
}
__device__ __forceinline__ void attn_phase(Frame& F, int l, char* lds) {
    for (int id = F.bid; ; id += F.G) { att::Unit U; if (!make_unit(F, l, id, U)) break; att::attn_unit(U, lds, F.tid); }
}

namespace pg8 {
struct EpiSwiglu {
    static constexpr bool PERM = false, AFTER_DRAIN = false, CHAIN = false;
    bf16_t* ACT;
    __device__ __forceinline__ void operator()(const f32x4 (&acc)[2][2][4][2], const Unit& u, int wr, int wc, int fr, int fq) const {
        { int ln_; asm volatile("v_mbcnt_lo_u32_b32 %0, -1, 0\n\tv_mbcnt_hi_u32_b32 %0, -1, %0" : "=v"(ln_)); fr = ln_ & 15; fq = ln_ >> 4; }
        const int row0 = u.pm * BM + wr * 64 + fr, col0 = u.pn * 128 + wc * 32 + 8 * fq;
#pragma unroll
        for (int ai = 0; ai < 2; ++ai)
#pragma unroll
            for (int m = 0; m < 4; ++m) { u32x4 w;
#pragma unroll
                for (int bj = 0; bj < 2; ++bj) { const f32x4 a = acc[ai][bj][m][0], b = acc[ai][bj][m][1]; f32x4 r;
#pragma unroll
                    for (int e = 0; e < 4; ++e) r[e] = a[e] * __builtin_amdgcn_rcpf(1.0f + __expf(-a[e])) * b[e];
                    w[2 * bj] = cvt_pk_bf16(r[0], r[1]); w[2 * bj + 1] = cvt_pk_bf16(r[2], r[3]); }
                *(u32x4*)(ACT + (size_t)(row0 + ai * HALF + m * 16) * 5632 + col0) = w; }
    }
};
struct EpiResid {
    static constexpr bool PERM = false, AFTER_DRAIN = false, CHAIN = false;
    float* X; const float* base_ctx; const float* base_lat; const float* gate; float coef;
    __device__ __forceinline__ void operator()(const f32x4 (&acc)[2][2][4][2], const Unit& u, int wr, int wc, int fr, int fq) const {
        { int ln_; asm volatile("v_mbcnt_lo_u32_b32 %0, -1, 0\n\tv_mbcnt_hi_u32_b32 %0, -1, %0" : "=v"(ln_)); fr = ln_ & 15; fq = ln_ >> 4; }
        const int col0 = u.pn * BM + wc * 32 + 4 * fq;
        const int grp = u.pm < 16 ? 0 : (u.pm < 32 ? 1 : 2);
        const float* bs = u.pm < 16 ? base_ctx + (size_t)u.pm * BM * 2048 : base_lat + (size_t)(u.pm - 16) * BM * 2048;
        f32x4 gv[2][2];
#pragma unroll
        for (int bj = 0; bj < 2; ++bj)
#pragma unroll
            for (int n = 0; n < 2; ++n) gv[bj][n] = *(const f32x4*)(gate + (size_t)grp * 18432 + col0 + bj * HALF + n * 16) * coef;
#pragma unroll
        for (int ai = 0; ai < 2; ++ai) {
            f32x4 bv[4][2][2];
#pragma unroll
            for (int m = 0; m < 4; ++m) { const size_t off = (size_t)(wr * 64 + fr + ai * HALF + m * 16) * 2048 + col0;
#pragma unroll
                for (int bj = 0; bj < 2; ++bj)
#pragma unroll
                    for (int n = 0; n < 2; ++n) bv[m][bj][n] = *(const f32x4*)(bs + off + bj * HALF + n * 16); }
#pragma unroll
            for (int m = 0; m < 4; ++m) { const size_t off = (size_t)(wr * 64 + fr + ai * HALF + m * 16) * 2048 + col0;
#pragma unroll
                for (int bj = 0; bj < 2; ++bj)
#pragma unroll
                    for (int n = 0; n < 2; ++n) *(f32x4*)(X + (size_t)u.pm * BM * 2048 + off + bj * HALF + n * 16) = bv[m][bj][n] + gv[bj][n] * acc[ai][bj][m][n]; } }
    }
};
struct EpiBranch {
    static constexpr bool PERM = false, AFTER_DRAIN = false, CHAIN = true;
    bf16_t* Mb; const bf16_t* GT;
    __device__ __forceinline__ void operator()(f32x4 (&acc)[2][2][4][2], const Unit& u, int wr, int wc, int fr, int fq) const {
        { int ln_; asm volatile("v_mbcnt_lo_u32_b32 %0, -1, 0\n\tv_mbcnt_hi_u32_b32 %0, -1, %0" : "=v"(ln_)); fr = ln_ & 15; fq = ln_ >> 4; }
        const int br = u.pm / 48, pm = u.pm - 48 * br, pn = u.pn & 7;
        const int row0 = pm * BM + wr * 64 + fr, col0 = pn * BM + wc * 32 + 4 * fq;
        const int o2 = br < 2 ? 2048 : 0;
        const float keep = br < 2 ? 1.0f : 0.0f;
#pragma unroll
        for (int aq = 0; aq < 4; ++aq) { const int ai = aq >> 1, m0 = (aq & 1) * 2;
            unsigned long long ga[2][2][2], gb[2][2][2];
#pragma unroll
            for (int mm = 0; mm < 2; ++mm) { const size_t row = (size_t)(row0 + ai * HALF + (m0 + mm) * 16);
#pragma unroll
                for (int bj = 0; bj < 2; ++bj)
#pragma unroll
                    for (int n = 0; n < 2; ++n) { const bf16_t* gp = GT + row * 6144 + br * 2048 + col0 + bj * HALF + n * 16; ga[mm][bj][n] = *(const unsigned long long*)gp; gb[mm][bj][n] = *(const unsigned long long*)(gp + o2); } }
#pragma unroll
            for (int mm = 0; mm < 2; ++mm) { const size_t row = (size_t)(row0 + ai * HALF + (m0 + mm) * 16);
#pragma unroll
                for (int bj = 0; bj < 2; ++bj)
#pragma unroll
                    for (int n = 0; n < 2; ++n) { const unsigned a0 = (unsigned)ga[mm][bj][n], a1 = (unsigned)(ga[mm][bj][n] >> 32), b0 = (unsigned)gb[mm][bj][n], b1 = (unsigned)(gb[mm][bj][n] >> 32);
                        const f32x4 num = {__uint_as_float(a0 << 16), __uint_as_float(a0 & 0xffff0000u), __uint_as_float(a1 << 16), __uint_as_float(a1 & 0xffff0000u)};
                        const f32x4 den = {__uint_as_float(b0 << 16), __uint_as_float(b0 & 0xffff0000u), __uint_as_float(b1 << 16), __uint_as_float(b1 & 0xffff0000u)};
                        f32x4 r;
#pragma unroll
                        for (int e = 0; e < 4; ++e) { const float nu = fmaxf(num[e], 1e-20f), de = fmaxf(den[e], 1e-20f); r[e] = br < 2 ? nu * __builtin_amdgcn_rcpf(de) : nu; }
                        if (br == 2) { const f32x4 t = acc[ai][bj][m0 + mm][n] * r;
                            *(unsigned long long*)(Mb + row * 2048 + col0 + bj * HALF + n * 16) = (unsigned long long)cvt_pk_bf16(t[0], t[1]) | ((unsigned long long)cvt_pk_bf16(t[2], t[3]) << 32); }
                        acc[ai][bj][m0 + mm][n] *= r * keep;
                        asm volatile("" : "+v"(acc[ai][bj][m0 + mm][n])); } }
            __builtin_amdgcn_sched_barrier(0); }
    }
};
struct EpiInproj {
    static constexpr bool PERM = false, AFTER_DRAIN = false, CHAIN = false;
    unsigned char* qkvg; float* out; const float* gq; const float* gk; const float* ropec; int l; PG8_LAS float* P;
    __device__ __forceinline__ void operator()(const f32x4 (&acc)[2][2][4][2], const Unit& u, int wr, int wc, int fr, int fq) const {
        { int ln_; asm volatile("v_mbcnt_lo_u32_b32 %0, -1, 0\n\tv_mbcnt_hi_u32_b32 %0, -1, %0" : "=v"(ln_)); fr = ln_ & 15; fq = ln_ >> 4; }
        constexpr size_t MiB_ = 1u << 20;
        const int pn = u.pn; const bool isctx = u.pm < 16;
        bf16_t* dst; int dld; float* fo = nullptr; int fld = 0; int kind = 0, norm = 0;
        if (pn < 4)        { dst = (bf16_t*)qkvg + pn * 256; dld = 1024; kind = 1; norm = 1; }
        else if (pn == 4)  { dst = (bf16_t*)(qkvg + 120 * MiB_); dld = 256; kind = 1; norm = 2; fo = out + 25165824; fld = 256; }
        else if (pn == 5)  { dst = (bf16_t*)(qkvg + 126 * MiB_); dld = 256; fo = out + 27262976; fld = 256; }
        else if (pn < 10)  { dst = (bf16_t*)(qkvg + 24 * MiB_) + (pn - 6) * 256; dld = 1024; }
        else if (pn < 14)  { dst = (bf16_t*)(qkvg + 72 * MiB_) + (pn - 10) * 256; dld = 1024; fo = out + 29360128 + (pn - 10) * 256; fld = 1024; }
        else if (pn < 18)  { dst = (bf16_t*)(qkvg + 96 * MiB_) + (pn - 14) * 256; dld = 1024; fo = out + 37748736 + (pn - 14) * 256; fld = 1024; }
        else if (pn < 22)  { dst = (bf16_t*)(qkvg + 48 * MiB_) + (pn - 18) * 256; dld = 1024; kind = 1; }
        else if (pn == 22) { dst = (bf16_t*)(qkvg + 132 * MiB_); dld = 256; kind = 1; fo = out + 46137344; fld = 256; }
        else if (pn == 23) { dst = (bf16_t*)(qkvg + 138 * MiB_); dld = 256; fo = out + 48234496; fld = 256; }
        else               { dst = (bf16_t*)(qkvg + 144 * MiB_) + (pn - 24) * 256; dld = 6144; kind = 2; }
        if (!isctx) fo = nullptr;
        const int rl0 = wr * 64 + fr;
        const size_t grow0 = (size_t)u.pm * BM;
        const size_t frow0 = ((size_t)(u.pm * 2 + l)) * 256;
        if (kind != 1) {
            const int c0 = 32 * wc + 8 * fq;
#pragma unroll
            for (int ai = 0; ai < 2; ++ai)
#pragma unroll
                for (int m = 0; m < 4; ++m) { const int rl = rl0 + ai * HALF + m * 16;
#pragma unroll
                    for (int bj = 0; bj < 2; ++bj) { f32x4 a = acc[ai][bj][m][0], b = acc[ai][bj][m][1];
                        if (kind == 2) {
#pragma unroll
                            for (int e = 0; e < 4; ++e) { a[e] = __builtin_amdgcn_rcpf(1.0f + __expf(-a[e])); b[e] = __builtin_amdgcn_rcpf(1.0f + __expf(-b[e])); } }
                        u32x4 w; w.x = cvt_pk_bf16(a[0], a[1]); w.y = cvt_pk_bf16(a[2], a[3]); w.z = cvt_pk_bf16(b[0], b[1]); w.w = cvt_pk_bf16(b[2], b[3]);
                        *(u32x4*)(dst + (grow0 + rl) * dld + bj * HALF + c0) = w;
                        if (fo) { float* fp = fo + (frow0 + rl) * fld + bj * HALF + c0; *(f32x4*)fp = a; *(f32x4*)(fp + 4) = b; } } }
            return;
        }
        const int db = 64 * (wc >> 1) + 16 * (wc & 1) + 4 * fq;
        if (norm) {
#pragma unroll
            for (int ai = 0; ai < 2; ++ai)
#pragma unroll
                for (int m = 0; m < 4; ++m)
#pragma unroll
                    for (int bj = 0; bj < 2; ++bj) { const f32x4 a = acc[ai][bj][m][0], b = acc[ai][bj][m][1];
                        float ss = (a[0] * a[0] + a[1] * a[1]) + (a[2] * a[2] + a[3] * a[3]) + (b[0] * b[0] + b[1] * b[1]) + (b[2] * b[2] + b[3] * b[3]);
                        ss += shx(ss, 16, 16 * fq + fr); ss += shx(ss, 32, 16 * fq + fr);
                        if (fq == 0) P[((rl0 + ai * HALF + m * 16) * 2 + bj) * 4 + wc] = ss; }
            asm volatile("s_waitcnt lgkmcnt(0)" ::: "memory"); __builtin_amdgcn_s_barrier(); asm volatile("" ::: "memory");
        }
        f32x4 g0 = {1.f, 1.f, 1.f, 1.f}, g1 = g0;
        if (norm) { const float* gg = norm == 1 ? gq : gk; g0 = *(const f32x4*)(gg + db); g1 = *(const f32x4*)(gg + db + 32); }
        const int fi = 16 * (wc & 1) + 4 * fq;
#pragma unroll
        for (int ai = 0; ai < 2; ++ai) { f32x4 csv[4], snv[4];
#pragma unroll
            for (int m = 0; m < 4; ++m) { csv[m] = (f32x4){1.f, 1.f, 1.f, 1.f}; snv[m] = (f32x4){0.f, 0.f, 0.f, 0.f};
                if (!isctx) { const int nl = (int)((grow0 + rl0 + ai * HALF + m * 16 - 4096) & 4095); const int pos = (wc >> 1) ? (nl & 63) : (nl >> 6);
                    csv[m] = *(const f32x4*)(ropec + pos * 32 + fi); snv[m] = *(const f32x4*)(ropec + 2048 + pos * 32 + fi); } }
#pragma unroll
            for (int m = 0; m < 4; ++m) { const int rl = rl0 + ai * HALF + m * 16;
                const f32x4 cs = csv[m], sn = snv[m];
#pragma unroll
                for (int bj = 0; bj < 2; ++bj) { f32x4 a = acc[ai][bj][m][0], b = acc[ai][bj][m][1];
                    if (norm) { const f32x4 pp = *(const PG8_LAS f32x4*)(P + (rl * 2 + bj) * 4); const float rstd = 1.0f / sqrtf(((pp[0] + pp[1]) + (pp[2] + pp[3])) * (1.0f / 128.0f) + 1e-6f);
                        a = a * rstd * g0; b = b * rstd * g1; }
                    const f32x4 y1 = a * cs - b * sn, y2 = b * cs + a * sn;
                    bf16_t* dp = dst + (grow0 + rl) * dld + bj * HALF + db;
                    *(unsigned long long*)dp = (unsigned long long)cvt_pk_bf16(y1[0], y1[1]) | ((unsigned long long)cvt_pk_bf16(y1[2], y1[3]) << 32);
                    *(unsigned long long*)(dp + 32) = (unsigned long long)cvt_pk_bf16(y2[0], y2[1]) | ((unsigned long long)cvt_pk_bf16(y2[2], y2[3]) << 32);
                    if (fo) { float* fp = fo + (frow0 + rl) * fld + bj * HALF + db; *(f32x4*)fp = y1; *(f32x4*)(fp + 32) = y2; } } } }
    }
};
struct BranchOrder {
    int G, c;
    __device__ __forceinline__ bool next(int i, Unit& u) const { const int j = i / 3, br = i - 3 * j; const int tile = j * G + c; if (tile >= 384) return false;
        u.pm = br * 48 + (tile >> 3); u.pn = br * 8 + (tile & 7); return true; }
    __device__ __forceinline__ void a_ready(const Unit&) const {}
    __device__ __forceinline__ void done(const Unit&) const {}
};
}

__global__ void __launch_bounds__(NTHR, 2) mega_fwd(Args args) {
    extern __shared__ __attribute__((aligned(16))) unsigned char lds[];
    Frame F;
    F.lds = (LAS unsigned char*)lds; F.tid = threadIdx.x; F.lane = F.tid & 63; F.wave = __builtin_amdgcn_readfirstlane(F.tid >> 6); F.G = gridDim.x; F.bid = blockIdx.x;
    F.out = (float*)in_ptr(25); F.ws = (unsigned char*)in_ptr(26);
    for (int u = F.tid; u < (LDS_BYTES - LDSCTL_OFF) / 4; u += NTHR) ((LAS unsigned*)(F.lds + LDSCTL_OFF))[u] = 0u;
    __syncthreads();
    volatile LAS unsigned* MISC = (volatile LAS unsigned*)(F.lds + MISC_OFF);
    XcdBarrier bar = xcd_barrier_post((unsigned*)(F.ws + WS_CTL) + CW_BAR, MISC + 8, F.tid);
#define RELAUNDER() do { asm volatile("v_mbcnt_lo_u32_b32 %0, -1, 0\n\tv_mbcnt_hi_u32_b32 %0, -1, %0" : "=v"(F.lane)); \
    asm volatile("" : "+s"(F.wave), "+s"(F.bid), "+s"(F.G), "+s"(F.ws), "+s"(F.out), "+s"(bar.bar), "+s"(bar.x)); F.tid = F.wave * 64 + F.lane; } while (0)
#define GRID_BAR() do { RELAUNDER(); xcd_barrier(bar, F.tid); RELAUNDER(); } while (0)

    prologue(F); GRID_BAR();

    for (int l = 0; l < 2; ++l) {
        unsigned char* wl = F.ws + WS_W + (size_t)l * W_LAYER;
        const float* modl = (const float*)(F.ws + WS_MODS) + (size_t)l * 3 * 18432;
        adaln_phase(F, l, 0, l == 0); GRID_BAR();
        { pg8::Gemm g{(const bf16*)(F.ws + WS_H), (const bf16*)(wl + W_GU1), RT, NGU, DM}; pg8::StaticOrder S; S.init(RT, NGU, F.G, F.bid);
          pg8::EpiSwiglu E{(bf16*)(F.ws + WS_ACT)};
          pg8::gemm_phase<pg8::EpiSwiglu, pg8::StaticOrder, true, true>(F.lds, g, S, E, F.tid); }
        GRID_BAR();
        { pg8::Gemm g{(const bf16*)(F.ws + WS_ACT), (const bf16*)(wl + W_D1), RT, DM, FF}; pg8::StaticOrder S; S.init(RT, DM, F.G, F.bid);
          pg8::EpiResid E{F.out, l == 0 ? in_ptr(0) : F.out, l == 0 ? in_ptr(1) : F.out + (size_t)R_CTX * DM, modl + 2 * DM, 0.5f};
          pg8::gemm_phase<pg8::EpiResid, pg8::StaticOrder, true, true>(F.lds, g, S, E, F.tid); }
        GRID_BAR();
        adaln_phase(F, l, 1, false); GRID_BAR();
        { pg8::Gemm g{(const bf16*)(F.ws + WS_H), (const bf16*)(wl + W_IN), RT, DIN, DM}; pg8::StaticOrder S; S.init(RT, DIN, F.G, F.bid);
          pg8::EpiInproj E{F.ws + WS_QKVG, F.out, in_ptr(16) + l * HD, in_ptr(17) + l * HD, (const float*)(F.ws + WS_ROPE), l, (LAS float*)(F.lds + EXCH_OFF)};
          pg8::gemm_phase<pg8::EpiInproj, pg8::StaticOrder, true, true>(F.lds, g, S, E, F.tid); }
        GRID_BAR();
        attn_phase(F, l, (char*)lds); GRID_BAR();
        { pg8::Gemm g{(const bf16*)(F.ws + WS_ACT)  , (const bf16*)(wl + W_B), 3 * RT, 3 * DM, 1024}; pg8::BranchOrder S{F.G, F.bid};
          pg8::EpiBranch E{(bf16*)(F.ws + WS_H), (const bf16*)(F.ws + WS_QKVG + 144 * MiB)};
          pg8::gemm_phase<pg8::EpiBranch, pg8::BranchOrder, true, true>(F.lds, g, S, E, F.tid); }
        GRID_BAR();
        { pg8::Gemm g{(const bf16*)(F.ws + WS_H)  , (const bf16*)(wl + W_O), RT, DM, DM}; pg8::StaticOrder S; S.init(RT, DM, F.G, F.bid);
          pg8::EpiResid E{F.out, F.out, F.out + (size_t)R_CTX * DM, modl + 5 * DM, 1.0f};
          pg8::gemm_phase<pg8::EpiResid, pg8::StaticOrder, true, true>(F.lds, g, S, E, F.tid); }
        GRID_BAR();
        adaln_phase(F, l, 2, false); GRID_BAR();
        { pg8::Gemm g{(const bf16*)(F.ws + WS_H), (const bf16*)(wl + W_GU2), RT, NGU, DM}; pg8::StaticOrder S; S.init(RT, NGU, F.G, F.bid);
          pg8::EpiSwiglu E{(bf16*)(F.ws + WS_ACT)};
          pg8::gemm_phase<pg8::EpiSwiglu, pg8::StaticOrder, true, true>(F.lds, g, S, E, F.tid); }
        GRID_BAR();
        { pg8::Gemm g{(const bf16*)(F.ws + WS_ACT), (const bf16*)(wl + W_D2), RT, DM, FF}; pg8::StaticOrder S; S.init(RT, DM, F.G, F.bid);
          pg8::EpiResid E{F.out, F.out, F.out + (size_t)R_CTX * DM, modl + 8 * DM, 0.5f};
          pg8::gemm_phase<pg8::EpiResid, pg8::StaticOrder, true, true>(F.lds, g, S, E, F.tid); }
        GRID_BAR();
    }
    final_phase(F);
#undef GRID_BAR
}

extern "C" void kernel_launch(void* const* d_in, const int* in_sizes, int n_in, void* d_out, int out_size, void* d_ws, size_t ws_size, hipStream_t stream) {
    static int grid = 0;
    if (grid == 0) {
        if (n_in != 25 || out_size != (int)OUT_TOTAL || ws_size < WS_END) { fprintf(stderr, "kernel_launch: unexpected shapes: n_in %d out %d ws %zu (need %zu)\n", n_in, out_size, ws_size, (size_t)WS_END); grid = -1; return; }
        int dev = 0, cus = 0, per_cu = 0;
        if (hipGetDevice(&dev) != hipSuccess || hipDeviceGetAttribute(&cus, hipDeviceAttributeMultiprocessorCount, dev) != hipSuccess) { grid = -1; return; }
        if (hipFuncSetAttribute((const void*)mega_fwd, hipFuncAttributeMaxDynamicSharedMemorySize, LDS_BYTES) != hipSuccess) { fprintf(stderr, "kernel_launch: hipFuncSetAttribute failed\n"); grid = -1; return; }
        if (hipOccupancyMaxActiveBlocksPerMultiprocessor(&per_cu, (const void*)mega_fwd, NTHR, LDS_BYTES) != hipSuccess || per_cu < 1) { fprintf(stderr, "kernel_launch: occupancy query says %d\n", per_cu); (void)hipGetLastError(); grid = -1; return; }
        grid = cus;
    }
    if (grid < 0) return;
    if (hipMemsetAsync((char*)d_ws + WS_CTL, 0, CTL_ZERO_BYTES, stream) != hipSuccess) return;
    Args a{};
    for (int i = 0; i < 25; ++i) a.in[i] = (const float*)d_in[i];
    a.out = (float*)d_out; a.ws = (unsigned char*)d_ws;
    hipLaunchKernelGGL(mega_fwd, dim3(grid), dim3(NTHR), LDS_BYTES, stream, a);
}
```
